# Optimizing an MI355X kernel written in HIP

```python
import jax, jax.numpy as jnp
from jax import lax
import numpy as np

D_MODEL = 1024
BATCH = 4
SEQ = 8192
DEPTH = 1

CHUNK = 64
Q_BLOCK = 128
PLE_DIM = 256
CONV_DIM = D_MODEL // 2
CONV_WIDTH = 3
SB_HEADS = 8
SB_HEAD_DIM = 64
SB_DIM = SB_HEADS * SB_HEAD_DIM
MIX_WIDTH = CONV_DIM + SB_DIM
IN_PROJ_DIM = 3 * CONV_DIM + 3 * SB_DIM
D_FF = 2816
FFN_RES = 0.5
EPS = 1e-6

kernel_name = "hybrid_shortconv_stickbreaking_macaron_block"


def _rmsnorm(x, g):
    xf = x.astype(jnp.float32)
    y = xf * lax.rsqrt(jnp.mean(xf * xf, axis=-1, keepdims=True) + EPS)
    return (y * g.astype(jnp.float32)).astype(x.dtype)


def _swiglu(h, w_gate, w_up, w_down):
    return (jax.nn.silu(h @ w_gate) * (h @ w_up)) @ w_down


def _short_gated_conv(b, c, u, conv_w, conv_b):
    z = c * u
    rhs = conv_w[:, None, :].astype(z.dtype)
    y = lax.conv_general_dilated(
        z, rhs, window_strides=(1,), padding=[(CONV_WIDTH - 1, 0)],
        dimension_numbers=("NWC", "WIO", "NWC"), feature_group_count=CONV_DIM)
    return b * (y + conv_b.astype(z.dtype))


def _stick_breaking(q, k, v):
    S = q.shape[2]
    scale = SB_HEAD_DIM ** -0.5
    outs = []
    for t0 in range(0, S, Q_BLOCK):
        kl = t0 + Q_BLOCK
        qs = q[:, :, t0:t0 + Q_BLOCK]
        ks = k[:, :, :kl]
        vs = v[:, :, :kl]
        z = jnp.einsum("bhqd,bhkd->bhqk", qs, ks) * scale
        t_idx = t0 + jnp.arange(Q_BLOCK)[:, None]
        s_idx = jnp.arange(kl)[None, :]
        causal = s_idx < t_idx
        log_keep = jnp.where(causal, jax.nn.log_sigmoid(-z), 0.0)
        later = lax.cumsum(log_keep, axis=3, reverse=True) - log_keep
        a = jnp.where(causal, jnp.exp(jax.nn.log_sigmoid(z) + later), 0.0)
        outs.append(jnp.einsum("bhqk,bhkd->bhqd", a, vs))
    return jnp.concatenate(outs, axis=2)


def setup_inputs(seed: int = 0) -> dict:
    key = jax.random.key(seed)
    ks = jax.random.split(key, 24)
    f32 = jnp.float32

    def w(k, shape, fan_in):
        return jax.random.normal(k, shape, f32) * (fan_in ** -0.5)

    def gain(k, shape):
        return 1.0 + 0.05 * jax.random.normal(k, shape, f32)

    return {
        "x": jax.random.normal(ks[0], (BATCH, SEQ, D_MODEL), f32),
        "p": jax.random.normal(ks[1], (DEPTH, BATCH, SEQ, PLE_DIM), f32),
        "ffn1_norm": gain(ks[2], (DEPTH, D_MODEL)),
        "ffn1_w_gate": w(ks[3], (DEPTH, D_MODEL, D_FF), D_MODEL),
        "ffn1_w_up": w(ks[4], (DEPTH, D_MODEL, D_FF), D_MODEL),
        "ffn1_w_down": w(ks[5], (DEPTH, D_FF, D_MODEL), D_FF),
        "mix_norm": gain(ks[6], (DEPTH, D_MODEL)),
        "w_in": w(ks[7], (DEPTH, D_MODEL, IN_PROJ_DIM), D_MODEL),
        "conv_w": w(ks[8], (DEPTH, CONV_WIDTH, CONV_DIM), CONV_WIDTH),
        "conv_b": 0.02 * jax.random.normal(ks[9], (DEPTH, CONV_DIM), f32),
        "q_norm": gain(ks[10], (DEPTH, SB_HEAD_DIM)),
        "k_norm": gain(ks[11], (DEPTH, SB_HEAD_DIM)),
        "w_out": w(ks[12], (DEPTH, MIX_WIDTH, D_MODEL), MIX_WIDTH),
        "ffn2_norm": gain(ks[13], (DEPTH, D_MODEL)),
        "ffn2_w_gate": w(ks[14], (DEPTH, D_MODEL, D_FF), D_MODEL),
        "ffn2_w_up": w(ks[15], (DEPTH, D_MODEL, D_FF), D_MODEL),
        "ffn2_w_down": w(ks[16], (DEPTH, D_FF, D_MODEL), D_FF),
        "ple_norm": gain(ks[17], (DEPTH, D_MODEL)),
        "ple_w_gate": w(ks[18], (DEPTH, D_MODEL, D_MODEL), D_MODEL),
        "ple_w_proj": w(ks[19], (DEPTH, PLE_DIM, D_MODEL), PLE_DIM),
    }


def reference(x, p, ffn1_norm, ffn1_w_gate, ffn1_w_up, ffn1_w_down, mix_norm, w_in,
              conv_w, conv_b, q_norm, k_norm, w_out, ffn2_norm, ffn2_w_gate, ffn2_w_up,
              ffn2_w_down, ple_norm, ple_w_gate, ple_w_proj):
    B, S, _ = x.shape
    for i in range(DEPTH):
        x = x + FFN_RES * _swiglu(_rmsnorm(x, ffn1_norm[i]), ffn1_w_gate[i], ffn1_w_up[i], ffn1_w_down[i])

        h = _rmsnorm(x, mix_norm[i])
        proj = h @ w_in[i]
        b_g, c_g, u, q, k, v = jnp.split(
            proj, np.cumsum([CONV_DIM, CONV_DIM, CONV_DIM, SB_DIM, SB_DIM]).tolist(), axis=-1)

        y_conv = _short_gated_conv(b_g, c_g, u, conv_w[i], conv_b[i])

        def heads(t):
            return t.reshape(B, S, SB_HEADS, SB_HEAD_DIM).transpose(0, 2, 1, 3).astype(jnp.float32)
        qh = _rmsnorm(heads(q), q_norm[i])
        kh = _rmsnorm(heads(k), k_norm[i])
        y_sb = _stick_breaking(qh, kh, heads(v))
        y_sb = y_sb.transpose(0, 2, 1, 3).reshape(B, S, SB_DIM).astype(x.dtype)

        x = x + jnp.concatenate([y_conv, y_sb], axis=-1) @ w_out[i]

        x = x + FFN_RES * _swiglu(_rmsnorm(x, ffn2_norm[i]), ffn2_w_gate[i], ffn2_w_up[i], ffn2_w_down[i])

        gate = jax.nn.sigmoid(_rmsnorm(x, ple_norm[i]) @ ple_w_gate[i])
        x = x + gate * (p[i].astype(x.dtype) @ ple_w_proj[i])
    return x
```

```cpp
#include <hip/hip_runtime.h>
#include <hip/hip_cooperative_groups.h>
#include <cstdio>
#include <cstdint>
namespace cg = cooperative_groups;
namespace pg8 {
#define PG8_LAS __attribute__((address_space(3)))
typedef unsigned short bf16_t;
typedef short bf16x8 __attribute__((ext_vector_type(8)));
typedef float f32x4 __attribute__((ext_vector_type(4)));
typedef unsigned u32x4 __attribute__((ext_vector_type(4)));
constexpr int BM = 256, BK = 64, HALF = 128, HTB = HALF * BK * 2  , STAGE_BYTES = 8 * HTB, NXCD = 8, WGM = 8;

__host__ __device__ __forceinline__ int lds_byte(int r, int c) { const int st = (r >> 4) * 2 + (c >> 5), rr = r & 15, cc = c & 31, ob = rr * 64 + cc * 2; return st * 1024 + (ob ^ (((ob >> 9) & 1) << 5)); }
__host__ __device__ __forceinline__ void stage_rc(int b, int& R, int& C) { const int st = b / 1024, sb = b % 1024, swz = sb ^ (((sb >> 9) & 1) << 5); R = (st >> 1) * 16 + swz / 64; C = (st & 1) * 32 + (swz % 64) / 2; }
__host__ __device__ __forceinline__ int perm32(int rho) { const int n = rho >> 4, i = rho & 15; return 8 * (i >> 2) + 4 * n + (i & 3); }

struct Unit { int pm, pn; };
struct Gemm { const bf16_t* A; const bf16_t* Bt; int M, N, K; };

struct StaticOrder {
    int nM, nN, nwg, G, c;
    __host__ __device__ void init(int M, int N, int G_, int c_) { nM = M / BM; nN = N / BM; nwg = nM * nN; G = G_; c = c_; }
    __host__ __device__ bool next(int i, Unit& u) const {
        const long L = (long)i * G + c; if (L >= nwg) return false;
        int wgid = (int)L; { const int q = nwg / NXCD, r = nwg % NXCD, xcd = wgid % NXCD, off = wgid / NXCD; wgid = (xcd < r ? xcd * (q + 1) : r * (q + 1) + (xcd - r) * q) + off; }
        const int nig = WGM * nN, gid = wgid / nig, fm = gid * WGM, gsz = (nM - fm) < WGM ? (nM - fm) : WGM;
        u.pm = fm + ((wgid % nig) % gsz); u.pn = (wgid % nig) / gsz; return true;
    }
    __device__ __forceinline__ void a_ready(const Unit&) const {}
    __device__ __forceinline__ void done(const Unit&) const {}
};

__device__ __forceinline__ unsigned cvt_pk_bf16(float lo, float hi) { unsigned r; asm volatile("v_cvt_pk_bf16_f32 %0, %1, %2" : "=v"(r) : "v"(lo), "v"(hi)); return r; }
typedef float f32x2 __attribute__((ext_vector_type(2)));
__device__ __forceinline__ float rs_of(float ss) { return rsqrtf(ss * (1.0f / 1024.0f) + 1e-6f); }
struct EpiSwiGLU {
    static constexpr bool PERM = true, AFTER_DRAIN = false;
    bf16_t* H; int ldh; const float* ss;
    __device__ __forceinline__ void operator()(const f32x4 (&acc)[2][2][4][2], const Unit& u, int wr, int wc, int fr, int fq) const {
        const int row0 = u.pm * BM + wr * 64 + fr, col0 = u.pn * HALF + wc * 32 + 8 * fq;
#pragma unroll
        for (int ai = 0; ai < 2; ++ai)
#pragma unroll
            for (int m = 0; m < 4; ++m) {
                const int row = row0 + ai * HALF + m * 16; const float rs = rs_of(ss[row]);
                unsigned ww[4];
#pragma unroll
                for (int n = 0; n < 2; ++n) { const f32x4 g = acc[ai][0][m][n] * rs, up = acc[ai][1][m][n] * rs; f32x4 hh;
#pragma unroll
                    for (int e = 0; e < 4; ++e) hh[e] = g[e] * __builtin_amdgcn_rcpf(1.0f + __builtin_amdgcn_exp2f(-1.4426950408889634f * g[e])) * up[e];
                    ww[2 * n] = cvt_pk_bf16(hh[0], hh[1]); ww[2 * n + 1] = cvt_pk_bf16(hh[2], hh[3]); }
                *(u32x4*)(H + (size_t)row * ldh + col0) = (u32x4){ww[0], ww[1], ww[2], ww[3]};
            }
    }
};
struct EpiResid {
    static constexpr bool PERM = true, AFTER_DRAIN = false;
    const float* xold; float* xout; bf16_t* xb; float* ssq; float alpha;
    __device__ __forceinline__ void operator()(const f32x4 (&acc)[2][2][4][2], const Unit& u, int wr, int wc, int fr, int fq) const {
        const int row0 = u.pm * BM + wr * 64 + fr, colb = u.pn * BM + wc * 32 + 8 * fq;
#pragma unroll
        for (int ai = 0; ai < 2; ++ai)
#pragma unroll
            for (int m = 0; m < 4; ++m) {
                const int row = row0 + ai * HALF + m * 16; float s = 0.f;
#pragma unroll
                for (int bj = 0; bj < 2; ++bj) { const size_t off = (size_t)row * 1024 + colb + bj * HALF;
                    const f32x4 o0 = *(const f32x4*)(xold + off), o1 = *(const f32x4*)(xold + off + 4);
                    const f32x4 v0 = o0 + acc[ai][bj][m][0] * alpha, v1 = o1 + acc[ai][bj][m][1] * alpha;
                    *(f32x4*)(xout + off) = v0; *(f32x4*)(xout + off + 4) = v1;
                    *(u32x4*)(xb + off) = (u32x4){cvt_pk_bf16(v0[0], v0[1]), cvt_pk_bf16(v0[2], v0[3]), cvt_pk_bf16(v1[0], v1[1]), cvt_pk_bf16(v1[2], v1[3])};
                    s += (v0[0] * v0[0] + v0[1] * v0[1]) + (v0[2] * v0[2] + v0[3] * v0[3]) + (v1[0] * v1[0] + v1[1] * v1[1]) + (v1[2] * v1[2] + v1[3] * v1[3]); }
                s += __shfl_xor(s, 16); s += __shfl_xor(s, 32);
                if (fq == 0) __hip_atomic_fetch_add(ssq + row, s, __ATOMIC_RELAXED, __HIP_MEMORY_SCOPE_AGENT);
            }
    }
};
struct EpiScaleBf16 {
    static constexpr bool PERM = true, AFTER_DRAIN = false;
    bf16_t* O; int ldc; const float* ss;
    __device__ __forceinline__ void operator()(const f32x4 (&acc)[2][2][4][2], const Unit& u, int wr, int wc, int fr, int fq) const {
        const int row0 = u.pm * BM + wr * 64 + fr, colb = u.pn * BM + wc * 32 + 8 * fq;
#pragma unroll
        for (int ai = 0; ai < 2; ++ai)
#pragma unroll
            for (int m = 0; m < 4; ++m) {
                const int row = row0 + ai * HALF + m * 16; const float rs = ss ? rs_of(ss[row]) : 1.0f;
#pragma unroll
                for (int bj = 0; bj < 2; ++bj) { const f32x4 v0 = acc[ai][bj][m][0] * rs, v1 = acc[ai][bj][m][1] * rs;
                    *(u32x4*)(O + (size_t)row * ldc + colb + bj * HALF) = (u32x4){cvt_pk_bf16(v0[0], v0[1]), cvt_pk_bf16(v0[2], v0[3]), cvt_pk_bf16(v1[0], v1[1]), cvt_pk_bf16(v1[2], v1[3])}; }
            }
    }
};
struct EpiPle {
    static constexpr bool PERM = true, AFTER_DRAIN = false;
    const float* xold; float* out; const bf16_t* PP; const float* ss;
    __device__ __forceinline__ void operator()(const f32x4 (&acc)[2][2][4][2], const Unit& u, int wr, int wc, int fr, int fq) const {
        const int row0 = u.pm * BM + wr * 64 + fr, colb = u.pn * BM + wc * 32 + 8 * fq;
#pragma unroll
        for (int ai = 0; ai < 2; ++ai)
#pragma unroll
            for (int m = 0; m < 4; ++m) {
                const int row = row0 + ai * HALF + m * 16; const float rs = rs_of(ss[row]) * -1.4426950408889634f;
#pragma unroll
                for (int bj = 0; bj < 2; ++bj) { const size_t off = (size_t)row * 1024 + colb + bj * HALF;
                    const f32x4 o0 = *(const f32x4*)(xold + off), o1 = *(const f32x4*)(xold + off + 4); const u32x4 pw = *(const u32x4*)(PP + off);
                    f32x4 p0, p1; p0[0] = __uint_as_float(pw[0] << 16); p0[1] = __uint_as_float(pw[0] & 0xffff0000u); p0[2] = __uint_as_float(pw[1] << 16); p0[3] = __uint_as_float(pw[1] & 0xffff0000u);
                    p1[0] = __uint_as_float(pw[2] << 16); p1[1] = __uint_as_float(pw[2] & 0xffff0000u); p1[2] = __uint_as_float(pw[3] << 16); p1[3] = __uint_as_float(pw[3] & 0xffff0000u);
                    f32x4 v0, v1;
#pragma unroll
                    for (int e = 0; e < 4; ++e) { v0[e] = o0[e] + __builtin_amdgcn_rcpf(1.0f + __builtin_amdgcn_exp2f(acc[ai][bj][m][0][e] * rs)) * p0[e];
                                                  v1[e] = o1[e] + __builtin_amdgcn_rcpf(1.0f + __builtin_amdgcn_exp2f(acc[ai][bj][m][1][e] * rs)) * p1[e]; }
                    *(f32x4*)(out + off) = v0; *(f32x4*)(out + off + 4) = v1; }
            }
    }
};
template <class Epi, class Sched, bool ALIGN_EPI = false, bool SP2 = false>
__device__ __forceinline__ void gemm_phase(PG8_LAS unsigned char* lds, const Gemm g, const Sched& S, const Epi& E) {
    const int tid = threadIdx.x, wid = __builtin_amdgcn_readfirstlane(tid >> 6), lane = tid & 63, wr = wid >> 2, wc = wid & 3, fr = lane & 15, fq = lane >> 4;
    const int K = g.K, nt = K / BK;
    unsigned voffA[2], voffB[2];
#pragma unroll
    for (int i = 0; i < 2; ++i) { int R, C; stage_rc(tid * 16 + i * 8192, R, C); const int Rb = Epi::PERM ? ((R & ~31) + perm32(R & 31)) : R;
        voffA[i] = (unsigned)(R * K + C) * 2u; voffB[i] = (unsigned)(Rb * K + C) * 2u; }
    const size_t kstep = (size_t)(BK * 2);
    const size_t hstep = (size_t)HALF * K * 2;
    const size_t tstep = 2 * hstep;
    const unsigned ldsw = (unsigned)wid * 1024u;
    const int aoff = lds_byte(wr * 64 + fr, fq * 8), boff = lds_byte(wc * 32 + fr, fq * 8);
#define PG8_SA(b, h) (((b) * 2 + (h)) * HTB)
#define PG8_SB(b, h) ((4 + (b) * 2 + (h)) * HTB)
#define PG8_STAGE(bufoff, gbase, voff) do { _Pragma("unroll") for (int _i = 0; _i < 2; ++_i) \
        __builtin_amdgcn_global_load_lds((const unsigned*)((const char*)(gbase) + (voff)[_i]), (PG8_LAS unsigned*)(lds + (bufoff) + ldsw + _i * 8192), 16, 0, 0); } while (0)
#define PG8_LDA(dst, b, h) do { _Pragma("unroll") for (int m = 0; m < 4; ++m) _Pragma("unroll") for (int k = 0; k < 2; ++k) dst[m][k] = *(const PG8_LAS bf16x8*)(lds + PG8_SA(b, h) + aoff + m * 2048 + k * 1024); } while (0)
#define PG8_LDB(dst, b, h) do { _Pragma("unroll") for (int n = 0; n < 2; ++n) _Pragma("unroll") for (int k = 0; k < 2; ++k) dst[n][k] = *(const PG8_LAS bf16x8*)(lds + PG8_SB(b, h) + boff + n * 2048 + k * 1024); } while (0)
#define PG8_MMA(ai, bj, At, Bt) do { __builtin_amdgcn_s_setprio(1); _Pragma("unroll") for (int m = 0; m < 4; ++m) _Pragma("unroll") for (int n = 0; n < 2; ++n) _Pragma("unroll") for (int k = 0; k < 2; ++k) \
        acc[ai][bj][m][n] = __builtin_amdgcn_mfma_f32_16x16x32_bf16(Bt[n][k], At[m][k], acc[ai][bj][m][n], 0, 0, 0); __builtin_amdgcn_s_setprio(0); } while (0)
#define PG8_WAIT_V(n) asm volatile("s_waitcnt vmcnt(" #n ")" ::: "memory")
#define PG8_WAIT_L(n) asm volatile("s_waitcnt lgkmcnt(" #n ")" ::: "memory")
#define PG8_BAR __builtin_amdgcn_s_barrier()
#define PG8_SCHED __builtin_amdgcn_sched_barrier(0)
    Unit cur, nxt; int ui = 0;
    if (!S.next(0, cur)) return;
    f32x4 acc[2][2][4][2];
#pragma unroll
    for (int a = 0; a < 2; ++a)
#pragma unroll
        for (int b = 0; b < 2; ++b)
#pragma unroll
            for (int m = 0; m < 4; ++m)
#pragma unroll
                for (int n = 0; n < 2; ++n) acc[a][b][m][n] = (f32x4){0.f, 0.f, 0.f, 0.f};
    bf16x8 At[4][2], B0[2][2], B1[2][2];
    const char* cA = (const char*)g.A + (size_t)cur.pm * tstep; const char* cB = (const char*)g.Bt + (size_t)cur.pn * tstep;
    S.a_ready(cur);
    if constexpr (SP2) {
        PG8_STAGE(PG8_SB(0, 0), cB, voffB); PG8_STAGE(PG8_SB(0, 1), cB + hstep, voffB); PG8_STAGE(PG8_SA(0, 0), cA, voffA); PG8_STAGE(PG8_SA(0, 1), cA + hstep, voffA);
        if (wr == 1) PG8_BAR;
        PG8_WAIT_V(2); PG8_BAR;
        PG8_STAGE(PG8_SB(1, 0), cB + kstep, voffB); PG8_STAGE(PG8_SA(1, 0), cA + kstep, voffA); PG8_STAGE(PG8_SB(1, 1), cB + hstep + kstep, voffB);
        PG8_WAIT_V(6); PG8_BAR;
    } else {
        PG8_STAGE(PG8_SB(0, 0), cB, voffB); PG8_STAGE(PG8_SA(0, 0), cA, voffA); PG8_STAGE(PG8_SB(0, 1), cB + hstep, voffB); PG8_STAGE(PG8_SA(0, 1), cA + hstep, voffA);
        if (wr == 1) PG8_BAR;
        PG8_WAIT_V(4); PG8_BAR;
        PG8_STAGE(PG8_SB(1, 0), cB + kstep, voffB); PG8_STAGE(PG8_SA(1, 0), cA + kstep, voffA); PG8_STAGE(PG8_SB(1, 1), cB + hstep + kstep, voffB);
        PG8_WAIT_V(6); PG8_BAR;
    }
    for (;;) {
        const bool has_next = S.next(ui + 1, nxt);
        const char* nA = has_next ? (const char*)g.A + (size_t)nxt.pm * tstep : cA; const char* nB = has_next ? (const char*)g.Bt + (size_t)nxt.pn * tstep : cB;
        for (int t = 0; t < nt; t += 2) {
            const bool last = (t == nt - 2);
            const char* a1 = cA + (size_t)(t + 1) * kstep;
            const char* a2 = last ? nA : cA + (size_t)(t + 2) * kstep; const char* b2 = last ? nB : cB + (size_t)(t + 2) * kstep;
            const char* a3 = a2 + kstep; const char* b3 = b2 + kstep;
            if (last && has_next) S.a_ready(nxt);
            if constexpr (SP2) {
            PG8_LDB(B0, 0, 0); PG8_LDB(B1, 0, 1); PG8_SCHED; PG8_LDA(At, 0, 0); PG8_STAGE(PG8_SA(1, 1), a1 + hstep, voffA);
            PG8_WAIT_V(8); PG8_WAIT_L(0); PG8_BAR; PG8_MMA(0, 0, At, B0); PG8_MMA(0, 1, At, B1); PG8_BAR; PG8_SCHED;
            PG8_LDA(At, 0, 1); PG8_STAGE(PG8_SB(0, 0), b2, voffB); PG8_STAGE(PG8_SB(0, 1), b2 + hstep, voffB); PG8_STAGE(PG8_SA(0, 0), a2, voffA);
            PG8_WAIT_V(8); PG8_WAIT_L(0); PG8_BAR; PG8_MMA(1, 0, At, B0); PG8_MMA(1, 1, At, B1); PG8_BAR; PG8_SCHED;
            PG8_LDB(B0, 1, 0); PG8_LDB(B1, 1, 1); PG8_SCHED; PG8_LDA(At, 1, 0); PG8_STAGE(PG8_SA(0, 1), a2 + hstep, voffA);
            PG8_WAIT_V(8); PG8_WAIT_L(0); PG8_BAR; PG8_MMA(0, 0, At, B0); PG8_MMA(0, 1, At, B1); PG8_BAR; PG8_SCHED;
            PG8_LDA(At, 1, 1); PG8_STAGE(PG8_SB(1, 0), b3, voffB); PG8_STAGE(PG8_SB(1, 1), b3 + hstep, voffB); PG8_STAGE(PG8_SA(1, 0), a3, voffA);
            PG8_WAIT_V(8); PG8_WAIT_L(0); PG8_BAR; PG8_MMA(1, 0, At, B0); PG8_MMA(1, 1, At, B1); PG8_BAR; PG8_SCHED;
            } else {
            PG8_LDB(B0, 0, 0); PG8_SCHED; PG8_LDA(At, 0, 0); PG8_STAGE(PG8_SA(1, 1), a1 + hstep, voffA);
            PG8_WAIT_L(8); PG8_BAR; PG8_WAIT_L(0); PG8_MMA(0, 0, At, B0); PG8_BAR; PG8_SCHED;
            PG8_LDB(B1, 0, 1); PG8_STAGE(PG8_SB(0, 0), b2, voffB);
            PG8_BAR; PG8_WAIT_L(0); PG8_MMA(0, 1, At, B1); PG8_BAR;
            PG8_LDA(At, 0, 1); PG8_STAGE(PG8_SA(0, 0), a2, voffA);
            PG8_BAR; PG8_WAIT_L(0); PG8_MMA(1, 0, At, B0); PG8_BAR; PG8_SCHED;
            PG8_STAGE(PG8_SB(0, 1), b2 + hstep, voffB);
            PG8_WAIT_V(6); PG8_BAR; PG8_MMA(1, 1, At, B1); PG8_BAR;
            PG8_LDB(B0, 1, 0); PG8_SCHED; PG8_LDA(At, 1, 0); PG8_STAGE(PG8_SA(0, 1), a2 + hstep, voffA);
            PG8_WAIT_L(8); PG8_BAR; PG8_WAIT_L(0); PG8_MMA(0, 0, At, B0); PG8_BAR; PG8_SCHED;
            PG8_LDB(B1, 1, 1); PG8_STAGE(PG8_SB(1, 0), b3, voffB);
            PG8_BAR; PG8_WAIT_L(0); PG8_MMA(0, 1, At, B1); PG8_BAR;
            PG8_LDA(At, 1, 1); PG8_STAGE(PG8_SA(1, 0), a3, voffA);
            PG8_BAR; PG8_WAIT_L(0); PG8_MMA(1, 0, At, B0); PG8_BAR; PG8_SCHED;
            PG8_STAGE(PG8_SB(1, 1), b3 + hstep, voffB);
            PG8_WAIT_V(6); PG8_BAR; PG8_MMA(1, 1, At, B1); PG8_BAR;
            }
        }
        if constexpr (ALIGN_EPI) { if (wr == 0) PG8_BAR; }
        if constexpr (!Epi::AFTER_DRAIN) { E(acc, cur, wr, wc, fr, fq); S.done(cur); }
        if (!has_next) break;
#pragma unroll
        for (int a = 0; a < 2; ++a)
#pragma unroll
            for (int b = 0; b < 2; ++b)
#pragma unroll
                for (int m = 0; m < 4; ++m)
#pragma unroll
                    for (int n = 0; n < 2; ++n) acc[a][b][m][n] = (f32x4){0.f, 0.f, 0.f, 0.f};
        cur = nxt; cA = nA; cB = nB; ++ui;
        if constexpr (ALIGN_EPI) { if (wr == 1) PG8_BAR; }
    }
    PG8_WAIT_V(0);
    if constexpr (!ALIGN_EPI) { if (wr == 0) PG8_BAR; }
    PG8_BAR;
    if constexpr (Epi::AFTER_DRAIN) { E.fused(acc, cur, wr, wc, fr, fq, lds, wid, lane); S.done(cur); }
#undef PG8_SA
#undef PG8_SB
#undef PG8_STAGE
#undef PG8_LDA
#undef PG8_LDB
#undef PG8_MMA
#undef PG8_WAIT_V
#undef PG8_WAIT_L
#undef PG8_BAR
#undef PG8_SCHED
}
}

constexpr int NWAVES = 8;
constexpr int BATCH = 4, SEQ = 8192, D = 1024, FF = 2816, NPROJ = 3072, PLE = 256, NH = 8, HD = 64, CONVD = 512;
constexpr int M = BATCH * SEQ;
#ifndef MK_ONE_LAUNCH
#define MK_ONE_LAUNCH 0
#endif
constexpr int N_PHASES = 10;
constexpr size_t MiB = 1u << 20;
constexpr size_t WS_CTL = 0, CTL_ZERO_BYTES = 1 * MiB;
constexpr size_t WS_W1GU = 2 * MiB, WS_W1D = 13 * MiB, WS_WIN = 19 * MiB, WS_WOUT = 25 * MiB, WS_W2GU = 27 * MiB, WS_W2D = 38 * MiB, WS_WPG = 44 * MiB, WS_WPP = 46 * MiB;
constexpr size_t WS_XB = 48 * MiB;
constexpr size_t WS_PB = 112 * MiB;
constexpr size_t WS_HID = 128 * MiB;
constexpr size_t WS_YMIX = 320 * MiB;
constexpr size_t WS_PP = 384 * MiB;
constexpr size_t WS_END = 448 * MiB;
constexpr int LDS_BYTES = 147456;

#define GAS __attribute__((address_space(1)))
#define LAS __attribute__((address_space(3)))
typedef unsigned short bf16;
typedef unsigned v4u __attribute__((ext_vector_type(4)));
typedef float f32x4 __attribute__((ext_vector_type(4)));
#define LDS_WAIT() asm volatile("s_waitcnt lgkmcnt(0)" ::: "memory")
__device__ __forceinline__ unsigned pk2(float lo, float hi) { return pg8::cvt_pk_bf16(lo, hi); }
__device__ __forceinline__ float bflo(unsigned w) { return __uint_as_float(w << 16); }
__device__ __forceinline__ float bfhi(unsigned w) { return __uint_as_float(w & 0xffff0000u); }
__device__ __forceinline__ float wave_sum(float v) {
#pragma unroll
    for (int o = 1; o < 64; o <<= 1) v += __shfl_xor(v, o);
    return v;
}

struct Args { const float* in[20]; float* out; unsigned char* ws; int ph_lo, ph_hi; };

__device__ __forceinline__ void tr_item(const float* W, int K, int N, const float* gain, bf16* WT, int dst_row0, LAS float* scr, int k0, int n0, int lane) {
#pragma unroll 8
    for (int i = 0; i < 32; ++i) { const int kk = 2 * i + (lane >> 5); float w = W[(size_t)(k0 + kk) * N + n0 + (lane & 31)]; if (gain) w *= gain[k0 + kk]; scr[kk * 33 + (lane & 31)] = w; }
    LDS_WAIT(); asm volatile("" ::: "memory");
    const int c = lane & 7;
#pragma unroll
    for (int j = 0; j < 4; ++j) { const int n = (lane >> 3) + 8 * j; const LAS float* s = scr + (8 * c) * 33 + n;
        v4u o; o.x = pk2(s[0 * 33], s[1 * 33]); o.y = pk2(s[2 * 33], s[3 * 33]); o.z = pk2(s[4 * 33], s[5 * 33]); o.w = pk2(s[6 * 33], s[7 * 33]);
        *(v4u*)(WT + (size_t)(dst_row0 + n) * K + k0 + 8 * c) = o; }
    LDS_WAIT(); asm volatile("" ::: "memory");
}
__device__ __forceinline__ bool tr_matrix(int& r, const float* W, int K, int N, const float* gain, bf16* WT, int mode, LAS float* scr, int lane) {
    const int nblk = N / 32, items = (K / 64) * nblk;
    if (r >= items) { r -= items; return false; }
    const int kb = r / nblk, nb = r % nblk, n0 = 32 * nb;
    const int dst = mode == 0 ? n0 : (256 * (n0 >> 7) + (n0 & 127) + (mode == 2 ? 128 : 0));
    tr_item(W, K, N, gain, WT, dst, scr, 64 * kb, n0, lane);
    return true;
}
__device__ __forceinline__ void p0_prep(const Args& a, LAS unsigned char* lds, int gw, int NGW, int lane, int wave) {
    unsigned char* ws = a.ws;
    LAS float* scr = (LAS float*)(lds + wave * 16384);
    constexpr int I_GU = (D / 64) * (FF / 32), I_DN = (FF / 64) * (D / 32), I_IN = (D / 64) * (NPROJ / 32), I_SQ = (D / 64) * (D / 32), I_PP = (PLE / 64) * (D / 32);
    constexpr int NITEMS = 4 * I_GU + 2 * I_DN + I_IN + 2 * I_SQ + I_PP;
    for (int it = gw; it < NITEMS; it += NGW) {
        int r = it;
        if (tr_matrix(r, a.in[3], D, FF, a.in[2], (bf16*)(ws + WS_W1GU), 1, scr, lane)) continue;
        if (tr_matrix(r, a.in[4], D, FF, a.in[2], (bf16*)(ws + WS_W1GU), 2, scr, lane)) continue;
        if (tr_matrix(r, a.in[14], D, FF, a.in[13], (bf16*)(ws + WS_W2GU), 1, scr, lane)) continue;
        if (tr_matrix(r, a.in[15], D, FF, a.in[13], (bf16*)(ws + WS_W2GU), 2, scr, lane)) continue;
        if (tr_matrix(r, a.in[5], FF, D, nullptr, (bf16*)(ws + WS_W1D), 0, scr, lane)) continue;
        if (tr_matrix(r, a.in[16], FF, D, nullptr, (bf16*)(ws + WS_W2D), 0, scr, lane)) continue;
        if (tr_matrix(r, a.in[7], D, NPROJ, a.in[6], (bf16*)(ws + WS_WIN), 0, scr, lane)) continue;
        if (tr_matrix(r, a.in[12], D, D, nullptr, (bf16*)(ws + WS_WOUT), 0, scr, lane)) continue;
        if (tr_matrix(r, a.in[18], D, D, a.in[17], (bf16*)(ws + WS_WPG), 0, scr, lane)) continue;
        tr_matrix(r, a.in[19], PLE, D, nullptr, (bf16*)(ws + WS_WPP), 0, scr, lane);
    }
    const float* x = a.in[0]; bf16* XB = (bf16*)(ws + WS_XB); float* ss1 = (float*)(ws + WS_CTL);
    for (int m = gw; m < M; m += NGW) {
        const f32x4* xr = (const f32x4*)(x + (size_t)m * D) + lane; f32x4 v[4]; float s = 0.f;
#pragma unroll
        for (int j = 0; j < 4; ++j) { v[j] = xr[64 * j]; s += (v[j].x * v[j].x + v[j].y * v[j].y) + (v[j].z * v[j].z + v[j].w * v[j].w); }
        s = wave_sum(s);
        unsigned long long* o8 = (unsigned long long*)(XB + (size_t)m * D) + lane;
#pragma unroll
        for (int j = 0; j < 4; ++j) o8[64 * j] = (unsigned long long)pk2(v[j].x, v[j].y) | ((unsigned long long)pk2(v[j].z, v[j].w) << 32);
        if (lane == 0) ss1[m] = s;
    }
    const float* p = a.in[1]; bf16* PB = (bf16*)(ws + WS_PB);
    for (int i = gw * 64 + lane; i < M * PLE / 8; i += NGW * 64) {
        const f32x4 v0 = *(const f32x4*)(p + (size_t)i * 8), v1 = *(const f32x4*)(p + (size_t)i * 8 + 4);
        *(v4u*)(PB + (size_t)i * 8) = (v4u){pk2(v0.x, v0.y), pk2(v0.z, v0.w), pk2(v1.x, v1.y), pk2(v1.z, v1.w)};
    }
}

__device__ __forceinline__ void unpack8(const v4u w, float (&f)[8]) { f[0] = bflo(w.x); f[1] = bfhi(w.x); f[2] = bflo(w.y); f[3] = bfhi(w.y); f[4] = bflo(w.z); f[5] = bfhi(w.z); f[6] = bflo(w.w); f[7] = bfhi(w.w); }
__device__ __forceinline__ v4u pack8(const float (&f)[8]) { return (v4u){pk2(f[0], f[1]), pk2(f[2], f[3]), pk2(f[4], f[5]), pk2(f[6], f[7])}; }
__device__ __forceinline__ void p4_mixprep(const Args& a, int gw, int NGW, int lane) {
    bf16* PROJ = (bf16*)(a.ws + WS_HID); bf16* YMIX = (bf16*)(a.ws + WS_YMIX);
    const float* cw = a.in[8]; const float* cbp = a.in[9]; const float* gq = a.in[10]; const float* gk = a.in[11];
    float w0[8], w1[8], w2[8], cb[8], gqv[8], gkv[8];
#pragma unroll
    for (int i = 0; i < 8; ++i) { w0[i] = cw[8 * lane + i]; w1[i] = cw[CONVD + 8 * lane + i]; w2[i] = cw[2 * CONVD + 8 * lane + i]; cb[i] = cbp[8 * lane + i];
        gqv[i] = gq[(lane & 7) * 8 + i] * 0.125f; gkv[i] = gk[(lane & 7) * 8 + i]; }
    for (int ch = gw; ch < M / 16; ch += NGW) {
        const int r0 = ch * 16; float z1[8], z2[8];
        if ((r0 & (SEQ - 1)) == 0) {
#pragma unroll
            for (int i = 0; i < 8; ++i) { z1[i] = 0.f; z2[i] = 0.f; }
        } else {
            float c[8], u[8];
            const bf16* pr = PROJ + (size_t)(r0 - 1) * NPROJ + 8 * lane; unpack8(*(const v4u*)(pr + 512), c); unpack8(*(const v4u*)(pr + 1024), u);
#pragma unroll
            for (int i = 0; i < 8; ++i) z1[i] = c[i] * u[i];
            pr -= NPROJ; unpack8(*(const v4u*)(pr + 512), c); unpack8(*(const v4u*)(pr + 1024), u);
#pragma unroll
            for (int i = 0; i < 8; ++i) z2[i] = c[i] * u[i];
        }
        for (int r = r0; r < r0 + 16; ++r) {
            bf16* pr = PROJ + (size_t)r * NPROJ + 8 * lane;
            float b[8], c[8], u[8], q[8], k[8], y[8];
            unpack8(*(const v4u*)(pr), b); unpack8(*(const v4u*)(pr + 512), c); unpack8(*(const v4u*)(pr + 1024), u);
            unpack8(*(const v4u*)(pr + 1536), q); unpack8(*(const v4u*)(pr + 2048), k);
#pragma unroll
            for (int i = 0; i < 8; ++i) { const float z0 = c[i] * u[i]; y[i] = b[i] * (w0[i] * z2[i] + w1[i] * z1[i] + w2[i] * z0 + cb[i]); z2[i] = z1[i]; z1[i] = z0; }
            *(v4u*)(YMIX + (size_t)r * D + 8 * lane) = pack8(y);
            float sq = 0.f, sk = 0.f;
#pragma unroll
            for (int i = 0; i < 8; ++i) { sq += q[i] * q[i]; sk += k[i] * k[i]; }
            sq += __shfl_xor(sq, 1); sq += __shfl_xor(sq, 2); sq += __shfl_xor(sq, 4);
            sk += __shfl_xor(sk, 1); sk += __shfl_xor(sk, 2); sk += __shfl_xor(sk, 4);
            const float rq = rsqrtf(sq * (1.0f / 64.0f) + 1e-6f), rk = rsqrtf(sk * (1.0f / 64.0f) + 1e-6f);
#pragma unroll
            for (int i = 0; i < 8; ++i) { q[i] *= rq * gqv[i]; k[i] *= rk * gkv[i]; }
            *(v4u*)(pr + 1536) = pack8(q); *(v4u*)(pr + 2048) = pack8(k);
        }
    }
}

__device__ __forceinline__ void p5_attn_naive(const Args& a, int tid) {
    const bf16* PROJ = (const bf16*)(a.ws + WS_HID); bf16* YMIX = (bf16*)(a.ws + WS_YMIX);
    for (int un = blockIdx.x; un < 512; un += gridDim.x) {
        const int bh = un & 31, r = un >> 5, qq = r < 8 ? r : 23 - r, b = bh >> 3, h = bh & 7;
        const int t = qq * 512 + tid;
        const bf16* base = PROJ + (size_t)b * SEQ * NPROJ + h * HD;
        float q[64], o[64];
#pragma unroll
        for (int c = 0; c < 8; ++c) { float f[8]; unpack8(*(const v4u*)(base + (size_t)t * NPROJ + 1536 + 8 * c), f);
#pragma unroll
            for (int e = 0; e < 8; ++e) { q[8 * c + e] = f[e]; o[8 * c + e] = 0.f; } }
        float carry = 0.f;
        for (int j = qq * 512 + 511; j >= 0; --j) {
            const bf16* kr = base + (size_t)j * NPROJ + 2048; float z = 0.f;
#pragma unroll
            for (int c = 0; c < 8; ++c) { float f[8]; unpack8(*(const v4u*)(kr + 8 * c), f);
#pragma unroll
                for (int e = 0; e < 8; ++e) z += q[8 * c + e] * f[e]; }
            const bool act = j < t;
            const float sp = fmaxf(z, 0.f) + __logf(1.0f + __expf(-fabsf(z)));
            const float av = act ? __expf(z - sp + carry) : 0.f;
            carry -= act ? sp : 0.f;
            const bf16* vr = kr + 512;
#pragma unroll
            for (int c = 0; c < 8; ++c) { float f[8]; unpack8(*(const v4u*)(vr + 8 * c), f);
#pragma unroll
                for (int e = 0; e < 8; ++e) o[8 * c + e] += av * f[e]; }
        }
        bf16* orow = YMIX + (size_t)(b * SEQ + t) * D + 512 + h * HD;
#pragma unroll
        for (int c = 0; c < 8; ++c) { float f[8];
#pragma unroll
            for (int e = 0; e < 8; ++e) f[e] = o[8 * c + e];
            *(v4u*)(orow + 8 * c) = pack8(f); }
    }
}

__global__ void __launch_bounds__(NWAVES * 64, 2) mk_fwd(Args args) {
    extern __shared__ __attribute__((aligned(16))) unsigned char lds_raw[];
    LAS unsigned char* lds = (LAS unsigned char*)lds_raw;
    const int tid = threadIdx.x, lane = tid & 63, wave = __builtin_amdgcn_readfirstlane(tid >> 6);
    const int G = gridDim.x, gw = blockIdx.x * NWAVES + wave, NGW = G * NWAVES;
    unsigned char* ws = args.ws;
    float* ss1 = (float*)(ws + WS_CTL); float* ss2 = ss1 + M; float* ss3 = ss2 + M; float* ss4 = ss3 + M;
    bf16* XB = (bf16*)(ws + WS_XB); bf16* PB = (bf16*)(ws + WS_PB); bf16* HID = (bf16*)(ws + WS_HID); bf16* PROJ = HID; bf16* YMIX = (bf16*)(ws + WS_YMIX); bf16* PP = (bf16*)(ws + WS_PP);
    const int lo = args.ph_lo, hi = args.ph_hi;
#define IN(k) (lo <= (k) && (k) < hi)
#define SEAM(k) do { if (IN(k) && IN((k) + 1)) { cg::this_grid().sync(); } } while (0)
    typedef pg8::StaticOrder SO;
    if (IN(0)) { p0_prep(args, lds, gw, NGW, lane, wave); } SEAM(0);
    if (IN(1)) {
        { pg8::Gemm g{XB, (const bf16*)(ws + WS_W1GU), M, 2 * FF, D}; SO S; S.init(M, 2 * FF, G, (int)blockIdx.x); pg8::EpiSwiGLU E{HID, FF, ss1};
          pg8::gemm_phase<pg8::EpiSwiGLU, SO, true, true>(lds, g, S, E); }
        { pg8::Gemm g{PB, (const bf16*)(ws + WS_WPP), M, D, PLE}; SO S; S.init(M, D, G, (int)blockIdx.x); pg8::EpiScaleBf16 E{PP, D, nullptr};
          pg8::gemm_phase<pg8::EpiScaleBf16, SO, true, true>(lds, g, S, E); }
    } SEAM(1);
    if (IN(2)) { pg8::Gemm g{HID, (const bf16*)(ws + WS_W1D), M, D, FF}; SO S; S.init(M, D, G, (int)blockIdx.x); pg8::EpiResid E{args.in[0], args.out, XB, ss2, 0.5f};
        pg8::gemm_phase<pg8::EpiResid, SO, true, true>(lds, g, S, E); } SEAM(2);
    if (IN(3)) { pg8::Gemm g{XB, (const bf16*)(ws + WS_WIN), M, NPROJ, D}; SO S; S.init(M, NPROJ, G, (int)blockIdx.x); pg8::EpiScaleBf16 E{PROJ, NPROJ, ss2};
        pg8::gemm_phase<pg8::EpiScaleBf16, SO, true, true>(lds, g, S, E); } SEAM(3);
    if (IN(4)) { p4_mixprep(args, gw, NGW, lane); } SEAM(4);
    if (IN(5)) { p5_attn_naive(args, tid); } SEAM(5);
    if (IN(6)) { pg8::Gemm g{YMIX, (const bf16*)(ws + WS_WOUT), M, D, D}; SO S; S.init(M, D, G, (int)blockIdx.x); pg8::EpiResid E{args.out, args.out, XB, ss3, 1.0f};
        pg8::gemm_phase<pg8::EpiResid, SO, true, true>(lds, g, S, E); } SEAM(6);
    if (IN(7)) { pg8::Gemm g{XB, (const bf16*)(ws + WS_W2GU), M, 2 * FF, D}; SO S; S.init(M, 2 * FF, G, (int)blockIdx.x); pg8::EpiSwiGLU E{HID, FF, ss3};
        pg8::gemm_phase<pg8::EpiSwiGLU, SO, true, true>(lds, g, S, E); } SEAM(7);
    if (IN(8)) { pg8::Gemm g{HID, (const bf16*)(ws + WS_W2D), M, D, FF}; SO S; S.init(M, D, G, (int)blockIdx.x); pg8::EpiResid E{args.out, args.out, XB, ss4, 0.5f};
        pg8::gemm_phase<pg8::EpiResid, SO, true, true>(lds, g, S, E); } SEAM(8);
    if (IN(9)) { pg8::Gemm g{XB, (const bf16*)(ws + WS_WPG), M, D, D}; SO S; S.init(M, D, G, (int)blockIdx.x); pg8::EpiPle E{args.out, args.out, PP, ss4};
        pg8::gemm_phase<pg8::EpiPle, SO, true, true>(lds, g, S, E); }
#undef IN
#undef SEAM
}

extern "C" void kernel_launch(void* const* d_in, const int* in_sizes, int n_in, void* d_out, int out_size, void* d_ws, size_t ws_size, hipStream_t stream) {
    static int grid = 0;
    if (grid == 0) {
        if (n_in != 20 || out_size != M * D || ws_size < WS_END) { fprintf(stderr, "kernel_launch: unexpected shapes (n_in %d out %d ws %zu)\n", n_in, out_size, ws_size); grid = -1; return; }
        int dev = 0, cus = 0, per_cu = 0;
        if (hipGetDevice(&dev) != hipSuccess || hipDeviceGetAttribute(&cus, hipDeviceAttributeMultiprocessorCount, dev) != hipSuccess) { grid = -1; return; }
        if (hipFuncSetAttribute((const void*)mk_fwd, hipFuncAttributeMaxDynamicSharedMemorySize, LDS_BYTES) != hipSuccess) { fprintf(stderr, "kernel_launch: hipFuncSetAttribute failed\n"); grid = -1; return; }
        if (hipOccupancyMaxActiveBlocksPerMultiprocessor(&per_cu, (const void*)mk_fwd, NWAVES * 64, LDS_BYTES) != hipSuccess || per_cu < 1) { fprintf(stderr, "kernel_launch: occupancy query says %d\n", per_cu); per_cu = 1; }
        (void)hipGetLastError();
        grid = cus;
    }
    if (grid < 0) return;
    (void)hipMemsetAsync((char*)d_ws + WS_CTL, 0, CTL_ZERO_BYTES, stream);
    Args a{};
    for (int i = 0; i < 20; ++i) a.in[i] = (const float*)d_in[i];
    a.out = (float*)d_out; a.ws = (unsigned char*)d_ws;
#if MK_ONE_LAUNCH
    a.ph_lo = 0; a.ph_hi = N_PHASES;
    void* kargs[] = {&a};
    hipError_t e = hipLaunchCooperativeKernel((const void*)mk_fwd, dim3(grid), dim3(NWAVES * 64), kargs, LDS_BYTES, stream);
    if (e != hipSuccess) fprintf(stderr, "kernel_launch: cooperative launch failed: %s\n", hipGetErrorString(e));
#else
    for (int ph = 0; ph < N_PHASES; ++ph) { a.ph_lo = ph; a.ph_hi = ph + 1; hipLaunchKernelGGL(mk_fwd, dim3(grid), dim3(NWAVES * 64), LDS_BYTES, stream, a); }
#endif
}
```

```cpp
#include <hip/hip_runtime.h>
#include <hip/hip_cooperative_groups.h>
#include <cstdio>
#include <cstdint>
namespace cg = cooperative_groups;
namespace pg8 {
#define PG8_LAS __attribute__((address_space(3)))
typedef unsigned short bf16_t;
typedef short bf16x8 __attribute__((ext_vector_type(8)));
typedef float f32x4 __attribute__((ext_vector_type(4)));
typedef unsigned u32x4 __attribute__((ext_vector_type(4)));
constexpr int BM = 256, BK = 64, HALF = 128, HTB = HALF * BK * 2  , STAGE_BYTES = 8 * HTB, NXCD = 8, WGM = 8;

__host__ __device__ __forceinline__ int lds_byte(int r, int c) { const int st = (r >> 4) * 2 + (c >> 5), rr = r & 15, cc = c & 31, ob = rr * 64 + cc * 2; return st * 1024 + (ob ^ (((ob >> 9) & 1) << 5)); }
__host__ __device__ __forceinline__ void stage_rc(int b, int& R, int& C) { const int st = b / 1024, sb = b % 1024, swz = sb ^ (((sb >> 9) & 1) << 5); R = (st >> 1) * 16 + swz / 64; C = (st & 1) * 32 + (swz % 64) / 2; }
__host__ __device__ __forceinline__ int perm32(int rho) { const int n = rho >> 4, i = rho & 15; return 8 * (i >> 2) + 4 * n + (i & 3); }

struct Unit { int pm, pn; };
struct Gemm { const bf16_t* A; const bf16_t* Bt; int M, N, K; };

struct StaticOrder {
    int nM, nN, nwg, G, c;
    __host__ __device__ void init(int M, int N, int G_, int c_) { nM = M / BM; nN = N / BM; nwg = nM * nN; G = G_; c = c_; }
    __host__ __device__ bool next(int i, Unit& u) const {
        const long L = (long)i * G + c; if (L >= nwg) return false;
        int wgid = (int)L; { const int q = nwg / NXCD, r = nwg % NXCD, xcd = wgid % NXCD, off = wgid / NXCD; wgid = (xcd < r ? xcd * (q + 1) : r * (q + 1) + (xcd - r) * q) + off; }
        const int nig = WGM * nN, gid = wgid / nig, fm = gid * WGM, gsz = (nM - fm) < WGM ? (nM - fm) : WGM;
        u.pm = fm + ((wgid % nig) % gsz); u.pn = (wgid % nig) / gsz; return true;
    }
    __device__ __forceinline__ void a_ready(const Unit&) const {}
    __device__ __forceinline__ void done(const Unit&) const {}
};

__device__ __forceinline__ unsigned cvt_pk_bf16(float lo, float hi) { unsigned r; asm volatile("v_cvt_pk_bf16_f32 %0, %1, %2" : "=v"(r) : "v"(lo), "v"(hi)); return r; }
typedef float f32x2 __attribute__((ext_vector_type(2)));
__device__ __forceinline__ float rs_of(float ss) { return rsqrtf(ss * (1.0f / 1024.0f) + 1e-6f); }
struct EpiSwiGLU {
    static constexpr bool PERM = true, AFTER_DRAIN = false;
    bf16_t* H; int ldh; const float* ss;
    __device__ __forceinline__ void operator()(const f32x4 (&acc)[2][2][4][2], const Unit& u, int wr, int wc, int fr, int fq) const {
        const int row0 = u.pm * BM + wr * 64 + fr, col0 = u.pn * HALF + wc * 32 + 8 * fq;
#pragma unroll
        for (int ai = 0; ai < 2; ++ai)
#pragma unroll
            for (int m = 0; m < 4; ++m) {
                const int row = row0 + ai * HALF + m * 16; const float rs = rs_of(ss[row]);
                unsigned ww[4];
#pragma unroll
                for (int n = 0; n < 2; ++n) { const f32x4 g = acc[ai][0][m][n] * rs, up = acc[ai][1][m][n] * rs; f32x4 hh;
#pragma unroll
                    for (int e = 0; e < 4; ++e) hh[e] = g[e] * __builtin_amdgcn_rcpf(1.0f + __builtin_amdgcn_exp2f(-1.4426950408889634f * g[e])) * up[e];
                    ww[2 * n] = cvt_pk_bf16(hh[0], hh[1]); ww[2 * n + 1] = cvt_pk_bf16(hh[2], hh[3]); }
                *(u32x4*)(H + (size_t)row * ldh + col0) = (u32x4){ww[0], ww[1], ww[2], ww[3]};
            }
    }
};
struct EpiResid {
    static constexpr bool PERM = true, AFTER_DRAIN = false;
    const float* xold; float* xout; bf16_t* xb; float* ssq; float alpha;
    __device__ __forceinline__ void operator()(const f32x4 (&acc)[2][2][4][2], const Unit& u, int wr, int wc, int fr, int fq) const {
        const int row0 = u.pm * BM + wr * 64 + fr, colb = u.pn * BM + wc * 32 + 8 * fq;
#pragma unroll
        for (int ai = 0; ai < 2; ++ai)
#pragma unroll
            for (int m = 0; m < 4; ++m) {
                const int row = row0 + ai * HALF + m * 16; float s = 0.f;
#pragma unroll
                for (int bj = 0; bj < 2; ++bj) { const size_t off = (size_t)row * 1024 + colb + bj * HALF;
                    const f32x4 o0 = *(const f32x4*)(xold + off), o1 = *(const f32x4*)(xold + off + 4);
                    const f32x4 v0 = o0 + acc[ai][bj][m][0] * alpha, v1 = o1 + acc[ai][bj][m][1] * alpha;
                    *(f32x4*)(xout + off) = v0; *(f32x4*)(xout + off + 4) = v1;
                    *(u32x4*)(xb + off) = (u32x4){cvt_pk_bf16(v0[0], v0[1]), cvt_pk_bf16(v0[2], v0[3]), cvt_pk_bf16(v1[0], v1[1]), cvt_pk_bf16(v1[2], v1[3])};
                    s += (v0[0] * v0[0] + v0[1] * v0[1]) + (v0[2] * v0[2] + v0[3] * v0[3]) + (v1[0] * v1[0] + v1[1] * v1[1]) + (v1[2] * v1[2] + v1[3] * v1[3]); }
                s += __shfl_xor(s, 16); s += __shfl_xor(s, 32);
                if (fq == 0) __hip_atomic_fetch_add(ssq + row, s, __ATOMIC_RELAXED, __HIP_MEMORY_SCOPE_AGENT);
            }
    }
};
struct EpiScaleBf16 {
    static constexpr bool PERM = true, AFTER_DRAIN = false;
    bf16_t* O; int ldc; const float* ss;
    __device__ __forceinline__ void operator()(const f32x4 (&acc)[2][2][4][2], const Unit& u, int wr, int wc, int fr, int fq) const {
        const int row0 = u.pm * BM + wr * 64 + fr, colb = u.pn * BM + wc * 32 + 8 * fq;
#pragma unroll
        for (int ai = 0; ai < 2; ++ai)
#pragma unroll
            for (int m = 0; m < 4; ++m) {
                const int row = row0 + ai * HALF + m * 16; const float rs = ss ? rs_of(ss[row]) : 1.0f;
#pragma unroll
                for (int bj = 0; bj < 2; ++bj) { const f32x4 v0 = acc[ai][bj][m][0] * rs, v1 = acc[ai][bj][m][1] * rs;
                    *(u32x4*)(O + (size_t)row * ldc + colb + bj * HALF) = (u32x4){cvt_pk_bf16(v0[0], v0[1]), cvt_pk_bf16(v0[2], v0[3]), cvt_pk_bf16(v1[0], v1[1]), cvt_pk_bf16(v1[2], v1[3])}; }
            }
    }
};
struct EpiPle {
    static constexpr bool PERM = true, AFTER_DRAIN = false;
    const float* xold; float* out; const bf16_t* PP; const float* ss;
    __device__ __forceinline__ void operator()(const f32x4 (&acc)[2][2][4][2], const Unit& u, int wr, int wc, int fr, int fq) const {
        const int row0 = u.pm * BM + wr * 64 + fr, colb = u.pn * BM + wc * 32 + 8 * fq;
#pragma unroll
        for (int ai = 0; ai < 2; ++ai)
#pragma unroll
            for (int m = 0; m < 4; ++m) {
                const int row = row0 + ai * HALF + m * 16; const float rs = rs_of(ss[row]) * -1.4426950408889634f;
#pragma unroll
                for (int bj = 0; bj < 2; ++bj) { const size_t off = (size_t)row * 1024 + colb + bj * HALF;
                    const f32x4 o0 = *(const f32x4*)(xold + off), o1 = *(const f32x4*)(xold + off + 4); const u32x4 pw = *(const u32x4*)(PP + off);
                    f32x4 p0, p1; p0[0] = __uint_as_float(pw[0] << 16); p0[1] = __uint_as_float(pw[0] & 0xffff0000u); p0[2] = __uint_as_float(pw[1] << 16); p0[3] = __uint_as_float(pw[1] & 0xffff0000u);
                    p1[0] = __uint_as_float(pw[2] << 16); p1[1] = __uint_as_float(pw[2] & 0xffff0000u); p1[2] = __uint_as_float(pw[3] << 16); p1[3] = __uint_as_float(pw[3] & 0xffff0000u);
                    f32x4 v0, v1;
#pragma unroll
                    for (int e = 0; e < 4; ++e) { v0[e] = o0[e] + __builtin_amdgcn_rcpf(1.0f + __builtin_amdgcn_exp2f(acc[ai][bj][m][0][e] * rs)) * p0[e];
                                                  v1[e] = o1[e] + __builtin_amdgcn_rcpf(1.0f + __builtin_amdgcn_exp2f(acc[ai][bj][m][1][e] * rs)) * p1[e]; }
                    *(f32x4*)(out + off) = v0; *(f32x4*)(out + off + 4) = v1; }
            }
    }
};
template <class Epi, class Sched, bool ALIGN_EPI = false, bool SP2 = false>
__device__ __forceinline__ void gemm_phase(PG8_LAS unsigned char* lds, const Gemm g, const Sched& S, const Epi& E) {
    const int tid = threadIdx.x, wid = __builtin_amdgcn_readfirstlane(tid >> 6), lane = tid & 63, wr = wid >> 2, wc = wid & 3, fr = lane & 15, fq = lane >> 4;
    const int K = g.K, nt = K / BK;
    unsigned voffA[2], voffB[2];
#pragma unroll
    for (int i = 0; i < 2; ++i) { int R, C; stage_rc(tid * 16 + i * 8192, R, C); const int Rb = Epi::PERM ? ((R & ~31) + perm32(R & 31)) : R;
        voffA[i] = (unsigned)(R * K + C) * 2u; voffB[i] = (unsigned)(Rb * K + C) * 2u; }
    const size_t kstep = (size_t)(BK * 2);
    const size_t hstep = (size_t)HALF * K * 2;
    const size_t tstep = 2 * hstep;
    const unsigned ldsw = (unsigned)wid * 1024u;
    const int aoff = lds_byte(wr * 64 + fr, fq * 8), boff = lds_byte(wc * 32 + fr, fq * 8);
#define PG8_SA(b, h) (((b) * 2 + (h)) * HTB)
#define PG8_SB(b, h) ((4 + (b) * 2 + (h)) * HTB)
#define PG8_STAGE(bufoff, gbase, voff) do { _Pragma("unroll") for (int _i = 0; _i < 2; ++_i) \
        __builtin_amdgcn_global_load_lds((const unsigned*)((const char*)(gbase) + (voff)[_i]), (PG8_LAS unsigned*)(lds + (bufoff) + ldsw + _i * 8192), 16, 0, 0); } while (0)
#define PG8_LDA(dst, b, h) do { _Pragma("unroll") for (int m = 0; m < 4; ++m) _Pragma("unroll") for (int k = 0; k < 2; ++k) dst[m][k] = *(const PG8_LAS bf16x8*)(lds + PG8_SA(b, h) + aoff + m * 2048 + k * 1024); } while (0)
#define PG8_LDB(dst, b, h) do { _Pragma("unroll") for (int n = 0; n < 2; ++n) _Pragma("unroll") for (int k = 0; k < 2; ++k) dst[n][k] = *(const PG8_LAS bf16x8*)(lds + PG8_SB(b, h) + boff + n * 2048 + k * 1024); } while (0)
#define PG8_MMA(ai, bj, At, Bt) do { __builtin_amdgcn_s_setprio(1); _Pragma("unroll") for (int m = 0; m < 4; ++m) _Pragma("unroll") for (int n = 0; n < 2; ++n) _Pragma("unroll") for (int k = 0; k < 2; ++k) \
        acc[ai][bj][m][n] = __builtin_amdgcn_mfma_f32_16x16x32_bf16(Bt[n][k], At[m][k], acc[ai][bj][m][n], 0, 0, 0); __builtin_amdgcn_s_setprio(0); } while (0)
#define PG8_WAIT_V(n) asm volatile("s_waitcnt vmcnt(" #n ")" ::: "memory")
#define PG8_WAIT_L(n) asm volatile("s_waitcnt lgkmcnt(" #n ")" ::: "memory")
#define PG8_BAR __builtin_amdgcn_s_barrier()
#define PG8_SCHED __builtin_amdgcn_sched_barrier(0)
    Unit cur, nxt; int ui = 0;
    if (!S.next(0, cur)) return;
    f32x4 acc[2][2][4][2];
#pragma unroll
    for (int a = 0; a < 2; ++a)
#pragma unroll
        for (int b = 0; b < 2; ++b)
#pragma unroll
            for (int m = 0; m < 4; ++m)
#pragma unroll
                for (int n = 0; n < 2; ++n) acc[a][b][m][n] = (f32x4){0.f, 0.f, 0.f, 0.f};
    bf16x8 At[4][2], B0[2][2], B1[2][2];
    const char* cA = (const char*)g.A + (size_t)cur.pm * tstep; const char* cB = (const char*)g.Bt + (size_t)cur.pn * tstep;
    S.a_ready(cur);
    if constexpr (SP2) {
        PG8_STAGE(PG8_SB(0, 0), cB, voffB); PG8_STAGE(PG8_SB(0, 1), cB + hstep, voffB); PG8_STAGE(PG8_SA(0, 0), cA, voffA); PG8_STAGE(PG8_SA(0, 1), cA + hstep, voffA);
        if (wr == 1) PG8_BAR;
        PG8_WAIT_V(2); PG8_BAR;
        PG8_STAGE(PG8_SB(1, 0), cB + kstep, voffB); PG8_STAGE(PG8_SA(1, 0), cA + kstep, voffA); PG8_STAGE(PG8_SB(1, 1), cB + hstep + kstep, voffB);
        PG8_WAIT_V(6); PG8_BAR;
    } else {
        PG8_STAGE(PG8_SB(0, 0), cB, voffB); PG8_STAGE(PG8_SA(0, 0), cA, voffA); PG8_STAGE(PG8_SB(0, 1), cB + hstep, voffB); PG8_STAGE(PG8_SA(0, 1), cA + hstep, voffA);
        if (wr == 1) PG8_BAR;
        PG8_WAIT_V(4); PG8_BAR;
        PG8_STAGE(PG8_SB(1, 0), cB + kstep, voffB); PG8_STAGE(PG8_SA(1, 0), cA + kstep, voffA); PG8_STAGE(PG8_SB(1, 1), cB + hstep + kstep, voffB);
        PG8_WAIT_V(6); PG8_BAR;
    }
    for (;;) {
        const bool has_next = S.next(ui + 1, nxt);
        const char* nA = has_next ? (const char*)g.A + (size_t)nxt.pm * tstep : cA; const char* nB = has_next ? (const char*)g.Bt + (size_t)nxt.pn * tstep : cB;
        for (int t = 0; t < nt; t += 2) {
            const bool last = (t == nt - 2);
            const char* a1 = cA + (size_t)(t + 1) * kstep;
            const char* a2 = last ? nA : cA + (size_t)(t + 2) * kstep; const char* b2 = last ? nB : cB + (size_t)(t + 2) * kstep;
            const char* a3 = a2 + kstep; const char* b3 = b2 + kstep;
            if (last && has_next) S.a_ready(nxt);
            if constexpr (SP2) {
            PG8_LDB(B0, 0, 0); PG8_LDB(B1, 0, 1); PG8_SCHED; PG8_LDA(At, 0, 0); PG8_STAGE(PG8_SA(1, 1), a1 + hstep, voffA);
            PG8_WAIT_V(8); PG8_WAIT_L(0); PG8_BAR; PG8_MMA(0, 0, At, B0); PG8_MMA(0, 1, At, B1); PG8_BAR; PG8_SCHED;
            PG8_LDA(At, 0, 1); PG8_STAGE(PG8_SB(0, 0), b2, voffB); PG8_STAGE(PG8_SB(0, 1), b2 + hstep, voffB); PG8_STAGE(PG8_SA(0, 0), a2, voffA);
            PG8_WAIT_V(8); PG8_WAIT_L(0); PG8_BAR; PG8_MMA(1, 0, At, B0); PG8_MMA(1, 1, At, B1); PG8_BAR; PG8_SCHED;
            PG8_LDB(B0, 1, 0); PG8_LDB(B1, 1, 1); PG8_SCHED; PG8_LDA(At, 1, 0); PG8_STAGE(PG8_SA(0, 1), a2 + hstep, voffA);
            PG8_WAIT_V(8); PG8_WAIT_L(0); PG8_BAR; PG8_MMA(0, 0, At, B0); PG8_MMA(0, 1, At, B1); PG8_BAR; PG8_SCHED;
            PG8_LDA(At, 1, 1); PG8_STAGE(PG8_SB(1, 0), b3, voffB); PG8_STAGE(PG8_SB(1, 1), b3 + hstep, voffB); PG8_STAGE(PG8_SA(1, 0), a3, voffA);
            PG8_WAIT_V(8); PG8_WAIT_L(0); PG8_BAR; PG8_MMA(1, 0, At, B0); PG8_MMA(1, 1, At, B1); PG8_BAR; PG8_SCHED;
            } else {
            PG8_LDB(B0, 0, 0); PG8_SCHED; PG8_LDA(At, 0, 0); PG8_STAGE(PG8_SA(1, 1), a1 + hstep, voffA);
            PG8_WAIT_L(8); PG8_BAR; PG8_WAIT_L(0); PG8_MMA(0, 0, At, B0); PG8_BAR; PG8_SCHED;
            PG8_LDB(B1, 0, 1); PG8_STAGE(PG8_SB(0, 0), b2, voffB);
            PG8_BAR; PG8_WAIT_L(0); PG8_MMA(0, 1, At, B1); PG8_BAR;
            PG8_LDA(At, 0, 1); PG8_STAGE(PG8_SA(0, 0), a2, voffA);
            PG8_BAR; PG8_WAIT_L(0); PG8_MMA(1, 0, At, B0); PG8_BAR; PG8_SCHED;
            PG8_STAGE(PG8_SB(0, 1), b2 + hstep, voffB);
            PG8_WAIT_V(6); PG8_BAR; PG8_MMA(1, 1, At, B1); PG8_BAR;
            PG8_LDB(B0, 1, 0); PG8_SCHED; PG8_LDA(At, 1, 0); PG8_STAGE(PG8_SA(0, 1), a2 + hstep, voffA);
            PG8_WAIT_L(8); PG8_BAR; PG8_WAIT_L(0); PG8_MMA(0, 0, At, B0); PG8_BAR; PG8_SCHED;
            PG8_LDB(B1, 1, 1); PG8_STAGE(PG8_SB(1, 0), b3, voffB);
            PG8_BAR; PG8_WAIT_L(0); PG8_MMA(0, 1, At, B1); PG8_BAR;
            PG8_LDA(At, 1, 1); PG8_STAGE(PG8_SA(1, 0), a3, voffA);
            PG8_BAR; PG8_WAIT_L(0); PG8_MMA(1, 0, At, B0); PG8_BAR; PG8_SCHED;
            PG8_STAGE(PG8_SB(1, 1), b3 + hstep, voffB);
            PG8_WAIT_V(6); PG8_BAR; PG8_MMA(1, 1, At, B1); PG8_BAR;
            }
        }
        if constexpr (ALIGN_EPI) { if (wr == 0) PG8_BAR; }
        if constexpr (!Epi::AFTER_DRAIN) { E(acc, cur, wr, wc, fr, fq); S.done(cur); }
        if (!has_next) break;
#pragma unroll
        for (int a = 0; a < 2; ++a)
#pragma unroll
            for (int b = 0; b < 2; ++b)
#pragma unroll
                for (int m = 0; m < 4; ++m)
#pragma unroll
                    for (int n = 0; n < 2; ++n) acc[a][b][m][n] = (f32x4){0.f, 0.f, 0.f, 0.f};
        cur = nxt; cA = nA; cB = nB; ++ui;
        if constexpr (ALIGN_EPI) { if (wr == 1) PG8_BAR; }
    }
    PG8_WAIT_V(0);
    if constexpr (!ALIGN_EPI) { if (wr == 0) PG8_BAR; }
    PG8_BAR;
    if constexpr (Epi::AFTER_DRAIN) { E.fused(acc, cur, wr, wc, fr, fq, lds, wid, lane); S.done(cur); }
#undef PG8_SA
#undef PG8_SB
#undef PG8_STAGE
#undef PG8_LDA
#undef PG8_LDB
#undef PG8_MMA
#undef PG8_WAIT_V
#undef PG8_WAIT_L
#undef PG8_BAR
#undef PG8_SCHED
}
}

constexpr int NWAVES = 8;
constexpr int BATCH = 4, SEQ = 8192, D = 1024, FF = 2816, NPROJ = 3072, PLE = 256, NH = 8, HD = 64, CONVD = 512;
constexpr int M = BATCH * SEQ;
#ifndef MK_ONE_LAUNCH
#define MK_ONE_LAUNCH 1
#endif
constexpr int N_PHASES = 10;
constexpr size_t MiB = 1u << 20;
constexpr size_t WS_CTL = 0, CTL_ZERO_BYTES = 1 * MiB;
constexpr size_t WS_W1GU = 2 * MiB, WS_W1D = 13 * MiB, WS_WIN = 19 * MiB, WS_WOUT = 25 * MiB, WS_W2GU = 27 * MiB, WS_W2D = 38 * MiB, WS_WPG = 44 * MiB, WS_WPP = 46 * MiB;
constexpr size_t WS_XB = 48 * MiB;
constexpr size_t WS_PB = 112 * MiB;
constexpr size_t WS_HID = 128 * MiB;
constexpr size_t WS_YMIX = 320 * MiB;
constexpr size_t WS_PP = 384 * MiB;
constexpr size_t WS_END = 448 * MiB;
constexpr int LDS_BYTES = 147456;

#define GAS __attribute__((address_space(1)))
#define LAS __attribute__((address_space(3)))
typedef unsigned short bf16;
typedef unsigned v4u __attribute__((ext_vector_type(4)));
typedef float f32x4 __attribute__((ext_vector_type(4)));
#define LDS_WAIT() asm volatile("s_waitcnt lgkmcnt(0)" ::: "memory")
__device__ __forceinline__ unsigned pk2(float lo, float hi) { return pg8::cvt_pk_bf16(lo, hi); }
__device__ __forceinline__ float bflo(unsigned w) { return __uint_as_float(w << 16); }
__device__ __forceinline__ float bfhi(unsigned w) { return __uint_as_float(w & 0xffff0000u); }
__device__ __forceinline__ float wave_sum(float v) {
#pragma unroll
    for (int o = 1; o < 64; o <<= 1) v += __shfl_xor(v, o);
    return v;
}

struct Args { const float* in[20]; float* out; unsigned char* ws; int ph_lo, ph_hi; };

__device__ __forceinline__ void tr_item(const float* W, int K, int N, const float* gain, bf16* WT, int dst_row0, LAS float* scr, int k0, int n0, int lane) {
#pragma unroll 8
    for (int i = 0; i < 32; ++i) { const int kk = 2 * i + (lane >> 5); float w = W[(size_t)(k0 + kk) * N + n0 + (lane & 31)]; if (gain) w *= gain[k0 + kk]; scr[kk * 33 + (lane & 31)] = w; }
    LDS_WAIT(); asm volatile("" ::: "memory");
    const int c = lane & 7;
#pragma unroll
    for (int j = 0; j < 4; ++j) { const int n = (lane >> 3) + 8 * j; const LAS float* s = scr + (8 * c) * 33 + n;
        v4u o; o.x = pk2(s[0 * 33], s[1 * 33]); o.y = pk2(s[2 * 33], s[3 * 33]); o.z = pk2(s[4 * 33], s[5 * 33]); o.w = pk2(s[6 * 33], s[7 * 33]);
        *(v4u*)(WT + (size_t)(dst_row0 + n) * K + k0 + 8 * c) = o; }
    LDS_WAIT(); asm volatile("" ::: "memory");
}
__device__ __forceinline__ bool tr_matrix(int& r, const float* W, int K, int N, const float* gain, bf16* WT, int mode, LAS float* scr, int lane) {
    const int nblk = N / 32, items = (K / 64) * nblk;
    if (r >= items) { r -= items; return false; }
    const int kb = r / nblk, nb = r % nblk, n0 = 32 * nb;
    const int dst = mode == 0 ? n0 : (256 * (n0 >> 7) + (n0 & 127) + (mode == 2 ? 128 : 0));
    tr_item(W, K, N, gain, WT, dst, scr, 64 * kb, n0, lane);
    return true;
}
__device__ __forceinline__ void p0_prep(const Args& a, LAS unsigned char* lds, int gw, int NGW, int lane, int wave) {
    unsigned char* ws = a.ws;
    LAS float* scr = (LAS float*)(lds + wave * 16384);
    constexpr int I_GU = (D / 64) * (FF / 32), I_DN = (FF / 64) * (D / 32), I_IN = (D / 64) * (NPROJ / 32), I_SQ = (D / 64) * (D / 32), I_PP = (PLE / 64) * (D / 32);
    constexpr int NITEMS = 4 * I_GU + 2 * I_DN + I_IN + 2 * I_SQ + I_PP;
    for (int it = gw; it < NITEMS; it += NGW) {
        int r = it;
        if (tr_matrix(r, a.in[3], D, FF, a.in[2], (bf16*)(ws + WS_W1GU), 1, scr, lane)) continue;
        if (tr_matrix(r, a.in[4], D, FF, a.in[2], (bf16*)(ws + WS_W1GU), 2, scr, lane)) continue;
        if (tr_matrix(r, a.in[14], D, FF, a.in[13], (bf16*)(ws + WS_W2GU), 1, scr, lane)) continue;
        if (tr_matrix(r, a.in[15], D, FF, a.in[13], (bf16*)(ws + WS_W2GU), 2, scr, lane)) continue;
        if (tr_matrix(r, a.in[5], FF, D, nullptr, (bf16*)(ws + WS_W1D), 0, scr, lane)) continue;
        if (tr_matrix(r, a.in[16], FF, D, nullptr, (bf16*)(ws + WS_W2D), 0, scr, lane)) continue;
        if (tr_matrix(r, a.in[7], D, NPROJ, a.in[6], (bf16*)(ws + WS_WIN), 0, scr, lane)) continue;
        if (tr_matrix(r, a.in[12], D, D, nullptr, (bf16*)(ws + WS_WOUT), 0, scr, lane)) continue;
        if (tr_matrix(r, a.in[18], D, D, a.in[17], (bf16*)(ws + WS_WPG), 0, scr, lane)) continue;
        tr_matrix(r, a.in[19], PLE, D, nullptr, (bf16*)(ws + WS_WPP), 0, scr, lane);
    }
    const float* x = a.in[0]; bf16* XB = (bf16*)(ws + WS_XB); float* ss1 = (float*)(ws + WS_CTL);
    for (int m = gw; m < M; m += NGW) {
        const f32x4* xr = (const f32x4*)(x + (size_t)m * D) + lane; f32x4 v[4]; float s = 0.f;
#pragma unroll
        for (int j = 0; j < 4; ++j) { v[j] = xr[64 * j]; s += (v[j].x * v[j].x + v[j].y * v[j].y) + (v[j].z * v[j].z + v[j].w * v[j].w); }
        s = wave_sum(s);
        unsigned long long* o8 = (unsigned long long*)(XB + (size_t)m * D) + lane;
#pragma unroll
        for (int j = 0; j < 4; ++j) o8[64 * j] = (unsigned long long)pk2(v[j].x, v[j].y) | ((unsigned long long)pk2(v[j].z, v[j].w) << 32);
        if (lane == 0) ss1[m] = s;
    }
    const float* p = a.in[1]; bf16* PB = (bf16*)(ws + WS_PB);
    for (int i = gw * 64 + lane; i < M * PLE / 8; i += NGW * 64) {
        const f32x4 v0 = *(const f32x4*)(p + (size_t)i * 8), v1 = *(const f32x4*)(p + (size_t)i * 8 + 4);
        *(v4u*)(PB + (size_t)i * 8) = (v4u){pk2(v0.x, v0.y), pk2(v0.z, v0.w), pk2(v1.x, v1.y), pk2(v1.z, v1.w)};
    }
}

__device__ __forceinline__ void unpack8(const v4u w, float (&f)[8]) { f[0] = bflo(w.x); f[1] = bfhi(w.x); f[2] = bflo(w.y); f[3] = bfhi(w.y); f[4] = bflo(w.z); f[5] = bfhi(w.z); f[6] = bflo(w.w); f[7] = bfhi(w.w); }
__device__ __forceinline__ v4u pack8(const float (&f)[8]) { return (v4u){pk2(f[0], f[1]), pk2(f[2], f[3]), pk2(f[4], f[5]), pk2(f[6], f[7])}; }
__device__ __forceinline__ void p4_mixprep(const Args& a, int gw, int NGW, int lane) {
    bf16* PROJ = (bf16*)(a.ws + WS_HID); bf16* YMIX = (bf16*)(a.ws + WS_YMIX);
    const float* cw = a.in[8]; const float* cbp = a.in[9]; const float* gq = a.in[10]; const float* gk = a.in[11];
    float w0[8], w1[8], w2[8], cb[8], gqv[8], gkv[8];
#pragma unroll
    for (int i = 0; i < 8; ++i) { w0[i] = cw[8 * lane + i]; w1[i] = cw[CONVD + 8 * lane + i]; w2[i] = cw[2 * CONVD + 8 * lane + i]; cb[i] = cbp[8 * lane + i];
        gqv[i] = gq[(lane & 7) * 8 + i] * 0.125f; gkv[i] = gk[(lane & 7) * 8 + i]; }
    for (int ch = gw; ch < M / 16; ch += NGW) {
        const int r0 = ch * 16; float z1[8], z2[8];
        if ((r0 & (SEQ - 1)) == 0) {
#pragma unroll
            for (int i = 0; i < 8; ++i) { z1[i] = 0.f; z2[i] = 0.f; }
        } else {
            float c[8], u[8];
            const bf16* pr = PROJ + (size_t)(r0 - 1) * NPROJ + 8 * lane; unpack8(*(const v4u*)(pr + 512), c); unpack8(*(const v4u*)(pr + 1024), u);
#pragma unroll
            for (int i = 0; i < 8; ++i) z1[i] = c[i] * u[i];
            pr -= NPROJ; unpack8(*(const v4u*)(pr + 512), c); unpack8(*(const v4u*)(pr + 1024), u);
#pragma unroll
            for (int i = 0; i < 8; ++i) z2[i] = c[i] * u[i];
        }
        for (int r = r0; r < r0 + 16; ++r) {
            bf16* pr = PROJ + (size_t)r * NPROJ + 8 * lane;
            float b[8], c[8], u[8], q[8], k[8], y[8];
            unpack8(*(const v4u*)(pr), b); unpack8(*(const v4u*)(pr + 512), c); unpack8(*(const v4u*)(pr + 1024), u);
            unpack8(*(const v4u*)(pr + 1536), q); unpack8(*(const v4u*)(pr + 2048), k);
#pragma unroll
            for (int i = 0; i < 8; ++i) { const float z0 = c[i] * u[i]; y[i] = b[i] * (w0[i] * z2[i] + w1[i] * z1[i] + w2[i] * z0 + cb[i]); z2[i] = z1[i]; z1[i] = z0; }
            *(v4u*)(YMIX + (size_t)r * D + 8 * lane) = pack8(y);
            float sq = 0.f, sk = 0.f;
#pragma unroll
            for (int i = 0; i < 8; ++i) { sq += q[i] * q[i]; sk += k[i] * k[i]; }
            sq += __shfl_xor(sq, 1); sq += __shfl_xor(sq, 2); sq += __shfl_xor(sq, 4);
            sk += __shfl_xor(sk, 1); sk += __shfl_xor(sk, 2); sk += __shfl_xor(sk, 4);
            const float rq = rsqrtf(sq * (1.0f / 64.0f) + 1e-6f), rk = rsqrtf(sk * (1.0f / 64.0f) + 1e-6f);
#pragma unroll
            for (int i = 0; i < 8; ++i) { q[i] *= rq * gqv[i]; k[i] *= rk * gkv[i]; }
            *(v4u*)(pr + 1536) = pack8(q); *(v4u*)(pr + 2048) = pack8(k);
        }
    }
}

__device__ __forceinline__ void p5_attn_naive(const Args& a, int tid) {
    const bf16* PROJ = (const bf16*)(a.ws + WS_HID); bf16* YMIX = (bf16*)(a.ws + WS_YMIX);
    for (int un = blockIdx.x; un < 512; un += gridDim.x) {
        const int bh = un & 31, r = un >> 5, qq = r < 8 ? r : 23 - r, b = bh >> 3, h = bh & 7;
        const int t = qq * 512 + tid;
        const bf16* base = PROJ + (size_t)b * SEQ * NPROJ + h * HD;
        float q[64], o[64];
#pragma unroll
        for (int c = 0; c < 8; ++c) { float f[8]; unpack8(*(const v4u*)(base + (size_t)t * NPROJ + 1536 + 8 * c), f);
#pragma unroll
            for (int e = 0; e < 8; ++e) { q[8 * c + e] = f[e]; o[8 * c + e] = 0.f; } }
        float carry = 0.f;
        for (int j = qq * 512 + 511; j >= 0; --j) {
            const bf16* kr = base + (size_t)j * NPROJ + 2048; float z = 0.f;
#pragma unroll
            for (int c = 0; c < 8; ++c) { float f[8]; unpack8(*(const v4u*)(kr + 8 * c), f);
#pragma unroll
                for (int e = 0; e < 8; ++e) z += q[8 * c + e] * f[e]; }
            const bool act = j < t;
            const float sp = fmaxf(z, 0.f) + __logf(1.0f + __expf(-fabsf(z)));
            const float av = act ? __expf(z - sp + carry) : 0.f;
            carry -= act ? sp : 0.f;
            const bf16* vr = kr + 512;
#pragma unroll
            for (int c = 0; c < 8; ++c) { float f[8]; unpack8(*(const v4u*)(vr + 8 * c), f);
#pragma unroll
                for (int e = 0; e < 8; ++e) o[8 * c + e] += av * f[e]; }
        }
        bf16* orow = YMIX + (size_t)(b * SEQ + t) * D + 512 + h * HD;
#pragma unroll
        for (int c = 0; c < 8; ++c) { float f[8];
#pragma unroll
            for (int e = 0; e < 8; ++e) f[e] = o[8 * c + e];
            *(v4u*)(orow + 8 * c) = pack8(f); }
    }
}

__global__ void __launch_bounds__(NWAVES * 64, 2) mk_fwd(Args args) {
    extern __shared__ __attribute__((aligned(16))) unsigned char lds_raw[];
    LAS unsigned char* lds = (LAS unsigned char*)lds_raw;
    const int tid = threadIdx.x, lane = tid & 63, wave = __builtin_amdgcn_readfirstlane(tid >> 6);
    const int G = gridDim.x, gw = blockIdx.x * NWAVES + wave, NGW = G * NWAVES;
    unsigned char* ws = args.ws;
    float* ss1 = (float*)(ws + WS_CTL); float* ss2 = ss1 + M; float* ss3 = ss2 + M; float* ss4 = ss3 + M;
    bf16* XB = (bf16*)(ws + WS_XB); bf16* PB = (bf16*)(ws + WS_PB); bf16* HID = (bf16*)(ws + WS_HID); bf16* PROJ = HID; bf16* YMIX = (bf16*)(ws + WS_YMIX); bf16* PP = (bf16*)(ws + WS_PP);
    const int lo = args.ph_lo, hi = args.ph_hi;
#define IN(k) (lo <= (k) && (k) < hi)
#define SEAM(k) do { if (IN(k) && IN((k) + 1)) { cg::this_grid().sync(); } } while (0)
    typedef pg8::StaticOrder SO;
    if (IN(0)) { p0_prep(args, lds, gw, NGW, lane, wave); } SEAM(0);
    if (IN(1)) {
        { pg8::Gemm g{XB, (const bf16*)(ws + WS_W1GU), M, 2 * FF, D}; SO S; S.init(M, 2 * FF, G, (int)blockIdx.x); pg8::EpiSwiGLU E{HID, FF, ss1};
          pg8::gemm_phase<pg8::EpiSwiGLU, SO, true, true>(lds, g, S, E); }
        { pg8::Gemm g{PB, (const bf16*)(ws + WS_WPP), M, D, PLE}; SO S; S.init(M, D, G, (int)blockIdx.x); pg8::EpiScaleBf16 E{PP, D, nullptr};
          pg8::gemm_phase<pg8::EpiScaleBf16, SO, true, true>(lds, g, S, E); }
    } SEAM(1);
    if (IN(2)) { pg8::Gemm g{HID, (const bf16*)(ws + WS_W1D), M, D, FF}; SO S; S.init(M, D, G, (int)blockIdx.x); pg8::EpiResid E{args.in[0], args.out, XB, ss2, 0.5f};
        pg8::gemm_phase<pg8::EpiResid, SO, true, true>(lds, g, S, E); } SEAM(2);
    if (IN(3)) { pg8::Gemm g{XB, (const bf16*)(ws + WS_WIN), M, NPROJ, D}; SO S; S.init(M, NPROJ, G, (int)blockIdx.x); pg8::EpiScaleBf16 E{PROJ, NPROJ, ss2};
        pg8::gemm_phase<pg8::EpiScaleBf16, SO, true, true>(lds, g, S, E); } SEAM(3);
    if (IN(4)) { p4_mixprep(args, gw, NGW, lane); } SEAM(4);
    if (IN(5)) { p5_attn_naive(args, tid); } SEAM(5);
    if (IN(6)) { pg8::Gemm g{YMIX, (const bf16*)(ws + WS_WOUT), M, D, D}; SO S; S.init(M, D, G, (int)blockIdx.x); pg8::EpiResid E{args.out, args.out, XB, ss3, 1.0f};
        pg8::gemm_phase<pg8::EpiResid, SO, true, true>(lds, g, S, E); } SEAM(6);
    if (IN(7)) { pg8::Gemm g{XB, (const bf16*)(ws + WS_W2GU), M, 2 * FF, D}; SO S; S.init(M, 2 * FF, G, (int)blockIdx.x); pg8::EpiSwiGLU E{HID, FF, ss3};
        pg8::gemm_phase<pg8::EpiSwiGLU, SO, true, true>(lds, g, S, E); } SEAM(7);
    if (IN(8)) { pg8::Gemm g{HID, (const bf16*)(ws + WS_W2D), M, D, FF}; SO S; S.init(M, D, G, (int)blockIdx.x); pg8::EpiResid E{args.out, args.out, XB, ss4, 0.5f};
        pg8::gemm_phase<pg8::EpiResid, SO, true, true>(lds, g, S, E); } SEAM(8);
    if (IN(9)) { pg8::Gemm g{XB, (const bf16*)(ws + WS_WPG), M, D, D}; SO S; S.init(M, D, G, (int)blockIdx.x); pg8::EpiPle E{args.out, args.out, PP, ss4};
        pg8::gemm_phase<pg8::EpiPle, SO, true, true>(lds, g, S, E); }
#undef IN
#undef SEAM
}

extern "C" void kernel_launch(void* const* d_in, const int* in_sizes, int n_in, void* d_out, int out_size, void* d_ws, size_t ws_size, hipStream_t stream) {
    static int grid = 0;
    if (grid == 0) {
        if (n_in != 20 || out_size != M * D || ws_size < WS_END) { fprintf(stderr, "kernel_launch: unexpected shapes (n_in %d out %d ws %zu)\n", n_in, out_size, ws_size); grid = -1; return; }
        int dev = 0, cus = 0, per_cu = 0;
        if (hipGetDevice(&dev) != hipSuccess || hipDeviceGetAttribute(&cus, hipDeviceAttributeMultiprocessorCount, dev) != hipSuccess) { grid = -1; return; }
        if (hipFuncSetAttribute((const void*)mk_fwd, hipFuncAttributeMaxDynamicSharedMemorySize, LDS_BYTES) != hipSuccess) { fprintf(stderr, "kernel_launch: hipFuncSetAttribute failed\n"); grid = -1; return; }
        if (hipOccupancyMaxActiveBlocksPerMultiprocessor(&per_cu, (const void*)mk_fwd, NWAVES * 64, LDS_BYTES) != hipSuccess || per_cu < 1) { fprintf(stderr, "kernel_launch: occupancy query says %d\n", per_cu); per_cu = 1; }
        (void)hipGetLastError();
        grid = cus;
    }
    if (grid < 0) return;
    (void)hipMemsetAsync((char*)d_ws + WS_CTL, 0, CTL_ZERO_BYTES, stream);
    Args a{};
    for (int i = 0; i < 20; ++i) a.in[i] = (const float*)d_in[i];
    a.out = (float*)d_out; a.ws = (unsigned char*)d_ws;
#if MK_ONE_LAUNCH
    a.ph_lo = 0; a.ph_hi = N_PHASES;
    void* kargs[] = {&a};
    hipError_t e = hipLaunchCooperativeKernel((const void*)mk_fwd, dim3(grid), dim3(NWAVES * 64), kargs, LDS_BYTES, stream);
    if (e != hipSuccess) fprintf(stderr, "kernel_launch: cooperative launch failed: %s\n", hipGetErrorString(e));
#else
    for (int ph = 0; ph < N_PHASES; ++ph) { a.ph_lo = ph; a.ph_hi = ph + 1; hipLaunchKernelGGL(mk_fwd, dim3(grid), dim3(NWAVES * 64), LDS_BYTES, stream, a); }
#endif
}
```

```cpp
#include <hip/hip_runtime.h>
#include <hip/hip_cooperative_groups.h>
#include <cstdio>
#include <cstdint>
namespace cg = cooperative_groups;
namespace pg8 {
#define PG8_LAS __attribute__((address_space(3)))
typedef unsigned short bf16_t;
typedef short bf16x8 __attribute__((ext_vector_type(8)));
typedef float f32x4 __attribute__((ext_vector_type(4)));
typedef unsigned u32x4 __attribute__((ext_vector_type(4)));
constexpr int BM = 256, BK = 64, HALF = 128, HTB = HALF * BK * 2  , STAGE_BYTES = 8 * HTB, NXCD = 8, WGM = 8;

__host__ __device__ __forceinline__ int lds_byte(int r, int c) { const int st = (r >> 4) * 2 + (c >> 5), rr = r & 15, cc = c & 31, ob = rr * 64 + cc * 2; return st * 1024 + (ob ^ (((ob >> 9) & 1) << 5)); }
__host__ __device__ __forceinline__ void stage_rc(int b, int& R, int& C) { const int st = b / 1024, sb = b % 1024, swz = sb ^ (((sb >> 9) & 1) << 5); R = (st >> 1) * 16 + swz / 64; C = (st & 1) * 32 + (swz % 64) / 2; }
__host__ __device__ __forceinline__ int perm32(int rho) { const int n = rho >> 4, i = rho & 15; return 8 * (i >> 2) + 4 * n + (i & 3); }

struct Unit { int pm, pn; };
struct Gemm { const bf16_t* A; const bf16_t* Bt; int M, N, K; };

struct StaticOrder {
    int nM, nN, nwg, G, c;
    __host__ __device__ void init(int M, int N, int G_, int c_) { nM = M / BM; nN = N / BM; nwg = nM * nN; G = G_; c = c_; }
    __host__ __device__ bool next(int i, Unit& u) const {
        const long L = (long)i * G + c; if (L >= nwg) return false;
        int wgid = (int)L; { const int q = nwg / NXCD, r = nwg % NXCD, xcd = wgid % NXCD, off = wgid / NXCD; wgid = (xcd < r ? xcd * (q + 1) : r * (q + 1) + (xcd - r) * q) + off; }
        const int nig = WGM * nN, gid = wgid / nig, fm = gid * WGM, gsz = (nM - fm) < WGM ? (nM - fm) : WGM;
        u.pm = fm + ((wgid % nig) % gsz); u.pn = (wgid % nig) / gsz; return true;
    }
    __device__ __forceinline__ void a_ready(const Unit&) const {}
    __device__ __forceinline__ void done(const Unit&) const {}
};

__device__ __forceinline__ unsigned cvt_pk_bf16(float lo, float hi) { unsigned r; asm volatile("v_cvt_pk_bf16_f32 %0, %1, %2" : "=v"(r) : "v"(lo), "v"(hi)); return r; }
typedef float f32x2 __attribute__((ext_vector_type(2)));
__device__ __forceinline__ float rs_of(float ss) { return rsqrtf(ss * (1.0f / 1024.0f) + 1e-6f); }
struct EpiSwiGLU {
    static constexpr bool PERM = true, AFTER_DRAIN = false;
    bf16_t* H; int ldh; const float* ss;
    __device__ __forceinline__ void operator()(const f32x4 (&acc)[2][2][4][2], const Unit& u, int wr, int wc, int fr, int fq) const {
        const int row0 = u.pm * BM + wr * 64 + fr, col0 = u.pn * HALF + wc * 32 + 8 * fq;
#pragma unroll
        for (int ai = 0; ai < 2; ++ai)
#pragma unroll
            for (int m = 0; m < 4; ++m) {
                const int row = row0 + ai * HALF + m * 16; const float rs = rs_of(ss[row]);
                unsigned ww[4];
#pragma unroll
                for (int n = 0; n < 2; ++n) { const f32x4 g = acc[ai][0][m][n] * rs, up = acc[ai][1][m][n] * rs; f32x4 hh;
#pragma unroll
                    for (int e = 0; e < 4; ++e) hh[e] = g[e] * __builtin_amdgcn_rcpf(1.0f + __builtin_amdgcn_exp2f(-1.4426950408889634f * g[e])) * up[e];
                    ww[2 * n] = cvt_pk_bf16(hh[0], hh[1]); ww[2 * n + 1] = cvt_pk_bf16(hh[2], hh[3]); }
                *(u32x4*)(H + (size_t)row * ldh + col0) = (u32x4){ww[0], ww[1], ww[2], ww[3]};
            }
    }
};
struct EpiResid {
    static constexpr bool PERM = true, AFTER_DRAIN = false;
    const float* xold; float* xout; bf16_t* xb; float* ssq; float alpha;
    __device__ __forceinline__ void operator()(const f32x4 (&acc)[2][2][4][2], const Unit& u, int wr, int wc, int fr, int fq) const {
        const int row0 = u.pm * BM + wr * 64 + fr, colb = u.pn * BM + wc * 32 + 8 * fq;
#pragma unroll
        for (int ai = 0; ai < 2; ++ai)
#pragma unroll
            for (int m = 0; m < 4; ++m) {
                const int row = row0 + ai * HALF + m * 16; float s = 0.f;
#pragma unroll
                for (int bj = 0; bj < 2; ++bj) { const size_t off = (size_t)row * 1024 + colb + bj * HALF;
                    const f32x4 o0 = *(const f32x4*)(xold + off), o1 = *(const f32x4*)(xold + off + 4);
                    const f32x4 v0 = o0 + acc[ai][bj][m][0] * alpha, v1 = o1 + acc[ai][bj][m][1] * alpha;
                    *(f32x4*)(xout + off) = v0; *(f32x4*)(xout + off + 4) = v1;
                    *(u32x4*)(xb + off) = (u32x4){cvt_pk_bf16(v0[0], v0[1]), cvt_pk_bf16(v0[2], v0[3]), cvt_pk_bf16(v1[0], v1[1]), cvt_pk_bf16(v1[2], v1[3])};
                    s += (v0[0] * v0[0] + v0[1] * v0[1]) + (v0[2] * v0[2] + v0[3] * v0[3]) + (v1[0] * v1[0] + v1[1] * v1[1]) + (v1[2] * v1[2] + v1[3] * v1[3]); }
                s += __shfl_xor(s, 16); s += __shfl_xor(s, 32);
                if (fq == 0) __hip_atomic_fetch_add(ssq + row, s, __ATOMIC_RELAXED, __HIP_MEMORY_SCOPE_AGENT);
            }
    }
};
struct EpiScaleBf16 {
    static constexpr bool PERM = true, AFTER_DRAIN = false;
    bf16_t* O; int ldc; const float* ss;
    __device__ __forceinline__ void operator()(const f32x4 (&acc)[2][2][4][2], const Unit& u, int wr, int wc, int fr, int fq) const {
        const int row0 = u.pm * BM + wr * 64 + fr, colb = u.pn * BM + wc * 32 + 8 * fq;
#pragma unroll
        for (int ai = 0; ai < 2; ++ai)
#pragma unroll
            for (int m = 0; m < 4; ++m) {
                const int row = row0 + ai * HALF + m * 16; const float rs = ss ? rs_of(ss[row]) : 1.0f;
#pragma unroll
                for (int bj = 0; bj < 2; ++bj) { const f32x4 v0 = acc[ai][bj][m][0] * rs, v1 = acc[ai][bj][m][1] * rs;
                    *(u32x4*)(O + (size_t)row * ldc + colb + bj * HALF) = (u32x4){cvt_pk_bf16(v0[0], v0[1]), cvt_pk_bf16(v0[2], v0[3]), cvt_pk_bf16(v1[0], v1[1]), cvt_pk_bf16(v1[2], v1[3])}; }
            }
    }
};
struct EpiPle {
    static constexpr bool PERM = true, AFTER_DRAIN = false;
    const float* xold; float* out; const bf16_t* PP; const float* ss;
    __device__ __forceinline__ void operator()(const f32x4 (&acc)[2][2][4][2], const Unit& u, int wr, int wc, int fr, int fq) const {
        const int row0 = u.pm * BM + wr * 64 + fr, colb = u.pn * BM + wc * 32 + 8 * fq;
#pragma unroll
        for (int ai = 0; ai < 2; ++ai)
#pragma unroll
            for (int m = 0; m < 4; ++m) {
                const int row = row0 + ai * HALF + m * 16; const float rs = rs_of(ss[row]) * -1.4426950408889634f;
#pragma unroll
                for (int bj = 0; bj < 2; ++bj) { const size_t off = (size_t)row * 1024 + colb + bj * HALF;
                    const f32x4 o0 = *(const f32x4*)(xold + off), o1 = *(const f32x4*)(xold + off + 4); const u32x4 pw = *(const u32x4*)(PP + off);
                    f32x4 p0, p1; p0[0] = __uint_as_float(pw[0] << 16); p0[1] = __uint_as_float(pw[0] & 0xffff0000u); p0[2] = __uint_as_float(pw[1] << 16); p0[3] = __uint_as_float(pw[1] & 0xffff0000u);
                    p1[0] = __uint_as_float(pw[2] << 16); p1[1] = __uint_as_float(pw[2] & 0xffff0000u); p1[2] = __uint_as_float(pw[3] << 16); p1[3] = __uint_as_float(pw[3] & 0xffff0000u);
                    f32x4 v0, v1;
#pragma unroll
                    for (int e = 0; e < 4; ++e) { v0[e] = o0[e] + __builtin_amdgcn_rcpf(1.0f + __builtin_amdgcn_exp2f(acc[ai][bj][m][0][e] * rs)) * p0[e];
                                                  v1[e] = o1[e] + __builtin_amdgcn_rcpf(1.0f + __builtin_amdgcn_exp2f(acc[ai][bj][m][1][e] * rs)) * p1[e]; }
                    *(f32x4*)(out + off) = v0; *(f32x4*)(out + off + 4) = v1; }
            }
    }
};
template <class Epi, class Sched, bool ALIGN_EPI = false, bool SP2 = false>
__device__ __forceinline__ void gemm_phase(PG8_LAS unsigned char* lds, const Gemm g, const Sched& S, const Epi& E) {
    const int tid = threadIdx.x, wid = __builtin_amdgcn_readfirstlane(tid >> 6), lane = tid & 63, wr = wid >> 2, wc = wid & 3, fr = lane & 15, fq = lane >> 4;
    const int K = g.K, nt = K / BK;
    unsigned voffA[2], voffB[2];
#pragma unroll
    for (int i = 0; i < 2; ++i) { int R, C; stage_rc(tid * 16 + i * 8192, R, C); const int Rb = Epi::PERM ? ((R & ~31) + perm32(R & 31)) : R;
        voffA[i] = (unsigned)(R * K + C) * 2u; voffB[i] = (unsigned)(Rb * K + C) * 2u; }
    const size_t kstep = (size_t)(BK * 2);
    const size_t hstep = (size_t)HALF * K * 2;
    const size_t tstep = 2 * hstep;
    const unsigned ldsw = (unsigned)wid * 1024u;
    const int aoff = lds_byte(wr * 64 + fr, fq * 8), boff = lds_byte(wc * 32 + fr, fq * 8);
#define PG8_SA(b, h) (((b) * 2 + (h)) * HTB)
#define PG8_SB(b, h) ((4 + (b) * 2 + (h)) * HTB)
#define PG8_STAGE(bufoff, gbase, voff) do { _Pragma("unroll") for (int _i = 0; _i < 2; ++_i) \
        __builtin_amdgcn_global_load_lds((const unsigned*)((const char*)(gbase) + (voff)[_i]), (PG8_LAS unsigned*)(lds + (bufoff) + ldsw + _i * 8192), 16, 0, 0); } while (0)
#define PG8_LDA(dst, b, h) do { _Pragma("unroll") for (int m = 0; m < 4; ++m) _Pragma("unroll") for (int k = 0; k < 2; ++k) dst[m][k] = *(const PG8_LAS bf16x8*)(lds + PG8_SA(b, h) + aoff + m * 2048 + k * 1024); } while (0)
#define PG8_LDB(dst, b, h) do { _Pragma("unroll") for (int n = 0; n < 2; ++n) _Pragma("unroll") for (int k = 0; k < 2; ++k) dst[n][k] = *(const PG8_LAS bf16x8*)(lds + PG8_SB(b, h) + boff + n * 2048 + k * 1024); } while (0)
#define PG8_MMA(ai, bj, At, Bt) do { __builtin_amdgcn_s_setprio(1); _Pragma("unroll") for (int m = 0; m < 4; ++m) _Pragma("unroll") for (int n = 0; n < 2; ++n) _Pragma("unroll") for (int k = 0; k < 2; ++k) \
        acc[ai][bj][m][n] = __builtin_amdgcn_mfma_f32_16x16x32_bf16(Bt[n][k], At[m][k], acc[ai][bj][m][n], 0, 0, 0); __builtin_amdgcn_s_setprio(0); } while (0)
#define PG8_WAIT_V(n) asm volatile("s_waitcnt vmcnt(" #n ")" ::: "memory")
#define PG8_WAIT_L(n) asm volatile("s_waitcnt lgkmcnt(" #n ")" ::: "memory")
#define PG8_BAR __builtin_amdgcn_s_barrier()
#define PG8_SCHED __builtin_amdgcn_sched_barrier(0)
    Unit cur, nxt; int ui = 0;
    if (!S.next(0, cur)) return;
    f32x4 acc[2][2][4][2];
#pragma unroll
    for (int a = 0; a < 2; ++a)
#pragma unroll
        for (int b = 0; b < 2; ++b)
#pragma unroll
            for (int m = 0; m < 4; ++m)
#pragma unroll
                for (int n = 0; n < 2; ++n) acc[a][b][m][n] = (f32x4){0.f, 0.f, 0.f, 0.f};
    bf16x8 At[4][2], B0[2][2], B1[2][2];
    const char* cA = (const char*)g.A + (size_t)cur.pm * tstep; const char* cB = (const char*)g.Bt + (size_t)cur.pn * tstep;
    S.a_ready(cur);
    if constexpr (SP2) {
        PG8_STAGE(PG8_SB(0, 0), cB, voffB); PG8_STAGE(PG8_SB(0, 1), cB + hstep, voffB); PG8_STAGE(PG8_SA(0, 0), cA, voffA); PG8_STAGE(PG8_SA(0, 1), cA + hstep, voffA);
        if (wr == 1) PG8_BAR;
        PG8_WAIT_V(2); PG8_BAR;
        PG8_STAGE(PG8_SB(1, 0), cB + kstep, voffB); PG8_STAGE(PG8_SA(1, 0), cA + kstep, voffA); PG8_STAGE(PG8_SB(1, 1), cB + hstep + kstep, voffB);
        PG8_WAIT_V(6); PG8_BAR;
    } else {
        PG8_STAGE(PG8_SB(0, 0), cB, voffB); PG8_STAGE(PG8_SA(0, 0), cA, voffA); PG8_STAGE(PG8_SB(0, 1), cB + hstep, voffB); PG8_STAGE(PG8_SA(0, 1), cA + hstep, voffA);
        if (wr == 1) PG8_BAR;
        PG8_WAIT_V(4); PG8_BAR;
        PG8_STAGE(PG8_SB(1, 0), cB + kstep, voffB); PG8_STAGE(PG8_SA(1, 0), cA + kstep, voffA); PG8_STAGE(PG8_SB(1, 1), cB + hstep + kstep, voffB);
        PG8_WAIT_V(6); PG8_BAR;
    }
    for (;;) {
        const bool has_next = S.next(ui + 1, nxt);
        const char* nA = has_next ? (const char*)g.A + (size_t)nxt.pm * tstep : cA; const char* nB = has_next ? (const char*)g.Bt + (size_t)nxt.pn * tstep : cB;
        for (int t = 0; t < nt; t += 2) {
            const bool last = (t == nt - 2);
            const char* a1 = cA + (size_t)(t + 1) * kstep;
            const char* a2 = last ? nA : cA + (size_t)(t + 2) * kstep; const char* b2 = last ? nB : cB + (size_t)(t + 2) * kstep;
            const char* a3 = a2 + kstep; const char* b3 = b2 + kstep;
            if (last && has_next) S.a_ready(nxt);
            if constexpr (SP2) {
            PG8_LDB(B0, 0, 0); PG8_LDB(B1, 0, 1); PG8_SCHED; PG8_LDA(At, 0, 0); PG8_STAGE(PG8_SA(1, 1), a1 + hstep, voffA);
            PG8_WAIT_V(8); PG8_WAIT_L(0); PG8_BAR; PG8_MMA(0, 0, At, B0); PG8_MMA(0, 1, At, B1); PG8_BAR; PG8_SCHED;
            PG8_LDA(At, 0, 1); PG8_STAGE(PG8_SB(0, 0), b2, voffB); PG8_STAGE(PG8_SB(0, 1), b2 + hstep, voffB); PG8_STAGE(PG8_SA(0, 0), a2, voffA);
            PG8_WAIT_V(8); PG8_WAIT_L(0); PG8_BAR; PG8_MMA(1, 0, At, B0); PG8_MMA(1, 1, At, B1); PG8_BAR; PG8_SCHED;
            PG8_LDB(B0, 1, 0); PG8_LDB(B1, 1, 1); PG8_SCHED; PG8_LDA(At, 1, 0); PG8_STAGE(PG8_SA(0, 1), a2 + hstep, voffA);
            PG8_WAIT_V(8); PG8_WAIT_L(0); PG8_BAR; PG8_MMA(0, 0, At, B0); PG8_MMA(0, 1, At, B1); PG8_BAR; PG8_SCHED;
            PG8_LDA(At, 1, 1); PG8_STAGE(PG8_SB(1, 0), b3, voffB); PG8_STAGE(PG8_SB(1, 1), b3 + hstep, voffB); PG8_STAGE(PG8_SA(1, 0), a3, voffA);
            PG8_WAIT_V(8); PG8_WAIT_L(0); PG8_BAR; PG8_MMA(1, 0, At, B0); PG8_MMA(1, 1, At, B1); PG8_BAR; PG8_SCHED;
            } else {
            PG8_LDB(B0, 0, 0); PG8_SCHED; PG8_LDA(At, 0, 0); PG8_STAGE(PG8_SA(1, 1), a1 + hstep, voffA);
            PG8_WAIT_L(8); PG8_BAR; PG8_WAIT_L(0); PG8_MMA(0, 0, At, B0); PG8_BAR; PG8_SCHED;
            PG8_LDB(B1, 0, 1); PG8_STAGE(PG8_SB(0, 0), b2, voffB);
            PG8_BAR; PG8_WAIT_L(0); PG8_MMA(0, 1, At, B1); PG8_BAR;
            PG8_LDA(At, 0, 1); PG8_STAGE(PG8_SA(0, 0), a2, voffA);
            PG8_BAR; PG8_WAIT_L(0); PG8_MMA(1, 0, At, B0); PG8_BAR; PG8_SCHED;
            PG8_STAGE(PG8_SB(0, 1), b2 + hstep, voffB);
            PG8_WAIT_V(6); PG8_BAR; PG8_MMA(1, 1, At, B1); PG8_BAR;
            PG8_LDB(B0, 1, 0); PG8_SCHED; PG8_LDA(At, 1, 0); PG8_STAGE(PG8_SA(0, 1), a2 + hstep, voffA);
            PG8_WAIT_L(8); PG8_BAR; PG8_WAIT_L(0); PG8_MMA(0, 0, At, B0); PG8_BAR; PG8_SCHED;
            PG8_LDB(B1, 1, 1); PG8_STAGE(PG8_SB(1, 0), b3, voffB);
            PG8_BAR; PG8_WAIT_L(0); PG8_MMA(0, 1, At, B1); PG8_BAR;
            PG8_LDA(At, 1, 1); PG8_STAGE(PG8_SA(1, 0), a3, voffA);
            PG8_BAR; PG8_WAIT_L(0); PG8_MMA(1, 0, At, B0); PG8_BAR; PG8_SCHED;
            PG8_STAGE(PG8_SB(1, 1), b3 + hstep, voffB);
            PG8_WAIT_V(6); PG8_BAR; PG8_MMA(1, 1, At, B1); PG8_BAR;
            }
        }
        if constexpr (ALIGN_EPI) { if (wr == 0) PG8_BAR; }
        if constexpr (!Epi::AFTER_DRAIN) { E(acc, cur, wr, wc, fr, fq); S.done(cur); }
        if (!has_next) break;
#pragma unroll
        for (int a = 0; a < 2; ++a)
#pragma unroll
            for (int b = 0; b < 2; ++b)
#pragma unroll
                for (int m = 0; m < 4; ++m)
#pragma unroll
                    for (int n = 0; n < 2; ++n) acc[a][b][m][n] = (f32x4){0.f, 0.f, 0.f, 0.f};
        cur = nxt; cA = nA; cB = nB; ++ui;
        if constexpr (ALIGN_EPI) { if (wr == 1) PG8_BAR; }
    }
    PG8_WAIT_V(0);
    if constexpr (!ALIGN_EPI) { if (wr == 0) PG8_BAR; }
    PG8_BAR;
    if constexpr (Epi::AFTER_DRAIN) { E.fused(acc, cur, wr, wc, fr, fq, lds, wid, lane); S.done(cur); }
#undef PG8_SA
#undef PG8_SB
#undef PG8_STAGE
#undef PG8_LDA
#undef PG8_LDB
#undef PG8_MMA
#undef PG8_WAIT_V
#undef PG8_WAIT_L
#undef PG8_BAR
#undef PG8_SCHED
}
}

constexpr int NWAVES = 8;
constexpr int BATCH = 4, SEQ = 8192, D = 1024, FF = 2816, NPROJ = 3072, PLE = 256, NH = 8, HD = 64, CONVD = 512;
constexpr int M = BATCH * SEQ;
#ifndef MK_ONE_LAUNCH
#define MK_ONE_LAUNCH 1
#endif
constexpr int N_PHASES = 10;
constexpr size_t MiB = 1u << 20;
constexpr size_t WS_CTL = 0, CTL_ZERO_BYTES = 1 * MiB;
constexpr size_t WS_W1GU = 2 * MiB, WS_W1D = 13 * MiB, WS_WIN = 19 * MiB, WS_WOUT = 25 * MiB, WS_W2GU = 27 * MiB, WS_W2D = 38 * MiB, WS_WPG = 44 * MiB, WS_WPP = 46 * MiB;
constexpr size_t WS_XB = 48 * MiB;
constexpr size_t WS_PB = 112 * MiB;
constexpr size_t WS_HID = 128 * MiB;
constexpr size_t WS_YMIX = 320 * MiB;
constexpr size_t WS_PP = 384 * MiB;
constexpr size_t WS_END = 448 * MiB;
#ifndef ATTN_NAIVE
#define ATTN_NAIVE 0
#endif
constexpr float QSC = ATTN_NAIVE ? 0.125f : 0.125f * 1.4426950408889634f;
constexpr int LDS_BYTES = 147456;

#define GAS __attribute__((address_space(1)))
#define LAS __attribute__((address_space(3)))
typedef unsigned short bf16;
typedef unsigned v4u __attribute__((ext_vector_type(4)));
typedef float f32x4 __attribute__((ext_vector_type(4)));
#define LDS_WAIT() asm volatile("s_waitcnt lgkmcnt(0)" ::: "memory")
__device__ __forceinline__ unsigned pk2(float lo, float hi) { return pg8::cvt_pk_bf16(lo, hi); }
__device__ __forceinline__ float bflo(unsigned w) { return __uint_as_float(w << 16); }
__device__ __forceinline__ float bfhi(unsigned w) { return __uint_as_float(w & 0xffff0000u); }
__device__ __forceinline__ float wave_sum(float v) {
#pragma unroll
    for (int o = 1; o < 64; o <<= 1) v += __shfl_xor(v, o);
    return v;
}

struct Args { const float* in[20]; float* out; unsigned char* ws; int ph_lo, ph_hi; };

__device__ __forceinline__ void tr_item(const float* W, int K, int N, const float* gain, bf16* WT, int dst_row0, LAS float* scr, int k0, int n0, int lane) {
#pragma unroll 8
    for (int i = 0; i < 32; ++i) { const int kk = 2 * i + (lane >> 5); float w = W[(size_t)(k0 + kk) * N + n0 + (lane & 31)]; if (gain) w *= gain[k0 + kk]; scr[kk * 33 + (lane & 31)] = w; }
    LDS_WAIT(); asm volatile("" ::: "memory");
    const int c = lane & 7;
#pragma unroll
    for (int j = 0; j < 4; ++j) { const int n = (lane >> 3) + 8 * j; const LAS float* s = scr + (8 * c) * 33 + n;
        v4u o; o.x = pk2(s[0 * 33], s[1 * 33]); o.y = pk2(s[2 * 33], s[3 * 33]); o.z = pk2(s[4 * 33], s[5 * 33]); o.w = pk2(s[6 * 33], s[7 * 33]);
        *(v4u*)(WT + (size_t)(dst_row0 + n) * K + k0 + 8 * c) = o; }
    LDS_WAIT(); asm volatile("" ::: "memory");
}
__device__ __forceinline__ bool tr_matrix(int& r, const float* W, int K, int N, const float* gain, bf16* WT, int mode, LAS float* scr, int lane) {
    const int nblk = N / 32, items = (K / 64) * nblk;
    if (r >= items) { r -= items; return false; }
    const int kb = r / nblk, nb = r % nblk, n0 = 32 * nb;
    const int dst = mode == 0 ? n0 : (256 * (n0 >> 7) + (n0 & 127) + (mode == 2 ? 128 : 0));
    tr_item(W, K, N, gain, WT, dst, scr, 64 * kb, n0, lane);
    return true;
}
__device__ __forceinline__ void p0_prep(const Args& a, LAS unsigned char* lds, int gw, int NGW, int lane, int wave) {
    unsigned char* ws = a.ws;
    LAS float* scr = (LAS float*)(lds + wave * 16384);
    constexpr int I_GU = (D / 64) * (FF / 32), I_DN = (FF / 64) * (D / 32), I_IN = (D / 64) * (NPROJ / 32), I_SQ = (D / 64) * (D / 32), I_PP = (PLE / 64) * (D / 32);
    constexpr int NITEMS = 4 * I_GU + 2 * I_DN + I_IN + 2 * I_SQ + I_PP;
    for (int it = gw; it < NITEMS; it += NGW) {
        int r = it;
        if (tr_matrix(r, a.in[3], D, FF, a.in[2], (bf16*)(ws + WS_W1GU), 1, scr, lane)) continue;
        if (tr_matrix(r, a.in[4], D, FF, a.in[2], (bf16*)(ws + WS_W1GU), 2, scr, lane)) continue;
        if (tr_matrix(r, a.in[14], D, FF, a.in[13], (bf16*)(ws + WS_W2GU), 1, scr, lane)) continue;
        if (tr_matrix(r, a.in[15], D, FF, a.in[13], (bf16*)(ws + WS_W2GU), 2, scr, lane)) continue;
        if (tr_matrix(r, a.in[5], FF, D, nullptr, (bf16*)(ws + WS_W1D), 0, scr, lane)) continue;
        if (tr_matrix(r, a.in[16], FF, D, nullptr, (bf16*)(ws + WS_W2D), 0, scr, lane)) continue;
        if (tr_matrix(r, a.in[7], D, NPROJ, a.in[6], (bf16*)(ws + WS_WIN), 0, scr, lane)) continue;
        if (tr_matrix(r, a.in[12], D, D, nullptr, (bf16*)(ws + WS_WOUT), 0, scr, lane)) continue;
        if (tr_matrix(r, a.in[18], D, D, a.in[17], (bf16*)(ws + WS_WPG), 0, scr, lane)) continue;
        tr_matrix(r, a.in[19], PLE, D, nullptr, (bf16*)(ws + WS_WPP), 0, scr, lane);
    }
    const float* x = a.in[0]; bf16* XB = (bf16*)(ws + WS_XB); float* ss1 = (float*)(ws + WS_CTL);
    for (int m = gw; m < M; m += NGW) {
        const f32x4* xr = (const f32x4*)(x + (size_t)m * D) + lane; f32x4 v[4]; float s = 0.f;
#pragma unroll
        for (int j = 0; j < 4; ++j) { v[j] = xr[64 * j]; s += (v[j].x * v[j].x + v[j].y * v[j].y) + (v[j].z * v[j].z + v[j].w * v[j].w); }
        s = wave_sum(s);
        unsigned long long* o8 = (unsigned long long*)(XB + (size_t)m * D) + lane;
#pragma unroll
        for (int j = 0; j < 4; ++j) o8[64 * j] = (unsigned long long)pk2(v[j].x, v[j].y) | ((unsigned long long)pk2(v[j].z, v[j].w) << 32);
        if (lane == 0) ss1[m] = s;
    }
    const float* p = a.in[1]; bf16* PB = (bf16*)(ws + WS_PB);
    for (int i = gw * 64 + lane; i < M * PLE / 8; i += NGW * 64) {
        const f32x4 v0 = *(const f32x4*)(p + (size_t)i * 8), v1 = *(const f32x4*)(p + (size_t)i * 8 + 4);
        *(v4u*)(PB + (size_t)i * 8) = (v4u){pk2(v0.x, v0.y), pk2(v0.z, v0.w), pk2(v1.x, v1.y), pk2(v1.z, v1.w)};
    }
}

__device__ __forceinline__ void unpack8(const v4u w, float (&f)[8]) { f[0] = bflo(w.x); f[1] = bfhi(w.x); f[2] = bflo(w.y); f[3] = bfhi(w.y); f[4] = bflo(w.z); f[5] = bfhi(w.z); f[6] = bflo(w.w); f[7] = bfhi(w.w); }
__device__ __forceinline__ v4u pack8(const float (&f)[8]) { return (v4u){pk2(f[0], f[1]), pk2(f[2], f[3]), pk2(f[4], f[5]), pk2(f[6], f[7])}; }
__device__ __forceinline__ void p4_mixprep(const Args& a, int gw, int NGW, int lane) {
    bf16* PROJ = (bf16*)(a.ws + WS_HID); bf16* YMIX = (bf16*)(a.ws + WS_YMIX);
    const float* cw = a.in[8]; const float* cbp = a.in[9]; const float* gq = a.in[10]; const float* gk = a.in[11];
    float w0[8], w1[8], w2[8], cb[8], gqv[8], gkv[8];
#pragma unroll
    for (int i = 0; i < 8; ++i) { w0[i] = cw[8 * lane + i]; w1[i] = cw[CONVD + 8 * lane + i]; w2[i] = cw[2 * CONVD + 8 * lane + i]; cb[i] = cbp[8 * lane + i];
        gqv[i] = gq[(lane & 7) * 8 + i] * QSC; gkv[i] = gk[(lane & 7) * 8 + i]; }
    for (int ch = gw; ch < M / 16; ch += NGW) {
        const int r0 = ch * 16; float z1[8], z2[8];
        if ((r0 & (SEQ - 1)) == 0) {
#pragma unroll
            for (int i = 0; i < 8; ++i) { z1[i] = 0.f; z2[i] = 0.f; }
        } else {
            float c[8], u[8];
            const bf16* pr = PROJ + (size_t)(r0 - 1) * NPROJ + 8 * lane; unpack8(*(const v4u*)(pr + 512), c); unpack8(*(const v4u*)(pr + 1024), u);
#pragma unroll
            for (int i = 0; i < 8; ++i) z1[i] = c[i] * u[i];
            pr -= NPROJ; unpack8(*(const v4u*)(pr + 512), c); unpack8(*(const v4u*)(pr + 1024), u);
#pragma unroll
            for (int i = 0; i < 8; ++i) z2[i] = c[i] * u[i];
        }
        for (int r = r0; r < r0 + 16; ++r) {
            bf16* pr = PROJ + (size_t)r * NPROJ + 8 * lane;
            float b[8], c[8], u[8], q[8], k[8], y[8];
            unpack8(*(const v4u*)(pr), b); unpack8(*(const v4u*)(pr + 512), c); unpack8(*(const v4u*)(pr + 1024), u);
            unpack8(*(const v4u*)(pr + 1536), q); unpack8(*(const v4u*)(pr + 2048), k);
#pragma unroll
            for (int i = 0; i < 8; ++i) { const float z0 = c[i] * u[i]; y[i] = b[i] * (w0[i] * z2[i] + w1[i] * z1[i] + w2[i] * z0 + cb[i]); z2[i] = z1[i]; z1[i] = z0; }
            *(v4u*)(YMIX + (size_t)r * D + 8 * lane) = pack8(y);
            float sq = 0.f, sk = 0.f;
#pragma unroll
            for (int i = 0; i < 8; ++i) { sq += q[i] * q[i]; sk += k[i] * k[i]; }
            sq += __shfl_xor(sq, 1); sq += __shfl_xor(sq, 2); sq += __shfl_xor(sq, 4);
            sk += __shfl_xor(sk, 1); sk += __shfl_xor(sk, 2); sk += __shfl_xor(sk, 4);
            const float rq = rsqrtf(sq * (1.0f / 64.0f) + 1e-6f), rk = rsqrtf(sk * (1.0f / 64.0f) + 1e-6f);
#pragma unroll
            for (int i = 0; i < 8; ++i) { q[i] *= rq * gqv[i]; k[i] *= rk * gkv[i]; }
            *(v4u*)(pr + 1536) = pack8(q); *(v4u*)(pr + 2048) = pack8(k);
        }
    }
}

__device__ __forceinline__ void p5_attn_naive(const Args& a, int tid) {
    const bf16* PROJ = (const bf16*)(a.ws + WS_HID); bf16* YMIX = (bf16*)(a.ws + WS_YMIX);
    for (int un = blockIdx.x; un < 512; un += gridDim.x) {
        const int bh = un & 31, r = un >> 5, qq = r < 8 ? r : 23 - r, b = bh >> 3, h = bh & 7;
        const int t = qq * 512 + tid;
        const bf16* base = PROJ + (size_t)b * SEQ * NPROJ + h * HD;
        float q[64], o[64];
#pragma unroll
        for (int c = 0; c < 8; ++c) { float f[8]; unpack8(*(const v4u*)(base + (size_t)t * NPROJ + 1536 + 8 * c), f);
#pragma unroll
            for (int e = 0; e < 8; ++e) { q[8 * c + e] = f[e]; o[8 * c + e] = 0.f; } }
        float carry = 0.f;
        for (int j = qq * 512 + 511; j >= 0; --j) {
            const bf16* kr = base + (size_t)j * NPROJ + 2048; float z = 0.f;
#pragma unroll
            for (int c = 0; c < 8; ++c) { float f[8]; unpack8(*(const v4u*)(kr + 8 * c), f);
#pragma unroll
                for (int e = 0; e < 8; ++e) z += q[8 * c + e] * f[e]; }
            const bool act = j < t;
            const float sp = fmaxf(z, 0.f) + __logf(1.0f + __expf(-fabsf(z)));
            const float av = act ? __expf(z - sp + carry) : 0.f;
            carry -= act ? sp : 0.f;
            const bf16* vr = kr + 512;
#pragma unroll
            for (int c = 0; c < 8; ++c) { float f[8]; unpack8(*(const v4u*)(vr + 8 * c), f);
#pragma unroll
                for (int e = 0; e < 8; ++e) o[8 * c + e] += av * f[e]; }
        }
        bf16* orow = YMIX + (size_t)(b * SEQ + t) * D + 512 + h * HD;
#pragma unroll
        for (int c = 0; c < 8; ++c) { float f[8];
#pragma unroll
            for (int e = 0; e < 8; ++e) f[e] = o[8 * c + e];
            *(v4u*)(orow + 8 * c) = pack8(f); }
    }
}

namespace sba {
using bf16x8 = __attribute__((ext_vector_type(8))) short;
using s16x4 = __attribute__((ext_vector_type(4))) short;
using f32x16 = __attribute__((ext_vector_type(16))) float;
typedef short v4i16_t __attribute__((ext_vector_type(4)));
typedef float f32x2_t __attribute__((ext_vector_type(2))); typedef __bf16 bf16x2_t __attribute__((ext_vector_type(2)));
typedef __attribute__((address_space(3))) const char* lds_cptr;
constexpr int SLOTB = 8192, LDS_K = 0, LDS_V = 2 * SLOTB;
__device__ __forceinline__ void glds16(const void* gsrc, unsigned lds_dst) { unsigned keep;
    asm volatile("s_mov_b32 %0, m0\n\ts_mov_b32 m0, %2\n\ts_nop 0\n\tglobal_load_lds_dwordx4 %1, off\n\ts_mov_b32 m0, %0" : "=&s"(keep) : "v"(gsrc), "s"(lds_dst) : "memory"); }
__device__ __forceinline__ unsigned cvtpk_s(float lo, float hi) { f32x2_t v = {lo, hi}; bf16x2_t b = __builtin_convertvector(v, bf16x2_t); return __builtin_bit_cast(unsigned, b); }
__device__ __forceinline__ s16x4 vtr(lds_cptr p) { return __builtin_bit_cast(s16x4, __builtin_amdgcn_ds_read_tr16_b64_v4i16((__attribute__((address_space(3))) v4i16_t*)p)); }
#define SBA_MFMA(a, b, c) __builtin_amdgcn_mfma_f32_32x32x16_bf16((a), (b), (c), 0, 0, 0)

__device__ __forceinline__ void unit(int b, int hd, int qb, const unsigned short* PROJ, unsigned short* YMIX, char* shm) {
    const int tid = threadIdx.x, lane = tid & 63, r32 = lane & 31, hi = lane >> 5; const int wid = __builtin_amdgcn_readfirstlane(tid >> 6);
    const size_t rowbase = (size_t)b * SEQ; const int q0 = qb * 256;
    const unsigned short* Qw = PROJ + (rowbase + q0 + wid * 32) * NPROJ + 1536 + hd * 64;
    const unsigned short* Kh = PROJ + rowbase * NPROJ + 2048 + hd * 64; const unsigned short* Vh = Kh + 512;
    const unsigned lds0 = (unsigned)(uintptr_t)shm;
    const unsigned short* ksrc = Kh + (size_t)lane * NPROJ + wid * 8;
    const unsigned short* vsrc = Vh + (size_t)(16 * (wid & 3) + (lane >> 2)) * NPROJ + (wid >> 2) * 32 + (lane & 3) * 8;
    const unsigned kdst = lds0 + LDS_K + wid * 1024, vdst = lds0 + LDS_V + wid * 1024;
#define DMA_K(t, so) glds16(ksrc + (size_t)(t) * 64 * NPROJ, (unsigned)__builtin_amdgcn_readfirstlane(kdst + (so)))
#define DMA_V(t, so) glds16(vsrc + (size_t)(t) * 64 * NPROJ, (unsigned)__builtin_amdgcn_readfirstlane(vdst + (so)))
    const lds_cptr shm3 = (lds_cptr)shm;
    const lds_cptr kp0 = shm3 + LDS_K + hi * 1024 + r32 * 16;
    const lds_cptr vp0 = shm3 + LDS_V + ((lane >> 4) & 1) * 32 + (lane & 3) * 8 + (4 * hi + ((lane & 15) >> 2)) * 64;
    const int NT = 4 * (qb + 1);
    DMA_K(NT - 1, 0); DMA_V(NT - 1, 0);
    bf16x8 qr[4];
#pragma unroll
    for (int d0 = 0; d0 < 4; ++d0) qr[d0] = *reinterpret_cast<const bf16x8*>(&Qw[(size_t)r32 * NPROJ + d0 * 16 + hi * 8]);
    f32x16 o[2]; o[0] = f32x16{}; o[1] = f32x16{};
    float carry = 1.0f;
    const int qrel = wid * 32 + r32;
    int slot = 0;
    for (int t = NT - 1; t >= 0; --t) {
        asm volatile("s_waitcnt vmcnt(0) lgkmcnt(0)\n\ts_barrier" ::: "memory");
        if (t > 0) { DMA_K(t - 1, (slot ^ 1) * SLOTB); DMA_V(t - 1, (slot ^ 1) * SLOTB); }
        const lds_cptr kp = kp0 + slot * SLOTB;
        f32x16 p0 = f32x16{}, p1 = f32x16{};
#pragma unroll
        for (int d0 = 0; d0 < 4; ++d0) {
            const bf16x8 b0 = *(const __attribute__((address_space(3))) bf16x8*)(kp + d0 * 2048);
            const bf16x8 b1 = *(const __attribute__((address_space(3))) bf16x8*)(kp + d0 * 2048 + 512);
            p0 = SBA_MFMA(b0, qr[d0], p0); p1 = SBA_MFMA(b1, qr[d0], p1);
        }
        if (t >= NT - 4) {
            const int kb = 64 * (t - (NT - 4)) + 4 * hi;
#pragma unroll
            for (int r = 0; r < 16; ++r) { const int kv = kb + (r & 3) + 8 * (r >> 2); if (kv >= qrel) p0[r] = -INFINITY; if (kv + 32 >= qrel) p1[r] = -INFINITY; }
        }
        float kp_[2][16];
#pragma unroll
        for (int r = 0; r < 16; ++r) { kp_[0][r] = __builtin_amdgcn_rcpf(1.0f + __builtin_amdgcn_exp2f(p0[r])); kp_[1][r] = __builtin_amdgcn_rcpf(1.0f + __builtin_amdgcn_exp2f(p1[r])); }
        float av[2][16]; float st = carry;
#pragma unroll
        for (int p = 1; p >= 0; --p)
#pragma unroll
            for (int g = 3; g >= 0; --g) {
                const float k0 = kp_[p][4 * g], k1 = kp_[p][4 * g + 1], k2 = kp_[p][4 * g + 2], k3 = kp_[p][4 * g + 3];
                const float s1 = k3 * k2, s0 = s1 * k1, G = s0 * k0;
                const auto rr = __builtin_amdgcn_permlane32_swap(__float_as_uint(G), __float_as_uint(G), false, false);
                const float Glo = __uint_as_float(rr[0]), Ghi = __uint_as_float(rr[1]);
                const float base = st * (hi ? 1.0f : Ghi);
                av[p][4 * g + 3] = (1.0f - k3) * base; av[p][4 * g + 2] = (1.0f - k2) * (base * k3); av[p][4 * g + 1] = (1.0f - k1) * (base * s1); av[p][4 * g] = (1.0f - k0) * (base * s0);
                st = st * (Glo * Ghi);
            }
        carry = st;
        unsigned pw[4][4];
#pragma unroll
        for (int ks = 0; ks < 4; ++ks)
#pragma unroll
            for (int j = 0; j < 4; ++j) pw[ks][j] = cvtpk_s(av[ks >> 1][8 * (ks & 1) + 2 * j], av[ks >> 1][8 * (ks & 1) + 2 * j + 1]);
        const lds_cptr vp = vp0 + slot * SLOTB;
#pragma unroll
        for (int d0 = 0; d0 < 2; ++d0)
#pragma unroll
            for (int ks = 0; ks < 4; ++ks) {
                const s16x4 lo = vtr(vp + d0 * 4096 + ks * 1024), hh = vtr(vp + d0 * 4096 + ks * 1024 + 512);
                const bf16x8 vf = (bf16x8){lo[0], lo[1], lo[2], lo[3], hh[0], hh[1], hh[2], hh[3]};
                const bf16x8 pa = __builtin_bit_cast(bf16x8, (v4u){pw[ks][0], pw[ks][1], pw[ks][2], pw[ks][3]});
                o[d0] = SBA_MFMA(pa, vf, o[d0]);
            }
        slot ^= 1;
    }
    unsigned short* Ow = YMIX + (rowbase + q0 + wid * 32) * D + 512 + hd * 64;
#pragma unroll
    for (int r = 0; r < 16; ++r) { const int orow = (r & 3) + 8 * (r >> 2) + 4 * hi;
#pragma unroll
        for (int d0 = 0; d0 < 2; ++d0) Ow[(size_t)orow * D + d0 * 32 + r32] = (unsigned short)(cvtpk_s(o[d0][r], 0.f) & 0xffffu); }
#undef DMA_K
#undef DMA_V
}
__device__ __forceinline__ void phase(const unsigned short* PROJ, unsigned short* YMIX, char* shm) {
    const int G = gridDim.x, bx = blockIdx.x; const int vcu = (G % 8 == 0) ? (bx % 8) * (G / 8) + bx / 8 : bx;
    for (int v = vcu; v < 256; v += G) { const int bh = v >> 3, s = v & 7;
#pragma unroll 1
        for (int i = 0; i < 4; ++i) { const int qb = (i == 0) ? 31 - s : (i == 1) ? 16 + s : (i == 2) ? 15 - s : s; unit(bh >> 3, bh & 7, qb, PROJ, YMIX, shm); } }
}
}

__global__ void __launch_bounds__(NWAVES * 64, 2) mk_fwd(Args args) {
    extern __shared__ __attribute__((aligned(16))) unsigned char lds_raw[];
    LAS unsigned char* lds = (LAS unsigned char*)lds_raw;
    const int tid = threadIdx.x, lane = tid & 63, wave = __builtin_amdgcn_readfirstlane(tid >> 6);
    const int G = gridDim.x, gw = blockIdx.x * NWAVES + wave, NGW = G * NWAVES;
    unsigned char* ws = args.ws;
    float* ss1 = (float*)(ws + WS_CTL); float* ss2 = ss1 + M; float* ss3 = ss2 + M; float* ss4 = ss3 + M;
    bf16* XB = (bf16*)(ws + WS_XB); bf16* PB = (bf16*)(ws + WS_PB); bf16* HID = (bf16*)(ws + WS_HID); bf16* PROJ = HID; bf16* YMIX = (bf16*)(ws + WS_YMIX); bf16* PP = (bf16*)(ws + WS_PP);
    const int lo = args.ph_lo, hi = args.ph_hi;
#define IN(k) (lo <= (k) && (k) < hi)
#define SEAM(k) do { if (IN(k) && IN((k) + 1)) { cg::this_grid().sync(); } } while (0)
    typedef pg8::StaticOrder SO;
    if (IN(0)) { p0_prep(args, lds, gw, NGW, lane, wave); } SEAM(0);
    if (IN(1)) {
        { pg8::Gemm g{XB, (const bf16*)(ws + WS_W1GU), M, 2 * FF, D}; SO S; S.init(M, 2 * FF, G, (int)blockIdx.x); pg8::EpiSwiGLU E{HID, FF, ss1};
          pg8::gemm_phase<pg8::EpiSwiGLU, SO, true, true>(lds, g, S, E); }
        { pg8::Gemm g{PB, (const bf16*)(ws + WS_WPP), M, D, PLE}; SO S; S.init(M, D, G, (int)blockIdx.x); pg8::EpiScaleBf16 E{PP, D, nullptr};
          pg8::gemm_phase<pg8::EpiScaleBf16, SO, true, true>(lds, g, S, E); }
    } SEAM(1);
    if (IN(2)) { pg8::Gemm g{HID, (const bf16*)(ws + WS_W1D), M, D, FF}; SO S; S.init(M, D, G, (int)blockIdx.x); pg8::EpiResid E{args.in[0], args.out, XB, ss2, 0.5f};
        pg8::gemm_phase<pg8::EpiResid, SO, true, true>(lds, g, S, E); } SEAM(2);
    if (IN(3)) { pg8::Gemm g{XB, (const bf16*)(ws + WS_WIN), M, NPROJ, D}; SO S; S.init(M, NPROJ, G, (int)blockIdx.x); pg8::EpiScaleBf16 E{PROJ, NPROJ, ss2};
        pg8::gemm_phase<pg8::EpiScaleBf16, SO, true, true>(lds, g, S, E); } SEAM(3);
    if (IN(4)) { p4_mixprep(args, gw, NGW, lane); } SEAM(4);
    if (IN(5)) { if (ATTN_NAIVE) p5_attn_naive(args, tid); else sba::phase(PROJ, YMIX, (char*)lds_raw); } SEAM(5);
    if (IN(6)) { pg8::Gemm g{YMIX, (const bf16*)(ws + WS_WOUT), M, D, D}; SO S; S.init(M, D, G, (int)blockIdx.x); pg8::EpiResid E{args.out, args.out, XB, ss3, 1.0f};
        pg8::gemm_phase<pg8::EpiResid, SO, true, true>(lds, g, S, E); } SEAM(6);
    if (IN(7)) { pg8::Gemm g{XB, (const bf16*)(ws + WS_W2GU), M, 2 * FF, D}; SO S; S.init(M, 2 * FF, G, (int)blockIdx.x); pg8::EpiSwiGLU E{HID, FF, ss3};
        pg8::gemm_phase<pg8::EpiSwiGLU, SO, true, true>(lds, g, S, E); } SEAM(7);
    if (IN(8)) { pg8::Gemm g{HID, (const bf16*)(ws + WS_W2D), M, D, FF}; SO S; S.init(M, D, G, (int)blockIdx.x); pg8::EpiResid E{args.out, args.out, XB, ss4, 0.5f};
        pg8::gemm_phase<pg8::EpiResid, SO, true, true>(lds, g, S, E); } SEAM(8);
    if (IN(9)) { pg8::Gemm g{XB, (const bf16*)(ws + WS_WPG), M, D, D}; SO S; S.init(M, D, G, (int)blockIdx.x); pg8::EpiPle E{args.out, args.out, PP, ss4};
        pg8::gemm_phase<pg8::EpiPle, SO, true, true>(lds, g, S, E); }
#undef IN
#undef SEAM
}

extern "C" void kernel_launch(void* const* d_in, const int* in_sizes, int n_in, void* d_out, int out_size, void* d_ws, size_t ws_size, hipStream_t stream) {
    static int grid = 0;
    if (grid == 0) {
        if (n_in != 20 || out_size != M * D || ws_size < WS_END) { fprintf(stderr, "kernel_launch: unexpected shapes (n_in %d out %d ws %zu)\n", n_in, out_size, ws_size); grid = -1; return; }
        int dev = 0, cus = 0, per_cu = 0;
        if (hipGetDevice(&dev) != hipSuccess || hipDeviceGetAttribute(&cus, hipDeviceAttributeMultiprocessorCount, dev) != hipSuccess) { grid = -1; return; }
        if (hipFuncSetAttribute((const void*)mk_fwd, hipFuncAttributeMaxDynamicSharedMemorySize, LDS_BYTES) != hipSuccess) { fprintf(stderr, "kernel_launch: hipFuncSetAttribute failed\n"); grid = -1; return; }
        if (hipOccupancyMaxActiveBlocksPerMultiprocessor(&per_cu, (const void*)mk_fwd, NWAVES * 64, LDS_BYTES) != hipSuccess || per_cu < 1) { fprintf(stderr, "kernel_launch: occupancy query says %d\n", per_cu); per_cu = 1; }
        (void)hipGetLastError();
        grid = cus;
    }
    if (grid < 0) return;
    (void)hipMemsetAsync((char*)d_ws + WS_CTL, 0, CTL_ZERO_BYTES, stream);
    Args a{};
    for (int i = 0; i < 20; ++i) a.in[i] = (const float*)d_in[i];
    a.out = (float*)d_out; a.ws = (unsigned char*)d_ws;
#if MK_ONE_LAUNCH
    a.ph_lo = 0; a.ph_hi = N_PHASES;
    void* kargs[] = {&a};
    hipError_t e = hipLaunchCooperativeKernel((const void*)mk_fwd, dim3(grid), dim3(NWAVES * 64), kargs, LDS_BYTES, stream);
    if (e != hipSuccess) fprintf(stderr, "kernel_launch: cooperative launch failed: %s\n", hipGetErrorString(e));
#else
    for (int ph = 0; ph < N_PHASES; ++ph) { a.ph_lo = ph; a.ph_hi = ph + 1; hipLaunchKernelGGL(mk_fwd, dim3(grid), dim3(NWAVES * 64), LDS_BYTES, stream, a); }
#endif
}
```

```cpp
#include <hip/hip_runtime.h>
#include <hip/hip_cooperative_groups.h>
#include <cstdio>
#include <cstdint>
namespace cg = cooperative_groups;
namespace pg8 {
#define PG8_LAS __attribute__((address_space(3)))
typedef unsigned short bf16_t;
typedef short bf16x8 __attribute__((ext_vector_type(8)));
typedef float f32x4 __attribute__((ext_vector_type(4)));
typedef unsigned u32x4 __attribute__((ext_vector_type(4)));
constexpr int BM = 256, BK = 64, HALF = 128, HTB = HALF * BK * 2  , STAGE_BYTES = 8 * HTB, NXCD = 8, WGM = 8;

__host__ __device__ __forceinline__ int lds_byte(int r, int c) { const int st = (r >> 4) * 2 + (c >> 5), rr = r & 15, cc = c & 31, ob = rr * 64 + cc * 2; return st * 1024 + (ob ^ (((ob >> 9) & 1) << 5)); }
__host__ __device__ __forceinline__ void stage_rc(int b, int& R, int& C) { const int st = b / 1024, sb = b % 1024, swz = sb ^ (((sb >> 9) & 1) << 5); R = (st >> 1) * 16 + swz / 64; C = (st & 1) * 32 + (swz % 64) / 2; }
__host__ __device__ __forceinline__ int perm32(int rho) { const int n = rho >> 4, i = rho & 15; return 8 * (i >> 2) + 4 * n + (i & 3); }

struct Unit { int pm, pn; };
struct Gemm { const bf16_t* A; const bf16_t* Bt; int M, N, K; };

struct StaticOrder {
    int nM, nN, nwg, G, c;
    __host__ __device__ void init(int M, int N, int G_, int c_) { nM = M / BM; nN = N / BM; nwg = nM * nN; G = G_; c = c_; }
    __host__ __device__ bool next(int i, Unit& u) const {
        const long L = (long)i * G + c; if (L >= nwg) return false;
        int wgid = (int)L; { const int q = nwg / NXCD, r = nwg % NXCD, xcd = wgid % NXCD, off = wgid / NXCD; wgid = (xcd < r ? xcd * (q + 1) : r * (q + 1) + (xcd - r) * q) + off; }
        const int nig = WGM * nN, gid = wgid / nig, fm = gid * WGM, gsz = (nM - fm) < WGM ? (nM - fm) : WGM;
        u.pm = fm + ((wgid % nig) % gsz); u.pn = (wgid % nig) / gsz; return true;
    }
    __device__ __forceinline__ void a_ready(const Unit&) const {}
    __device__ __forceinline__ void done(const Unit&) const {}
};

__device__ __forceinline__ unsigned cvt_pk_bf16(float lo, float hi) { unsigned r; asm volatile("v_cvt_pk_bf16_f32 %0, %1, %2" : "=v"(r) : "v"(lo), "v"(hi)); return r; }
typedef float f32x2 __attribute__((ext_vector_type(2)));
__device__ __forceinline__ float rs_of(float ss) { return rsqrtf(ss * (1.0f / 1024.0f) + 1e-6f); }
struct EpiSwiGLU {
    static constexpr bool PERM = true, AFTER_DRAIN = false;
    bf16_t* H; int ldh; const float* ss;
    __device__ __forceinline__ void operator()(const f32x4 (&acc)[2][2][4][2], const Unit& u, int wr, int wc, int fr, int fq) const {
        const int row0 = u.pm * BM + wr * 64 + fr, col0 = u.pn * HALF + wc * 32 + 8 * fq;
#pragma unroll
        for (int ai = 0; ai < 2; ++ai)
#pragma unroll
            for (int m = 0; m < 4; ++m) {
                const int row = row0 + ai * HALF + m * 16; const float rs = rs_of(ss[row]);
                unsigned ww[4];
#pragma unroll
                for (int n = 0; n < 2; ++n) { const f32x4 g = acc[ai][0][m][n] * rs, up = acc[ai][1][m][n] * rs; f32x4 hh;
#pragma unroll
                    for (int e = 0; e < 4; ++e) hh[e] = g[e] * __builtin_amdgcn_rcpf(1.0f + __builtin_amdgcn_exp2f(-1.4426950408889634f * g[e])) * up[e];
                    ww[2 * n] = cvt_pk_bf16(hh[0], hh[1]); ww[2 * n + 1] = cvt_pk_bf16(hh[2], hh[3]); }
                *(u32x4*)(H + (size_t)row * ldh + col0) = (u32x4){ww[0], ww[1], ww[2], ww[3]};
            }
    }
};
template <bool XF32> struct EpiResid {
    static constexpr bool PERM = true, AFTER_DRAIN = false;
    const float* xold; bf16_t* xb; float* ssq; float alpha;
    __device__ __forceinline__ void operator()(const f32x4 (&acc)[2][2][4][2], const Unit& u, int wr, int wc, int fr, int fq) const {
        const int row0 = u.pm * BM + wr * 64 + fr, colb = u.pn * BM + wc * 32 + 8 * fq;
#pragma unroll
        for (int ai = 0; ai < 2; ++ai)
#pragma unroll
            for (int m = 0; m < 4; ++m) {
                const int row = row0 + ai * HALF + m * 16; float s = 0.f;
#pragma unroll
                for (int bj = 0; bj < 2; ++bj) { const size_t off = (size_t)row * 1024 + colb + bj * HALF;
                    f32x4 o0, o1;
                    if (XF32) { o0 = *(const f32x4*)(xold + off); o1 = *(const f32x4*)(xold + off + 4); }
                    else { const u32x4 pw = *(const u32x4*)(xb + off);
                        o0[0] = __uint_as_float(pw[0] << 16); o0[1] = __uint_as_float(pw[0] & 0xffff0000u); o0[2] = __uint_as_float(pw[1] << 16); o0[3] = __uint_as_float(pw[1] & 0xffff0000u);
                        o1[0] = __uint_as_float(pw[2] << 16); o1[1] = __uint_as_float(pw[2] & 0xffff0000u); o1[2] = __uint_as_float(pw[3] << 16); o1[3] = __uint_as_float(pw[3] & 0xffff0000u); }
                    const f32x4 v0 = o0 + acc[ai][bj][m][0] * alpha, v1 = o1 + acc[ai][bj][m][1] * alpha;
                    *(u32x4*)(xb + off) = (u32x4){cvt_pk_bf16(v0[0], v0[1]), cvt_pk_bf16(v0[2], v0[3]), cvt_pk_bf16(v1[0], v1[1]), cvt_pk_bf16(v1[2], v1[3])};
                    s += (v0[0] * v0[0] + v0[1] * v0[1]) + (v0[2] * v0[2] + v0[3] * v0[3]) + (v1[0] * v1[0] + v1[1] * v1[1]) + (v1[2] * v1[2] + v1[3] * v1[3]); }
                s += __shfl_xor(s, 16); s += __shfl_xor(s, 32);
                if (fq == 0) __hip_atomic_fetch_add(ssq + row, s, __ATOMIC_RELAXED, __HIP_MEMORY_SCOPE_AGENT);
            }
    }
};
struct EpiScaleBf16 {
    static constexpr bool PERM = true, AFTER_DRAIN = false;
    bf16_t* O; int ldc; const float* ss;
    __device__ __forceinline__ void operator()(const f32x4 (&acc)[2][2][4][2], const Unit& u, int wr, int wc, int fr, int fq) const {
        const int row0 = u.pm * BM + wr * 64 + fr, colb = u.pn * BM + wc * 32 + 8 * fq;
#pragma unroll
        for (int ai = 0; ai < 2; ++ai)
#pragma unroll
            for (int m = 0; m < 4; ++m) {
                const int row = row0 + ai * HALF + m * 16; const float rs = ss ? rs_of(ss[row]) : 1.0f;
#pragma unroll
                for (int bj = 0; bj < 2; ++bj) { const f32x4 v0 = acc[ai][bj][m][0] * rs, v1 = acc[ai][bj][m][1] * rs;
                    *(u32x4*)(O + (size_t)row * ldc + colb + bj * HALF) = (u32x4){cvt_pk_bf16(v0[0], v0[1]), cvt_pk_bf16(v0[2], v0[3]), cvt_pk_bf16(v1[0], v1[1]), cvt_pk_bf16(v1[2], v1[3])}; }
            }
    }
};
struct EpiPle {
    static constexpr bool PERM = true, AFTER_DRAIN = false;
    const bf16_t* xold; float* out; const bf16_t* PP; const float* ss;
    __device__ __forceinline__ void operator()(const f32x4 (&acc)[2][2][4][2], const Unit& u, int wr, int wc, int fr, int fq) const {
        const int row0 = u.pm * BM + wr * 64 + fr, colb = u.pn * BM + wc * 32 + 8 * fq;
#pragma unroll
        for (int ai = 0; ai < 2; ++ai)
#pragma unroll
            for (int m = 0; m < 4; ++m) {
                const int row = row0 + ai * HALF + m * 16; const float rs = rs_of(ss[row]) * -1.4426950408889634f;
#pragma unroll
                for (int bj = 0; bj < 2; ++bj) { const size_t off = (size_t)row * 1024 + colb + bj * HALF;
                    const u32x4 xw = *(const u32x4*)(xold + off); const u32x4 pw = *(const u32x4*)(PP + off); f32x4 o0, o1;
                    o0[0] = __uint_as_float(xw[0] << 16); o0[1] = __uint_as_float(xw[0] & 0xffff0000u); o0[2] = __uint_as_float(xw[1] << 16); o0[3] = __uint_as_float(xw[1] & 0xffff0000u);
                    o1[0] = __uint_as_float(xw[2] << 16); o1[1] = __uint_as_float(xw[2] & 0xffff0000u); o1[2] = __uint_as_float(xw[3] << 16); o1[3] = __uint_as_float(xw[3] & 0xffff0000u);
                    f32x4 p0, p1; p0[0] = __uint_as_float(pw[0] << 16); p0[1] = __uint_as_float(pw[0] & 0xffff0000u); p0[2] = __uint_as_float(pw[1] << 16); p0[3] = __uint_as_float(pw[1] & 0xffff0000u);
                    p1[0] = __uint_as_float(pw[2] << 16); p1[1] = __uint_as_float(pw[2] & 0xffff0000u); p1[2] = __uint_as_float(pw[3] << 16); p1[3] = __uint_as_float(pw[3] & 0xffff0000u);
                    f32x4 v0, v1;
#pragma unroll
                    for (int e = 0; e < 4; ++e) { v0[e] = o0[e] + __builtin_amdgcn_rcpf(1.0f + __builtin_amdgcn_exp2f(acc[ai][bj][m][0][e] * rs)) * p0[e];
                                                  v1[e] = o1[e] + __builtin_amdgcn_rcpf(1.0f + __builtin_amdgcn_exp2f(acc[ai][bj][m][1][e] * rs)) * p1[e]; }
                    *(f32x4*)(out + off) = v0; *(f32x4*)(out + off + 4) = v1; }
            }
    }
};
template <class Epi, class Sched, bool ALIGN_EPI = false, bool SP2 = false>
__device__ __forceinline__ void gemm_phase(PG8_LAS unsigned char* lds, const Gemm g, const Sched& S, const Epi& E) {
    const int tid = threadIdx.x, wid = __builtin_amdgcn_readfirstlane(tid >> 6), lane = tid & 63, wr = wid >> 2, wc = wid & 3, fr = lane & 15, fq = lane >> 4;
    const int K = g.K, nt = K / BK;
    unsigned voffA[2], voffB[2];
#pragma unroll
    for (int i = 0; i < 2; ++i) { int R, C; stage_rc(tid * 16 + i * 8192, R, C); const int Rb = Epi::PERM ? ((R & ~31) + perm32(R & 31)) : R;
        voffA[i] = (unsigned)(R * K + C) * 2u; voffB[i] = (unsigned)(Rb * K + C) * 2u; }
    const size_t kstep = (size_t)(BK * 2);
    const size_t hstep = (size_t)HALF * K * 2;
    const size_t tstep = 2 * hstep;
    const unsigned ldsw = (unsigned)wid * 1024u;
    const int aoff = lds_byte(wr * 64 + fr, fq * 8), boff = lds_byte(wc * 32 + fr, fq * 8);
#define PG8_SA(b, h) (((b) * 2 + (h)) * HTB)
#define PG8_SB(b, h) ((4 + (b) * 2 + (h)) * HTB)
#define PG8_STAGE(bufoff, gbase, voff) do { _Pragma("unroll") for (int _i = 0; _i < 2; ++_i) \
        __builtin_amdgcn_global_load_lds((const unsigned*)((const char*)(gbase) + (voff)[_i]), (PG8_LAS unsigned*)(lds + (bufoff) + ldsw + _i * 8192), 16, 0, 0); } while (0)
#define PG8_LDA(dst, b, h) do { _Pragma("unroll") for (int m = 0; m < 4; ++m) _Pragma("unroll") for (int k = 0; k < 2; ++k) dst[m][k] = *(const PG8_LAS bf16x8*)(lds + PG8_SA(b, h) + aoff + m * 2048 + k * 1024); } while (0)
#define PG8_LDB(dst, b, h) do { _Pragma("unroll") for (int n = 0; n < 2; ++n) _Pragma("unroll") for (int k = 0; k < 2; ++k) dst[n][k] = *(const PG8_LAS bf16x8*)(lds + PG8_SB(b, h) + boff + n * 2048 + k * 1024); } while (0)
#define PG8_MMA(ai, bj, At, Bt) do { __builtin_amdgcn_s_setprio(1); _Pragma("unroll") for (int m = 0; m < 4; ++m) _Pragma("unroll") for (int n = 0; n < 2; ++n) _Pragma("unroll") for (int k = 0; k < 2; ++k) \
        acc[ai][bj][m][n] = __builtin_amdgcn_mfma_f32_16x16x32_bf16(Bt[n][k], At[m][k], acc[ai][bj][m][n], 0, 0, 0); __builtin_amdgcn_s_setprio(0); } while (0)
#define PG8_WAIT_V(n) asm volatile("s_waitcnt vmcnt(" #n ")" ::: "memory")
#define PG8_WAIT_L(n) asm volatile("s_waitcnt lgkmcnt(" #n ")" ::: "memory")
#define PG8_BAR __builtin_amdgcn_s_barrier()
#define PG8_SCHED __builtin_amdgcn_sched_barrier(0)
    Unit cur, nxt; int ui = 0;
    if (!S.next(0, cur)) return;
    f32x4 acc[2][2][4][2];
#pragma unroll
    for (int a = 0; a < 2; ++a)
#pragma unroll
        for (int b = 0; b < 2; ++b)
#pragma unroll
            for (int m = 0; m < 4; ++m)
#pragma unroll
                for (int n = 0; n < 2; ++n) acc[a][b][m][n] = (f32x4){0.f, 0.f, 0.f, 0.f};
    bf16x8 At[4][2], B0[2][2], B1[2][2];
    const char* cA = (const char*)g.A + (size_t)cur.pm * tstep; const char* cB = (const char*)g.Bt + (size_t)cur.pn * tstep;
    S.a_ready(cur);
    if constexpr (SP2) {
        PG8_STAGE(PG8_SB(0, 0), cB, voffB); PG8_STAGE(PG8_SB(0, 1), cB + hstep, voffB); PG8_STAGE(PG8_SA(0, 0), cA, voffA); PG8_STAGE(PG8_SA(0, 1), cA + hstep, voffA);
        if (wr == 1) PG8_BAR;
        PG8_WAIT_V(2); PG8_BAR;
        PG8_STAGE(PG8_SB(1, 0), cB + kstep, voffB); PG8_STAGE(PG8_SA(1, 0), cA + kstep, voffA); PG8_STAGE(PG8_SB(1, 1), cB + hstep + kstep, voffB);
        PG8_WAIT_V(6); PG8_BAR;
    } else {
        PG8_STAGE(PG8_SB(0, 0), cB, voffB); PG8_STAGE(PG8_SA(0, 0), cA, voffA); PG8_STAGE(PG8_SB(0, 1), cB + hstep, voffB); PG8_STAGE(PG8_SA(0, 1), cA + hstep, voffA);
        if (wr == 1) PG8_BAR;
        PG8_WAIT_V(4); PG8_BAR;
        PG8_STAGE(PG8_SB(1, 0), cB + kstep, voffB); PG8_STAGE(PG8_SA(1, 0), cA + kstep, voffA); PG8_STAGE(PG8_SB(1, 1), cB + hstep + kstep, voffB);
        PG8_WAIT_V(6); PG8_BAR;
    }
    for (;;) {
        const bool has_next = S.next(ui + 1, nxt);
        const char* nA = has_next ? (const char*)g.A + (size_t)nxt.pm * tstep : cA; const char* nB = has_next ? (const char*)g.Bt + (size_t)nxt.pn * tstep : cB;
        for (int t = 0; t < nt; t += 2) {
            const bool last = (t == nt - 2);
            const char* a1 = cA + (size_t)(t + 1) * kstep;
            const char* a2 = last ? nA : cA + (size_t)(t + 2) * kstep; const char* b2 = last ? nB : cB + (size_t)(t + 2) * kstep;
            const char* a3 = a2 + kstep; const char* b3 = b2 + kstep;
            if (last && has_next) S.a_ready(nxt);
            if constexpr (SP2) {
            PG8_LDB(B0, 0, 0); PG8_LDB(B1, 0, 1); PG8_SCHED; PG8_LDA(At, 0, 0); PG8_STAGE(PG8_SA(1, 1), a1 + hstep, voffA);
            PG8_WAIT_V(8); PG8_WAIT_L(0); PG8_BAR; PG8_MMA(0, 0, At, B0); PG8_MMA(0, 1, At, B1); PG8_BAR; PG8_SCHED;
            PG8_LDA(At, 0, 1); PG8_STAGE(PG8_SB(0, 0), b2, voffB); PG8_STAGE(PG8_SB(0, 1), b2 + hstep, voffB); PG8_STAGE(PG8_SA(0, 0), a2, voffA);
            PG8_WAIT_V(8); PG8_WAIT_L(0); PG8_BAR; PG8_MMA(1, 0, At, B0); PG8_MMA(1, 1, At, B1); PG8_BAR; PG8_SCHED;
            PG8_LDB(B0, 1, 0); PG8_LDB(B1, 1, 1); PG8_SCHED; PG8_LDA(At, 1, 0); PG8_STAGE(PG8_SA(0, 1), a2 + hstep, voffA);
            PG8_WAIT_V(8); PG8_WAIT_L(0); PG8_BAR; PG8_MMA(0, 0, At, B0); PG8_MMA(0, 1, At, B1); PG8_BAR; PG8_SCHED;
            PG8_LDA(At, 1, 1); PG8_STAGE(PG8_SB(1, 0), b3, voffB); PG8_STAGE(PG8_SB(1, 1), b3 + hstep, voffB); PG8_STAGE(PG8_SA(1, 0), a3, voffA);
            PG8_WAIT_V(8); PG8_WAIT_L(0); PG8_BAR; PG8_MMA(1, 0, At, B0); PG8_MMA(1, 1, At, B1); PG8_BAR; PG8_SCHED;
            } else {
            PG8_LDB(B0, 0, 0); PG8_SCHED; PG8_LDA(At, 0, 0); PG8_STAGE(PG8_SA(1, 1), a1 + hstep, voffA);
            PG8_WAIT_L(8); PG8_BAR; PG8_WAIT_L(0); PG8_MMA(0, 0, At, B0); PG8_BAR; PG8_SCHED;
            PG8_LDB(B1, 0, 1); PG8_STAGE(PG8_SB(0, 0), b2, voffB);
            PG8_BAR; PG8_WAIT_L(0); PG8_MMA(0, 1, At, B1); PG8_BAR;
            PG8_LDA(At, 0, 1); PG8_STAGE(PG8_SA(0, 0), a2, voffA);
            PG8_BAR; PG8_WAIT_L(0); PG8_MMA(1, 0, At, B0); PG8_BAR; PG8_SCHED;
            PG8_STAGE(PG8_SB(0, 1), b2 + hstep, voffB);
            PG8_WAIT_V(6); PG8_BAR; PG8_MMA(1, 1, At, B1); PG8_BAR;
            PG8_LDB(B0, 1, 0); PG8_SCHED; PG8_LDA(At, 1, 0); PG8_STAGE(PG8_SA(0, 1), a2 + hstep, voffA);
            PG8_WAIT_L(8); PG8_BAR; PG8_WAIT_L(0); PG8_MMA(0, 0, At, B0); PG8_BAR; PG8_SCHED;
            PG8_LDB(B1, 1, 1); PG8_STAGE(PG8_SB(1, 0), b3, voffB);
            PG8_BAR; PG8_WAIT_L(0); PG8_MMA(0, 1, At, B1); PG8_BAR;
            PG8_LDA(At, 1, 1); PG8_STAGE(PG8_SA(1, 0), a3, voffA);
            PG8_BAR; PG8_WAIT_L(0); PG8_MMA(1, 0, At, B0); PG8_BAR; PG8_SCHED;
            PG8_STAGE(PG8_SB(1, 1), b3 + hstep, voffB);
            PG8_WAIT_V(6); PG8_BAR; PG8_MMA(1, 1, At, B1); PG8_BAR;
            }
        }
        if constexpr (ALIGN_EPI) { if (wr == 0) PG8_BAR; }
        if constexpr (!Epi::AFTER_DRAIN) { E(acc, cur, wr, wc, fr, fq); S.done(cur); }
        if (!has_next) break;
#pragma unroll
        for (int a = 0; a < 2; ++a)
#pragma unroll
            for (int b = 0; b < 2; ++b)
#pragma unroll
                for (int m = 0; m < 4; ++m)
#pragma unroll
                    for (int n = 0; n < 2; ++n) acc[a][b][m][n] = (f32x4){0.f, 0.f, 0.f, 0.f};
        cur = nxt; cA = nA; cB = nB; ++ui;
        if constexpr (ALIGN_EPI) { if (wr == 1) PG8_BAR; }
    }
    PG8_WAIT_V(0);
    if constexpr (!ALIGN_EPI) { if (wr == 0) PG8_BAR; }
    PG8_BAR;
    if constexpr (Epi::AFTER_DRAIN) { E.fused(acc, cur, wr, wc, fr, fq, lds, wid, lane); S.done(cur); }
#undef PG8_SA
#undef PG8_SB
#undef PG8_STAGE
#undef PG8_LDA
#undef PG8_LDB
#undef PG8_MMA
#undef PG8_WAIT_V
#undef PG8_WAIT_L
#undef PG8_BAR
#undef PG8_SCHED
}
}

constexpr int NWAVES = 8;
constexpr int BATCH = 4, SEQ = 8192, D = 1024, FF = 2816, NPROJ = 3072, PLE = 256, NH = 8, HD = 64, CONVD = 512;
constexpr int M = BATCH * SEQ;
#ifndef PROBE_DUP
#define PROBE_DUP 0
#endif
#ifndef MK_ONE_LAUNCH
#define MK_ONE_LAUNCH 1
#endif
constexpr int N_PHASES = 10;
constexpr size_t MiB = 1u << 20;
constexpr size_t WS_CTL = 0, CTL_ZERO_BYTES = 1 * MiB;
constexpr size_t WS_W1GU = 2 * MiB, WS_W1D = 13 * MiB, WS_WIN = 19 * MiB, WS_WOUT = 25 * MiB, WS_W2GU = 27 * MiB, WS_W2D = 38 * MiB, WS_WPG = 44 * MiB, WS_WPP = 46 * MiB;
constexpr size_t WS_XB = 48 * MiB;
constexpr size_t WS_PB = 112 * MiB;
constexpr size_t WS_HID = 128 * MiB;
constexpr size_t WS_YMIX = 320 * MiB;
constexpr size_t WS_PP = 384 * MiB;
constexpr size_t WS_END = 448 * MiB;
#ifndef ATTN_NAIVE
#define ATTN_NAIVE 0
#endif
constexpr float QSC = ATTN_NAIVE ? 0.125f : 0.125f * 1.4426950408889634f;
constexpr int LDS_BYTES = 147456;

#define GAS __attribute__((address_space(1)))
#define LAS __attribute__((address_space(3)))
typedef unsigned short bf16;
typedef unsigned v4u __attribute__((ext_vector_type(4)));
typedef float f32x4 __attribute__((ext_vector_type(4)));
#define LDS_WAIT() asm volatile("s_waitcnt lgkmcnt(0)" ::: "memory")
__device__ __forceinline__ unsigned pk2(float lo, float hi) { return pg8::cvt_pk_bf16(lo, hi); }
__device__ __forceinline__ float bflo(unsigned w) { return __uint_as_float(w << 16); }
__device__ __forceinline__ float bfhi(unsigned w) { return __uint_as_float(w & 0xffff0000u); }
__device__ __forceinline__ float wave_sum(float v) {
#pragma unroll
    for (int o = 1; o < 64; o <<= 1) v += __shfl_xor(v, o);
    return v;
}

#define XB_TMO      128
#define XB_XCNT(j)  (256  + 64 * (j))
#define XB_XSUB(j)  (1280 + 64 * (j))
#define XB_XGEN(j)  (2304 + 64 * (j))
#define XB_TOP      3328
#define XB_TOPGEN   3392
#define XCD_BAR_WORDS 3456
#define XB_SPIN_CAP (1u << 18)

__device__ __forceinline__ unsigned xb_ld(unsigned* p)              { return __hip_atomic_load(p, __ATOMIC_RELAXED, __HIP_MEMORY_SCOPE_AGENT); }
__device__ __forceinline__ unsigned xb_add(unsigned* p, unsigned v) { return __hip_atomic_fetch_add(p, v, __ATOMIC_RELAXED, __HIP_MEMORY_SCOPE_AGENT); }
__device__ __forceinline__ unsigned xb_xcc_id() { return (unsigned)__builtin_amdgcn_s_getreg((3 << 11) | 20) & 0xFu; }
#define XB_SPIN(cond, bar) do { unsigned _sp = 0; while (cond) { __builtin_amdgcn_s_sleep(1); \
    if ((++_sp & 255u) == 0u) { if (xb_ld(&(bar)[XB_TMO])) break; if (_sp > XB_SPIN_CAP) { atomicAdd(&(bar)[XB_TMO], 1u); break; } } } } while (0)

struct XcdBarrier {
    unsigned* bar; unsigned x;
    volatile LAS unsigned* st;
};

__device__ __forceinline__ XcdBarrier xcd_barrier_post(unsigned* bar, volatile LAS unsigned* st) {
    XcdBarrier b; b.bar = bar; b.x = xb_xcc_id(); b.st = st;
    if (threadIdx.x == 0) (void)xb_add(&bar[XB_XCNT(b.x)], 1u);
    return b;
}
__device__ __forceinline__ void xcd_barrier_complete(unsigned* bar, unsigned x, unsigned& nloc, unsigned& nx) {
    const unsigned G = gridDim.x * gridDim.y * gridDim.z;
    unsigned sum, cnt, mine, sp = 0u;
    for (;;) {
        sum = 0u; cnt = 0u; mine = 0u;
#pragma unroll
        for (unsigned j = 0; j < 16; ++j) { const unsigned c = xb_ld(&bar[XB_XCNT(j)]); sum += c; cnt += (c > 0u) ? 1u : 0u; mine = (j == x) ? c : mine; }
        if (sum == G) break;
        __builtin_amdgcn_s_sleep(1);
        if ((++sp & 255u) == 0u) { if (xb_ld(&bar[XB_TMO])) break; if (sp > XB_SPIN_CAP) { atomicAdd(&bar[XB_TMO], 1u); break; } }
    }
    nloc = mine > 0u ? mine : 1u; nx = cnt > 0u ? cnt : 1u;
}

__device__ __forceinline__ void xcd_barrier(const XcdBarrier& b) {
    asm volatile("s_waitcnt vmcnt(0)" ::: "memory");
    __syncthreads();
    if (threadIdx.x == 0) {
        unsigned* bar = b.bar;
        __builtin_amdgcn_s_waitcnt(0);
        unsigned nloc = b.st[0], nx = b.st[1];
        if (nloc == 0u) { xcd_barrier_complete(bar, b.x, nloc, nx); b.st[0] = nloc; b.st[1] = nx; }
        const unsigned old = xb_add(&bar[XB_XSUB(b.x)], 1u);
        const unsigned gen = old / nloc;
        if (old + 1u == (gen + 1u) * nloc) {
            __builtin_amdgcn_fence(__ATOMIC_RELEASE, "agent");
            asm volatile("s_waitcnt vmcnt(0)" ::: "memory");
            const unsigned og = xb_add(&bar[XB_TOP], 1u);
            const unsigned tg = og / nx;
            if (og + 1u == (tg + 1u) * nx) xb_add(&bar[XB_TOPGEN], 1u);
            else XB_SPIN(xb_ld(&bar[XB_TOPGEN]) == tg, bar);
            __builtin_amdgcn_fence(__ATOMIC_ACQUIRE, "agent");
            xb_add(&bar[XB_XGEN(b.x)], 1u);
            asm volatile("s_waitcnt vmcnt(0)" ::: "memory");
        } else {
            XB_SPIN(xb_ld(&bar[XB_XGEN(b.x)]) == gen, bar);
            __builtin_amdgcn_fence(__ATOMIC_ACQUIRE, "agent");
            asm volatile("s_waitcnt vmcnt(0)" ::: "memory");
        }
    }
    __syncthreads();
}

constexpr size_t WS_BAR = 768 * 1024;
struct Args { const float* in[20]; float* out; unsigned char* ws; int ph_lo, ph_hi; };

__device__ __forceinline__ void tr_item(const float* __restrict__ W, int K, int N, const float* __restrict__ gain, bf16* __restrict__ WT, int dst_row0, LAS float* scr, int k0, int n0, int lane) {
    float w[32]; const float* wp = W + (size_t)(k0 + (lane >> 5)) * N + n0 + (lane & 31);
#pragma unroll
    for (int i = 0; i < 32; ++i) w[i] = wp[(size_t)(2 * i) * N];
    if (gain) {
#pragma unroll
        for (int i = 0; i < 32; ++i) w[i] *= gain[k0 + 2 * i + (lane >> 5)];
    }
#pragma unroll
    for (int i = 0; i < 32; ++i) scr[(2 * i + (lane >> 5)) * 33 + (lane & 31)] = w[i];
    LDS_WAIT(); asm volatile("" ::: "memory");
    const int c = lane & 7;
#pragma unroll
    for (int j = 0; j < 4; ++j) { const int n = (lane >> 3) + 8 * j; const LAS float* s = scr + (8 * c) * 33 + n;
        v4u o; o.x = pk2(s[0 * 33], s[1 * 33]); o.y = pk2(s[2 * 33], s[3 * 33]); o.z = pk2(s[4 * 33], s[5 * 33]); o.w = pk2(s[6 * 33], s[7 * 33]);
        *(v4u*)(WT + (size_t)(dst_row0 + n) * K + k0 + 8 * c) = o; }
    LDS_WAIT(); asm volatile("" ::: "memory");
}
__device__ __forceinline__ bool tr_matrix(int& r, const float* W, int K, int N, const float* gain, bf16* WT, int mode, LAS float* scr, int lane) {
    const int nblk = N / 32, items = (K / 64) * nblk;
    if (r >= items) { r -= items; return false; }
    const int kb = r / nblk, nb = r % nblk, n0 = 32 * nb;
    const int dst = mode == 0 ? n0 : (256 * (n0 >> 7) + (n0 & 127) + (mode == 2 ? 128 : 0));
    tr_item(W, K, N, gain, WT, dst, scr, 64 * kb, n0, lane);
    return true;
}
__device__ __forceinline__ void p0_prep(const Args& a, LAS unsigned char* lds, int gw, int NGW, int lane, int wave) {
    unsigned char* ws = a.ws;
    LAS float* scr = (LAS float*)(lds + wave * 16384);
    constexpr int I_GU = (D / 64) * (FF / 32), I_DN = (FF / 64) * (D / 32), I_IN = (D / 64) * (NPROJ / 32), I_SQ = (D / 64) * (D / 32), I_PP = (PLE / 64) * (D / 32);
    constexpr int NITEMS = 4 * I_GU + 2 * I_DN + I_IN + 2 * I_SQ + I_PP;
    for (int it = gw; it < NITEMS; it += NGW) {
        int r = it;
        if (tr_matrix(r, a.in[3], D, FF, a.in[2], (bf16*)(ws + WS_W1GU), 1, scr, lane)) continue;
        if (tr_matrix(r, a.in[4], D, FF, a.in[2], (bf16*)(ws + WS_W1GU), 2, scr, lane)) continue;
        if (tr_matrix(r, a.in[14], D, FF, a.in[13], (bf16*)(ws + WS_W2GU), 1, scr, lane)) continue;
        if (tr_matrix(r, a.in[15], D, FF, a.in[13], (bf16*)(ws + WS_W2GU), 2, scr, lane)) continue;
        if (tr_matrix(r, a.in[5], FF, D, nullptr, (bf16*)(ws + WS_W1D), 0, scr, lane)) continue;
        if (tr_matrix(r, a.in[16], FF, D, nullptr, (bf16*)(ws + WS_W2D), 0, scr, lane)) continue;
        if (tr_matrix(r, a.in[7], D, NPROJ, a.in[6], (bf16*)(ws + WS_WIN), 0, scr, lane)) continue;
        if (tr_matrix(r, a.in[12], D, D, nullptr, (bf16*)(ws + WS_WOUT), 0, scr, lane)) continue;
        if (tr_matrix(r, a.in[18], D, D, a.in[17], (bf16*)(ws + WS_WPG), 0, scr, lane)) continue;
        tr_matrix(r, a.in[19], PLE, D, nullptr, (bf16*)(ws + WS_WPP), 0, scr, lane);
    }
    const float* __restrict__ x = a.in[0]; bf16* __restrict__ XB = (bf16*)(ws + WS_XB); float* __restrict__ ss1 = (float*)(ws + WS_CTL);
    for (int m0 = gw * 4; m0 < M; m0 += NGW * 4) {
        f32x4 v[4][4];
#pragma unroll
        for (int r = 0; r < 4; ++r)
#pragma unroll
            for (int j = 0; j < 4; ++j) v[r][j] = ((const f32x4*)(x + (size_t)(m0 + r) * D) + lane)[64 * j];
#pragma unroll
        for (int r = 0; r < 4; ++r) { float s = 0.f;
#pragma unroll
            for (int j = 0; j < 4; ++j) s += (v[r][j].x * v[r][j].x + v[r][j].y * v[r][j].y) + (v[r][j].z * v[r][j].z + v[r][j].w * v[r][j].w);
            s = wave_sum(s);
            unsigned long long* o8 = (unsigned long long*)(XB + (size_t)(m0 + r) * D) + lane;
#pragma unroll
            for (int j = 0; j < 4; ++j) o8[64 * j] = (unsigned long long)pk2(v[r][j].x, v[r][j].y) | ((unsigned long long)pk2(v[r][j].z, v[r][j].w) << 32);
            if (lane == 0) ss1[m0 + r] = s; }
    }
    const float* __restrict__ p = a.in[1]; bf16* __restrict__ PB = (bf16*)(ws + WS_PB);
    for (int i0 = gw * 64 + lane; i0 < M * PLE / 8; i0 += NGW * 64 * 4) {
        f32x4 v0[4], v1[4];
#pragma unroll
        for (int r = 0; r < 4; ++r) { const size_t i = (size_t)i0 + (size_t)r * NGW * 64; v0[r] = *(const f32x4*)(p + i * 8); v1[r] = *(const f32x4*)(p + i * 8 + 4); }
#pragma unroll
        for (int r = 0; r < 4; ++r) { const size_t i = (size_t)i0 + (size_t)r * NGW * 64; *(v4u*)(PB + i * 8) = (v4u){pk2(v0[r].x, v0[r].y), pk2(v0[r].z, v0[r].w), pk2(v1[r].x, v1[r].y), pk2(v1[r].z, v1[r].w)}; }
    }
}

__device__ __forceinline__ void unpack8(const v4u w, float (&f)[8]) { f[0] = bflo(w.x); f[1] = bfhi(w.x); f[2] = bflo(w.y); f[3] = bfhi(w.y); f[4] = bflo(w.z); f[5] = bfhi(w.z); f[6] = bflo(w.w); f[7] = bfhi(w.w); }
__device__ __forceinline__ v4u pack8(const float (&f)[8]) { return (v4u){pk2(f[0], f[1]), pk2(f[2], f[3]), pk2(f[4], f[5]), pk2(f[6], f[7])}; }
__device__ __forceinline__ void p4_mixprep(const Args& a, int gw, int NGW, int lane) {
    bf16* PROJ = (bf16*)(a.ws + WS_HID); bf16* YMIX = (bf16*)(a.ws + WS_YMIX);
    const float* cw = a.in[8]; const float* cbp = a.in[9]; const float* gq = a.in[10]; const float* gk = a.in[11];
    float w0[8], w1[8], w2[8], cb[8], gqv[8], gkv[8];
#pragma unroll
    for (int i = 0; i < 8; ++i) { w0[i] = cw[8 * lane + i]; w1[i] = cw[CONVD + 8 * lane + i]; w2[i] = cw[2 * CONVD + 8 * lane + i]; cb[i] = cbp[8 * lane + i];
        gqv[i] = gq[(lane & 7) * 8 + i] * QSC; gkv[i] = gk[(lane & 7) * 8 + i]; }
    for (int ch = gw; ch < M / 16; ch += NGW) {
        const int r0 = ch * 16; float z1[8], z2[8];
        if ((r0 & (SEQ - 1)) == 0) {
#pragma unroll
            for (int i = 0; i < 8; ++i) { z1[i] = 0.f; z2[i] = 0.f; }
        } else {
            float c[8], u[8];
            const bf16* pr = PROJ + (size_t)(r0 - 1) * NPROJ + 8 * lane; unpack8(*(const v4u*)(pr + 512), c); unpack8(*(const v4u*)(pr + 1024), u);
#pragma unroll
            for (int i = 0; i < 8; ++i) z1[i] = c[i] * u[i];
            pr -= NPROJ; unpack8(*(const v4u*)(pr + 512), c); unpack8(*(const v4u*)(pr + 1024), u);
#pragma unroll
            for (int i = 0; i < 8; ++i) z2[i] = c[i] * u[i];
        }
        for (int r = r0; r < r0 + 16; ++r) {
            bf16* pr = PROJ + (size_t)r * NPROJ + 8 * lane;
            float b[8], c[8], u[8], q[8], k[8], y[8];
            unpack8(*(const v4u*)(pr), b); unpack8(*(const v4u*)(pr + 512), c); unpack8(*(const v4u*)(pr + 1024), u);
            unpack8(*(const v4u*)(pr + 1536), q); unpack8(*(const v4u*)(pr + 2048), k);
#pragma unroll
            for (int i = 0; i < 8; ++i) { const float z0 = c[i] * u[i]; y[i] = b[i] * (w0[i] * z2[i] + w1[i] * z1[i] + w2[i] * z0 + cb[i]); z2[i] = z1[i]; z1[i] = z0; }
            *(v4u*)(YMIX + (size_t)r * D + 8 * lane) = pack8(y);
            float sq = 0.f, sk = 0.f;
#pragma unroll
            for (int i = 0; i < 8; ++i) { sq += q[i] * q[i]; sk += k[i] * k[i]; }
            sq += __shfl_xor(sq, 1); sq += __shfl_xor(sq, 2); sq += __shfl_xor(sq, 4);
            sk += __shfl_xor(sk, 1); sk += __shfl_xor(sk, 2); sk += __shfl_xor(sk, 4);
            const float rq = rsqrtf(sq * (1.0f / 64.0f) + 1e-6f), rk = rsqrtf(sk * (1.0f / 64.0f) + 1e-6f);
#pragma unroll
            for (int i = 0; i < 8; ++i) { q[i] *= rq * gqv[i]; k[i] *= rk * gkv[i]; }
            *(v4u*)(pr + 1536) = pack8(q); *(v4u*)(pr + 2048) = pack8(k);
        }
    }
}

__device__ __forceinline__ void p5_attn_naive(const Args& a, int tid) {
    const bf16* PROJ = (const bf16*)(a.ws + WS_HID); bf16* YMIX = (bf16*)(a.ws + WS_YMIX);
    for (int un = blockIdx.x; un < 512; un += gridDim.x) {
        const int bh = un & 31, r = un >> 5, qq = r < 8 ? r : 23 - r, b = bh >> 3, h = bh & 7;
        const int t = qq * 512 + tid;
        const bf16* base = PROJ + (size_t)b * SEQ * NPROJ + h * HD;
        float q[64], o[64];
#pragma unroll
        for (int c = 0; c < 8; ++c) { float f[8]; unpack8(*(const v4u*)(base + (size_t)t * NPROJ + 1536 + 8 * c), f);
#pragma unroll
            for (int e = 0; e < 8; ++e) { q[8 * c + e] = f[e]; o[8 * c + e] = 0.f; } }
        float carry = 0.f;
        for (int j = qq * 512 + 511; j >= 0; --j) {
            const bf16* kr = base + (size_t)j * NPROJ + 2048; float z = 0.f;
#pragma unroll
            for (int c = 0; c < 8; ++c) { float f[8]; unpack8(*(const v4u*)(kr + 8 * c), f);
#pragma unroll
                for (int e = 0; e < 8; ++e) z += q[8 * c + e] * f[e]; }
            const bool act = j < t;
            const float sp = fmaxf(z, 0.f) + __logf(1.0f + __expf(-fabsf(z)));
            const float av = act ? __expf(z - sp + carry) : 0.f;
            carry -= act ? sp : 0.f;
            const bf16* vr = kr + 512;
#pragma unroll
            for (int c = 0; c < 8; ++c) { float f[8]; unpack8(*(const v4u*)(vr + 8 * c), f);
#pragma unroll
                for (int e = 0; e < 8; ++e) o[8 * c + e] += av * f[e]; }
        }
        bf16* orow = YMIX + (size_t)(b * SEQ + t) * D + 512 + h * HD;
#pragma unroll
        for (int c = 0; c < 8; ++c) { float f[8];
#pragma unroll
            for (int e = 0; e < 8; ++e) f[e] = o[8 * c + e];
            *(v4u*)(orow + 8 * c) = pack8(f); }
    }
}

namespace sba {
using bf16x8 = __attribute__((ext_vector_type(8))) short;
using s16x4 = __attribute__((ext_vector_type(4))) short;
using f32x16 = __attribute__((ext_vector_type(16))) float;
typedef short v4i16_t __attribute__((ext_vector_type(4)));
typedef float f32x2_t __attribute__((ext_vector_type(2))); typedef __bf16 bf16x2_t __attribute__((ext_vector_type(2)));
typedef __attribute__((address_space(3))) const char* lds_cptr;
constexpr int SLOTB = 8192, LDS_K = 0, LDS_V = 2 * SLOTB;
__device__ __forceinline__ void glds16(const void* gsrc, unsigned lds_dst) { unsigned keep;
    asm volatile("s_mov_b32 %0, m0\n\ts_mov_b32 m0, %2\n\ts_nop 0\n\tglobal_load_lds_dwordx4 %1, off\n\ts_mov_b32 m0, %0" : "=&s"(keep) : "v"(gsrc), "s"(lds_dst) : "memory"); }
__device__ __forceinline__ unsigned cvtpk_s(float lo, float hi) { f32x2_t v = {lo, hi}; bf16x2_t b = __builtin_convertvector(v, bf16x2_t); return __builtin_bit_cast(unsigned, b); }
__device__ __forceinline__ s16x4 vtr(lds_cptr p) { return __builtin_bit_cast(s16x4, __builtin_amdgcn_ds_read_tr16_b64_v4i16((__attribute__((address_space(3))) v4i16_t*)p)); }
#define SBA_MFMA(a, b, c) __builtin_amdgcn_mfma_f32_32x32x16_bf16((a), (b), (c), 0, 0, 0)

__device__ __forceinline__ void unit(int b, int hd, int qb, const unsigned short* PROJ, unsigned short* YMIX, char* shm) {
    const int tid = threadIdx.x, lane = tid & 63, r32 = lane & 31, hi = lane >> 5; const int wid = __builtin_amdgcn_readfirstlane(tid >> 6);
    const size_t rowbase = (size_t)b * SEQ; const int q0 = qb * 256;
    const unsigned short* Qw = PROJ + (rowbase + q0 + wid * 32) * NPROJ + 1536 + hd * 64;
    const unsigned short* Kh = PROJ + rowbase * NPROJ + 2048 + hd * 64; const unsigned short* Vh = Kh + 512;
    const unsigned lds0 = (unsigned)(uintptr_t)shm;
    const unsigned short* ksrc = Kh + (size_t)lane * NPROJ + wid * 8;
    const unsigned short* vsrc = Vh + (size_t)(16 * (wid & 3) + (lane >> 2)) * NPROJ + (wid >> 2) * 32 + (lane & 3) * 8;
    const unsigned kdst = lds0 + LDS_K + wid * 1024, vdst = lds0 + LDS_V + wid * 1024;
#define DMA_K(t, so) glds16(ksrc + (size_t)(t) * 64 * NPROJ, (unsigned)__builtin_amdgcn_readfirstlane(kdst + (so)))
#define DMA_V(t, so) glds16(vsrc + (size_t)(t) * 64 * NPROJ, (unsigned)__builtin_amdgcn_readfirstlane(vdst + (so)))
    const lds_cptr shm3 = (lds_cptr)shm;
    const lds_cptr kp0 = shm3 + LDS_K + hi * 1024 + r32 * 16;
    const lds_cptr vp0 = shm3 + LDS_V + ((lane >> 4) & 1) * 32 + (lane & 3) * 8 + (4 * hi + ((lane & 15) >> 2)) * 64;
    const int NT = 4 * (qb + 1);
    DMA_K(NT - 1, 0); DMA_V(NT - 1, 0);
    bf16x8 qr[4];
#pragma unroll
    for (int d0 = 0; d0 < 4; ++d0) qr[d0] = *reinterpret_cast<const bf16x8*>(&Qw[(size_t)r32 * NPROJ + d0 * 16 + hi * 8]);
    f32x16 o[2]; o[0] = f32x16{}; o[1] = f32x16{};
    float carry = 1.0f;
    const int qrel = wid * 32 + r32;
    int slot = 0;
    for (int t = NT - 1; t >= 0; --t) {
        asm volatile("s_waitcnt vmcnt(0) lgkmcnt(0)\n\ts_barrier" ::: "memory");
        if (t > 0) { DMA_K(t - 1, (slot ^ 1) * SLOTB); DMA_V(t - 1, (slot ^ 1) * SLOTB); }
        const lds_cptr kp = kp0 + slot * SLOTB;
        f32x16 p0 = f32x16{}, p1 = f32x16{};
#pragma unroll
        for (int d0 = 0; d0 < 4; ++d0) {
            const bf16x8 b0 = *(const __attribute__((address_space(3))) bf16x8*)(kp + d0 * 2048);
            const bf16x8 b1 = *(const __attribute__((address_space(3))) bf16x8*)(kp + d0 * 2048 + 512);
            p0 = SBA_MFMA(b0, qr[d0], p0); p1 = SBA_MFMA(b1, qr[d0], p1);
        }
        if (t >= NT - 4) {
            const int kb = 64 * (t - (NT - 4)) + 4 * hi;
#pragma unroll
            for (int r = 0; r < 16; ++r) { const int kv = kb + (r & 3) + 8 * (r >> 2); if (kv >= qrel) p0[r] = -INFINITY; if (kv + 32 >= qrel) p1[r] = -INFINITY; }
        }
        float kp_[2][16];
#pragma unroll
        for (int r = 0; r < 16; ++r) { kp_[0][r] = __builtin_amdgcn_rcpf(1.0f + __builtin_amdgcn_exp2f(p0[r])); kp_[1][r] = __builtin_amdgcn_rcpf(1.0f + __builtin_amdgcn_exp2f(p1[r])); }
        float av[2][16]; float st = carry;
#pragma unroll
        for (int p = 1; p >= 0; --p)
#pragma unroll
            for (int g = 3; g >= 0; --g) {
                const float k0 = kp_[p][4 * g], k1 = kp_[p][4 * g + 1], k2 = kp_[p][4 * g + 2], k3 = kp_[p][4 * g + 3];
                const float s1 = k3 * k2, s0 = s1 * k1, G = s0 * k0;
                const auto rr = __builtin_amdgcn_permlane32_swap(__float_as_uint(G), __float_as_uint(G), false, false);
                const float Glo = __uint_as_float(rr[0]), Ghi = __uint_as_float(rr[1]);
                const float base = st * (hi ? 1.0f : Ghi);
                av[p][4 * g + 3] = (1.0f - k3) * base; av[p][4 * g + 2] = (1.0f - k2) * (base * k3); av[p][4 * g + 1] = (1.0f - k1) * (base * s1); av[p][4 * g] = (1.0f - k0) * (base * s0);
                st = st * (Glo * Ghi);
            }
        carry = st;
        unsigned pw[4][4];
#pragma unroll
        for (int ks = 0; ks < 4; ++ks)
#pragma unroll
            for (int j = 0; j < 4; ++j) pw[ks][j] = cvtpk_s(av[ks >> 1][8 * (ks & 1) + 2 * j], av[ks >> 1][8 * (ks & 1) + 2 * j + 1]);
        const lds_cptr vp = vp0 + slot * SLOTB;
#pragma unroll
        for (int d0 = 0; d0 < 2; ++d0)
#pragma unroll
            for (int ks = 0; ks < 4; ++ks) {
                const s16x4 lo = vtr(vp + d0 * 4096 + ks * 1024), hh = vtr(vp + d0 * 4096 + ks * 1024 + 512);
                const bf16x8 vf = (bf16x8){lo[0], lo[1], lo[2], lo[3], hh[0], hh[1], hh[2], hh[3]};
                const bf16x8 pa = __builtin_bit_cast(bf16x8, (v4u){pw[ks][0], pw[ks][1], pw[ks][2], pw[ks][3]});
                o[d0] = SBA_MFMA(pa, vf, o[d0]);
            }
        slot ^= 1;
    }
    unsigned short* Ow = YMIX + (rowbase + q0 + wid * 32) * D + 512 + hd * 64;
#pragma unroll
    for (int r = 0; r < 16; ++r) { const int orow = (r & 3) + 8 * (r >> 2) + 4 * hi;
#pragma unroll
        for (int d0 = 0; d0 < 2; ++d0) Ow[(size_t)orow * D + d0 * 32 + r32] = (unsigned short)(cvtpk_s(o[d0][r], 0.f) & 0xffffu); }
#undef DMA_K
#undef DMA_V
}
__device__ __forceinline__ void phase(const unsigned short* PROJ, unsigned short* YMIX, char* shm) {
    const int G = gridDim.x, bx = blockIdx.x; const int vcu = (G % 8 == 0) ? (bx % 8) * (G / 8) + bx / 8 : bx;
    for (int v = vcu; v < 256; v += G) { const int bh = v >> 3, s = v & 7;
#pragma unroll 1
        for (int i = 0; i < 4; ++i) { const int qb = (i == 0) ? 31 - s : (i == 1) ? 16 + s : (i == 2) ? 15 - s : s; unit(bh >> 3, bh & 7, qb, PROJ, YMIX, shm); } }
}
}

__global__ void __launch_bounds__(NWAVES * 64, 2) mk_fwd(Args args) {
    extern __shared__ __attribute__((aligned(16))) unsigned char lds_raw[];
    LAS unsigned char* lds = (LAS unsigned char*)lds_raw;
    const int tid = threadIdx.x, lane = tid & 63, wave = __builtin_amdgcn_readfirstlane(tid >> 6);
    const int G = gridDim.x, gw = blockIdx.x * NWAVES + wave, NGW = G * NWAVES;
    unsigned char* ws = args.ws;
    float* ss1 = (float*)(ws + WS_CTL); float* ss2 = ss1 + M; float* ss3 = ss2 + M; float* ss4 = ss3 + M;
    bf16* XB = (bf16*)(ws + WS_XB); bf16* PB = (bf16*)(ws + WS_PB); bf16* HID = (bf16*)(ws + WS_HID); bf16* PROJ = HID; bf16* YMIX = (bf16*)(ws + WS_YMIX); bf16* PP = (bf16*)(ws + WS_PP);
    const int lo = args.ph_lo, hi = args.ph_hi;
    volatile LAS unsigned* MISC = (volatile LAS unsigned*)(lds + 131072);
    if (tid < 32) MISC[tid] = 0u;
    __syncthreads();
    XcdBarrier bar; bar.bar = (unsigned*)(ws + WS_BAR); bar.x = 0; bar.st = nullptr;
    if (hi - lo > 1) bar = xcd_barrier_post((unsigned*)(ws + WS_BAR), MISC + 8);
#define IN(k) (lo <= (k) && (k) < hi)
#define SEAM(k) do { if (IN(k) && IN((k) + 1)) { if ((k) == 0) cg::this_grid().sync(); else xcd_barrier(bar); } } while (0)
    typedef pg8::StaticOrder SO;
    if (IN(0)) { p0_prep(args, lds, gw, NGW, lane, wave); } SEAM(0);
    if (IN(1)) {
        { pg8::Gemm g{XB, (const bf16*)(ws + WS_W1GU), M, 2 * FF, D}; SO S; S.init(M, 2 * FF, G, (int)blockIdx.x); pg8::EpiSwiGLU E{HID, FF, ss1};
          pg8::gemm_phase<pg8::EpiSwiGLU, SO, true, true>(lds, g, S, E); }
        { pg8::Gemm g{PB, (const bf16*)(ws + WS_WPP), M, D, PLE}; SO S; S.init(M, D, G, (int)blockIdx.x); pg8::EpiScaleBf16 E{PP, D, nullptr};
          pg8::gemm_phase<pg8::EpiScaleBf16, SO, true, true>(lds, g, S, E); }
    } SEAM(1);
    if (IN(2)) { pg8::Gemm g{HID, (const bf16*)(ws + WS_W1D), M, D, FF}; SO S; S.init(M, D, G, (int)blockIdx.x); pg8::EpiResid<true> E{args.in[0], XB, ss2, 0.5f};
        pg8::gemm_phase<pg8::EpiResid<true>, SO, true, true>(lds, g, S, E); } SEAM(2);
    if (IN(3)) { pg8::Gemm g{XB, (const bf16*)(ws + WS_WIN), M, NPROJ, D}; SO S; S.init(M, NPROJ, G, (int)blockIdx.x); pg8::EpiScaleBf16 E{PROJ, NPROJ, ss2};
        pg8::gemm_phase<pg8::EpiScaleBf16, SO, true, true>(lds, g, S, E); } SEAM(3);
    if (IN(4)) { p4_mixprep(args, gw, NGW, lane); } SEAM(4);
    if (IN(5)) { if (ATTN_NAIVE) p5_attn_naive(args, tid); else sba::phase(PROJ, YMIX, (char*)lds_raw); } SEAM(5);
    if (IN(6)) { pg8::Gemm g{YMIX, (const bf16*)(ws + WS_WOUT), M, D, D}; SO S; S.init(M, D, G, (int)blockIdx.x); pg8::EpiResid<false> E{nullptr, XB, ss3, 1.0f};
        pg8::gemm_phase<pg8::EpiResid<false>, SO, true, true>(lds, g, S, E); } SEAM(6);
    if (IN(7)) { pg8::Gemm g{XB, (const bf16*)(ws + WS_W2GU), M, 2 * FF, D}; SO S; S.init(M, 2 * FF, G, (int)blockIdx.x); pg8::EpiSwiGLU E{HID, FF, ss3};
        pg8::gemm_phase<pg8::EpiSwiGLU, SO, true, true>(lds, g, S, E); } SEAM(7);
    if (IN(8)) { pg8::Gemm g{HID, (const bf16*)(ws + WS_W2D), M, D, FF}; SO S; S.init(M, D, G, (int)blockIdx.x); pg8::EpiResid<false> E{nullptr, XB, ss4, 0.5f};
        pg8::gemm_phase<pg8::EpiResid<false>, SO, true, true>(lds, g, S, E); } SEAM(8);
    if (IN(9)) { pg8::Gemm g{XB, (const bf16*)(ws + WS_WPG), M, D, D}; SO S; S.init(M, D, G, (int)blockIdx.x); pg8::EpiPle E{XB, args.out, PP, ss4};
        pg8::gemm_phase<pg8::EpiPle, SO, true, true>(lds, g, S, E); }
#undef IN
#undef SEAM
}

extern "C" void kernel_launch(void* const* d_in, const int* in_sizes, int n_in, void* d_out, int out_size, void* d_ws, size_t ws_size, hipStream_t stream) {
    static int grid = 0;
    if (grid == 0) {
        if (n_in != 20 || out_size != M * D || ws_size < WS_END) { fprintf(stderr, "kernel_launch: unexpected shapes (n_in %d out %d ws %zu)\n", n_in, out_size, ws_size); grid = -1; return; }
        int dev = 0, cus = 0, per_cu = 0;
        if (hipGetDevice(&dev) != hipSuccess || hipDeviceGetAttribute(&cus, hipDeviceAttributeMultiprocessorCount, dev) != hipSuccess) { grid = -1; return; }
        if (hipFuncSetAttribute((const void*)mk_fwd, hipFuncAttributeMaxDynamicSharedMemorySize, LDS_BYTES) != hipSuccess) { fprintf(stderr, "kernel_launch: hipFuncSetAttribute failed\n"); grid = -1; return; }
        if (hipOccupancyMaxActiveBlocksPerMultiprocessor(&per_cu, (const void*)mk_fwd, NWAVES * 64, LDS_BYTES) != hipSuccess || per_cu < 1) { fprintf(stderr, "kernel_launch: occupancy query says %d\n", per_cu); per_cu = 1; }
        (void)hipGetLastError();
        grid = cus;
    }
    if (grid < 0) return;
    (void)hipMemsetAsync((char*)d_ws + WS_CTL, 0, CTL_ZERO_BYTES, stream);
    Args a{};
    for (int i = 0; i < 20; ++i) a.in[i] = (const float*)d_in[i];
    a.out = (float*)d_out; a.ws = (unsigned char*)d_ws;
#if MK_ONE_LAUNCH
    a.ph_lo = 0; a.ph_hi = N_PHASES;
    void* kargs[] = {&a};
    hipError_t e = hipLaunchCooperativeKernel((const void*)mk_fwd, dim3(grid), dim3(NWAVES * 64), kargs, LDS_BYTES, stream);
    if (e != hipSuccess) fprintf(stderr, "kernel_launch: cooperative launch failed: %s\n", hipGetErrorString(e));
#else
    for (int ph = 0; ph < N_PHASES; ++ph) for (int rep = 0; rep < 1 + ((PROBE_DUP >> ph) & 1); ++rep) { a.ph_lo = ph; a.ph_hi = ph + 1; hipLaunchKernelGGL(mk_fwd, dim3(grid), dim3(NWAVES * 64), LDS_BYTES, stream, a); }
#endif
}
```

```cpp
#include <hip/hip_runtime.h>
#include <hip/hip_cooperative_groups.h>
#include <cstdio>
#include <cstdint>
namespace cg = cooperative_groups;
namespace pg8 {
#define PG8_LAS __attribute__((address_space(3)))
typedef unsigned short bf16_t;
typedef short bf16x8 __attribute__((ext_vector_type(8)));
typedef float f32x4 __attribute__((ext_vector_type(4)));
typedef unsigned u32x4 __attribute__((ext_vector_type(4)));
constexpr int BM = 256, BK = 64, HALF = 128, HTB = HALF * BK * 2  , STAGE_BYTES = 8 * HTB, NXCD = 8, WGM = 8;

__host__ __device__ __forceinline__ int lds_byte(int r, int c) { const int st = (r >> 4) * 2 + (c >> 5), rr = r & 15, cc = c & 31, ob = rr * 64 + cc * 2; return st * 1024 + (ob ^ (((ob >> 9) & 1) << 5)); }
__host__ __device__ __forceinline__ void stage_rc(int b, int& R, int& C) { const int st = b / 1024, sb = b % 1024, swz = sb ^ (((sb >> 9) & 1) << 5); R = (st >> 1) * 16 + swz / 64; C = (st & 1) * 32 + (swz % 64) / 2; }
__host__ __device__ __forceinline__ int perm32(int rho) { const int n = rho >> 4, i = rho & 15; return 8 * (i >> 2) + 4 * n + (i & 3); }

struct Unit { int pm, pn; };
struct Gemm { const bf16_t* A; const bf16_t* Bt; int M, N, K; };

struct StaticOrder {
    int nM, nN, nwg, G, c;
    __host__ __device__ void init(int M, int N, int G_, int c_) { nM = M / BM; nN = N / BM; nwg = nM * nN; G = G_; c = c_; }
    __host__ __device__ bool next(int i, Unit& u) const {
        const long L = (long)i * G + c; if (L >= nwg) return false;
        int wgid = (int)L; { const int q = nwg / NXCD, r = nwg % NXCD, xcd = wgid % NXCD, off = wgid / NXCD; wgid = (xcd < r ? xcd * (q + 1) : r * (q + 1) + (xcd - r) * q) + off; }
        const int nig = WGM * nN, gid = wgid / nig, fm = gid * WGM, gsz = (nM - fm) < WGM ? (nM - fm) : WGM;
        u.pm = fm + ((wgid % nig) % gsz); u.pn = (wgid % nig) / gsz; return true;
    }
    __device__ __forceinline__ void a_ready(const Unit&) const {}
    __device__ __forceinline__ void done(const Unit&) const {}
};

__device__ __forceinline__ unsigned cvt_pk_bf16(float lo, float hi) { unsigned r; asm volatile("v_cvt_pk_bf16_f32 %0, %1, %2" : "=v"(r) : "v"(lo), "v"(hi)); return r; }
typedef float f32x2 __attribute__((ext_vector_type(2)));
__device__ __forceinline__ float rs_of(float ss) { return rsqrtf(ss * (1.0f / 1024.0f) + 1e-6f); }
struct EpiSwiGLU {
    static constexpr bool PERM = true, AFTER_DRAIN = false;
    bf16_t* H; int ldh; const float* ss;
    __device__ __forceinline__ void operator()(const f32x4 (&acc)[2][2][4][2], const Unit& u, int wr, int wc, int fr, int fq) const {
        const int row0 = u.pm * BM + wr * 64 + fr, col0 = u.pn * HALF + wc * 32 + 8 * fq;
#pragma unroll
        for (int ai = 0; ai < 2; ++ai)
#pragma unroll
            for (int m = 0; m < 4; ++m) {
                const int row = row0 + ai * HALF + m * 16; const float rs = rs_of(ss[row]);
                unsigned ww[4];
#pragma unroll
                for (int n = 0; n < 2; ++n) { const f32x4 g = acc[ai][0][m][n] * rs, up = acc[ai][1][m][n] * rs; f32x4 hh;
#pragma unroll
                    for (int e = 0; e < 4; ++e) hh[e] = g[e] * __builtin_amdgcn_rcpf(1.0f + __builtin_amdgcn_exp2f(-1.4426950408889634f * g[e])) * up[e];
                    ww[2 * n] = cvt_pk_bf16(hh[0], hh[1]); ww[2 * n + 1] = cvt_pk_bf16(hh[2], hh[3]); }
                *(u32x4*)(H + (size_t)row * ldh + col0) = (u32x4){ww[0], ww[1], ww[2], ww[3]};
            }
    }
};
template <bool XF32> struct EpiResid {
    static constexpr bool PERM = true, AFTER_DRAIN = false;
    const float* xold; bf16_t* xb; float* ssq; float alpha;
    __device__ __forceinline__ void operator()(const f32x4 (&acc)[2][2][4][2], const Unit& u, int wr, int wc, int fr, int fq) const {
        const int row0 = u.pm * BM + wr * 64 + fr, colb = u.pn * BM + wc * 32 + 8 * fq;
#pragma unroll
        for (int ai = 0; ai < 2; ++ai)
#pragma unroll
            for (int m = 0; m < 4; ++m) {
                const int row = row0 + ai * HALF + m * 16; float s = 0.f;
#pragma unroll
                for (int bj = 0; bj < 2; ++bj) { const size_t off = (size_t)row * 1024 + colb + bj * HALF;
                    f32x4 o0, o1;
                    if (XF32) { o0 = *(const f32x4*)(xold + off); o1 = *(const f32x4*)(xold + off + 4); }
                    else { const u32x4 pw = *(const u32x4*)(xb + off);
                        o0[0] = __uint_as_float(pw[0] << 16); o0[1] = __uint_as_float(pw[0] & 0xffff0000u); o0[2] = __uint_as_float(pw[1] << 16); o0[3] = __uint_as_float(pw[1] & 0xffff0000u);
                        o1[0] = __uint_as_float(pw[2] << 16); o1[1] = __uint_as_float(pw[2] & 0xffff0000u); o1[2] = __uint_as_float(pw[3] << 16); o1[3] = __uint_as_float(pw[3] & 0xffff0000u); }
                    const f32x4 v0 = o0 + acc[ai][bj][m][0] * alpha, v1 = o1 + acc[ai][bj][m][1] * alpha;
                    *(u32x4*)(xb + off) = (u32x4){cvt_pk_bf16(v0[0], v0[1]), cvt_pk_bf16(v0[2], v0[3]), cvt_pk_bf16(v1[0], v1[1]), cvt_pk_bf16(v1[2], v1[3])};
                    s += (v0[0] * v0[0] + v0[1] * v0[1]) + (v0[2] * v0[2] + v0[3] * v0[3]) + (v1[0] * v1[0] + v1[1] * v1[1]) + (v1[2] * v1[2] + v1[3] * v1[3]); }
                s += __shfl_xor(s, 16); s += __shfl_xor(s, 32);
                if (fq == 0) __hip_atomic_fetch_add(ssq + row, s, __ATOMIC_RELAXED, __HIP_MEMORY_SCOPE_AGENT);
            }
    }
};
struct EpiScaleBf16 {
    static constexpr bool PERM = true, AFTER_DRAIN = false;
    bf16_t* O; int ldc; const float* ss;
    __device__ __forceinline__ void operator()(const f32x4 (&acc)[2][2][4][2], const Unit& u, int wr, int wc, int fr, int fq) const {
        const int row0 = u.pm * BM + wr * 64 + fr, colb = u.pn * BM + wc * 32 + 8 * fq;
#pragma unroll
        for (int ai = 0; ai < 2; ++ai)
#pragma unroll
            for (int m = 0; m < 4; ++m) {
                const int row = row0 + ai * HALF + m * 16; const float rs = ss ? rs_of(ss[row]) : 1.0f;
#pragma unroll
                for (int bj = 0; bj < 2; ++bj) { const f32x4 v0 = acc[ai][bj][m][0] * rs, v1 = acc[ai][bj][m][1] * rs;
                    *(u32x4*)(O + (size_t)row * ldc + colb + bj * HALF) = (u32x4){cvt_pk_bf16(v0[0], v0[1]), cvt_pk_bf16(v0[2], v0[3]), cvt_pk_bf16(v1[0], v1[1]), cvt_pk_bf16(v1[2], v1[3])}; }
            }
    }
};
struct EpiPle {
    static constexpr bool PERM = true, AFTER_DRAIN = false;
    const bf16_t* xold; float* out; const bf16_t* PP; const float* ss;
    __device__ __forceinline__ void operator()(const f32x4 (&acc)[2][2][4][2], const Unit& u, int wr, int wc, int fr, int fq) const {
        const int row0 = u.pm * BM + wr * 64 + fr, colb = u.pn * BM + wc * 32 + 8 * fq;
#pragma unroll
        for (int ai = 0; ai < 2; ++ai)
#pragma unroll
            for (int m = 0; m < 4; ++m) {
                const int row = row0 + ai * HALF + m * 16; const float rs = rs_of(ss[row]) * -1.4426950408889634f;
#pragma unroll
                for (int bj = 0; bj < 2; ++bj) { const size_t off = (size_t)row * 1024 + colb + bj * HALF;
                    const u32x4 xw = *(const u32x4*)(xold + off); const u32x4 pw = *(const u32x4*)(PP + off); f32x4 o0, o1;
                    o0[0] = __uint_as_float(xw[0] << 16); o0[1] = __uint_as_float(xw[0] & 0xffff0000u); o0[2] = __uint_as_float(xw[1] << 16); o0[3] = __uint_as_float(xw[1] & 0xffff0000u);
                    o1[0] = __uint_as_float(xw[2] << 16); o1[1] = __uint_as_float(xw[2] & 0xffff0000u); o1[2] = __uint_as_float(xw[3] << 16); o1[3] = __uint_as_float(xw[3] & 0xffff0000u);
                    f32x4 p0, p1; p0[0] = __uint_as_float(pw[0] << 16); p0[1] = __uint_as_float(pw[0] & 0xffff0000u); p0[2] = __uint_as_float(pw[1] << 16); p0[3] = __uint_as_float(pw[1] & 0xffff0000u);
                    p1[0] = __uint_as_float(pw[2] << 16); p1[1] = __uint_as_float(pw[2] & 0xffff0000u); p1[2] = __uint_as_float(pw[3] << 16); p1[3] = __uint_as_float(pw[3] & 0xffff0000u);
                    f32x4 v0, v1;
#pragma unroll
                    for (int e = 0; e < 4; ++e) { v0[e] = o0[e] + __builtin_amdgcn_rcpf(1.0f + __builtin_amdgcn_exp2f(acc[ai][bj][m][0][e] * rs)) * p0[e];
                                                  v1[e] = o1[e] + __builtin_amdgcn_rcpf(1.0f + __builtin_amdgcn_exp2f(acc[ai][bj][m][1][e] * rs)) * p1[e]; }
                    *(f32x4*)(out + off) = v0; *(f32x4*)(out + off + 4) = v1; }
            }
    }
};
template <class Epi, class Sched, bool ALIGN_EPI = false, bool SP2 = false>
__device__ __forceinline__ void gemm_phase(PG8_LAS unsigned char* lds, const Gemm g, const Sched& S, const Epi& E) {
    const int tid = threadIdx.x, wid = __builtin_amdgcn_readfirstlane(tid >> 6), lane = tid & 63, wr = wid >> 2, wc = wid & 3, fr = lane & 15, fq = lane >> 4;
    const int K = g.K, nt = K / BK;
    unsigned voffA[2], voffB[2];
#pragma unroll
    for (int i = 0; i < 2; ++i) { int R, C; stage_rc(tid * 16 + i * 8192, R, C); const int Rb = Epi::PERM ? ((R & ~31) + perm32(R & 31)) : R;
        voffA[i] = (unsigned)(R * K + C) * 2u; voffB[i] = (unsigned)(Rb * K + C) * 2u; }
    const size_t kstep = (size_t)(BK * 2);
    const size_t hstep = (size_t)HALF * K * 2;
    const size_t tstep = 2 * hstep;
    const unsigned ldsw = (unsigned)wid * 1024u;
    const int aoff = lds_byte(wr * 64 + fr, fq * 8), boff = lds_byte(wc * 32 + fr, fq * 8);
#define PG8_SA(b, h) (((b) * 2 + (h)) * HTB)
#define PG8_SB(b, h) ((4 + (b) * 2 + (h)) * HTB)
#define PG8_STAGE(bufoff, gbase, voff) do { _Pragma("unroll") for (int _i = 0; _i < 2; ++_i) \
        __builtin_amdgcn_global_load_lds((const unsigned*)((const char*)(gbase) + (voff)[_i]), (PG8_LAS unsigned*)(lds + (bufoff) + ldsw + _i * 8192), 16, 0, 0); } while (0)
#define PG8_LDA(dst, b, h) do { _Pragma("unroll") for (int m = 0; m < 4; ++m) _Pragma("unroll") for (int k = 0; k < 2; ++k) dst[m][k] = *(const PG8_LAS bf16x8*)(lds + PG8_SA(b, h) + aoff + m * 2048 + k * 1024); } while (0)
#define PG8_LDB(dst, b, h) do { _Pragma("unroll") for (int n = 0; n < 2; ++n) _Pragma("unroll") for (int k = 0; k < 2; ++k) dst[n][k] = *(const PG8_LAS bf16x8*)(lds + PG8_SB(b, h) + boff + n * 2048 + k * 1024); } while (0)
#define PG8_MMA(ai, bj, At, Bt) do { __builtin_amdgcn_s_setprio(1); _Pragma("unroll") for (int m = 0; m < 4; ++m) _Pragma("unroll") for (int n = 0; n < 2; ++n) _Pragma("unroll") for (int k = 0; k < 2; ++k) \
        acc[ai][bj][m][n] = __builtin_amdgcn_mfma_f32_16x16x32_bf16(Bt[n][k], At[m][k], acc[ai][bj][m][n], 0, 0, 0); __builtin_amdgcn_s_setprio(0); } while (0)
#define PG8_WAIT_V(n) asm volatile("s_waitcnt vmcnt(" #n ")" ::: "memory")
#define PG8_WAIT_L(n) asm volatile("s_waitcnt lgkmcnt(" #n ")" ::: "memory")
#define PG8_BAR __builtin_amdgcn_s_barrier()
#define PG8_SCHED __builtin_amdgcn_sched_barrier(0)
    Unit cur, nxt; int ui = 0;
    if (!S.next(0, cur)) return;
    f32x4 acc[2][2][4][2];
#pragma unroll
    for (int a = 0; a < 2; ++a)
#pragma unroll
        for (int b = 0; b < 2; ++b)
#pragma unroll
            for (int m = 0; m < 4; ++m)
#pragma unroll
                for (int n = 0; n < 2; ++n) acc[a][b][m][n] = (f32x4){0.f, 0.f, 0.f, 0.f};
    bf16x8 At[4][2], B0[2][2], B1[2][2];
    const char* cA = (const char*)g.A + (size_t)cur.pm * tstep; const char* cB = (const char*)g.Bt + (size_t)cur.pn * tstep;
    S.a_ready(cur);
    if constexpr (SP2) {
        PG8_STAGE(PG8_SB(0, 0), cB, voffB); PG8_STAGE(PG8_SB(0, 1), cB + hstep, voffB); PG8_STAGE(PG8_SA(0, 0), cA, voffA); PG8_STAGE(PG8_SA(0, 1), cA + hstep, voffA);
        if (wr == 1) PG8_BAR;
        PG8_WAIT_V(2); PG8_BAR;
        PG8_STAGE(PG8_SB(1, 0), cB + kstep, voffB); PG8_STAGE(PG8_SA(1, 0), cA + kstep, voffA); PG8_STAGE(PG8_SB(1, 1), cB + hstep + kstep, voffB);
        PG8_WAIT_V(6); PG8_BAR;
    } else {
        PG8_STAGE(PG8_SB(0, 0), cB, voffB); PG8_STAGE(PG8_SA(0, 0), cA, voffA); PG8_STAGE(PG8_SB(0, 1), cB + hstep, voffB); PG8_STAGE(PG8_SA(0, 1), cA + hstep, voffA);
        if (wr == 1) PG8_BAR;
        PG8_WAIT_V(4); PG8_BAR;
        PG8_STAGE(PG8_SB(1, 0), cB + kstep, voffB); PG8_STAGE(PG8_SA(1, 0), cA + kstep, voffA); PG8_STAGE(PG8_SB(1, 1), cB + hstep + kstep, voffB);
        PG8_WAIT_V(6); PG8_BAR;
    }
    for (;;) {
        const bool has_next = S.next(ui + 1, nxt);
        const char* nA = has_next ? (const char*)g.A + (size_t)nxt.pm * tstep : cA; const char* nB = has_next ? (const char*)g.Bt + (size_t)nxt.pn * tstep : cB;
        for (int t = 0; t < nt; t += 2) {
            const bool last = (t == nt - 2);
            const char* a1 = cA + (size_t)(t + 1) * kstep;
            const char* a2 = last ? nA : cA + (size_t)(t + 2) * kstep; const char* b2 = last ? nB : cB + (size_t)(t + 2) * kstep;
            const char* a3 = a2 + kstep; const char* b3 = b2 + kstep;
            if (last && has_next) S.a_ready(nxt);
            if constexpr (SP2) {
            PG8_LDB(B0, 0, 0); PG8_LDB(B1, 0, 1); PG8_SCHED; PG8_LDA(At, 0, 0); PG8_STAGE(PG8_SA(1, 1), a1 + hstep, voffA);
            PG8_WAIT_V(8); PG8_WAIT_L(0); PG8_BAR; PG8_MMA(0, 0, At, B0); PG8_MMA(0, 1, At, B1); PG8_BAR; PG8_SCHED;
            PG8_LDA(At, 0, 1); PG8_STAGE(PG8_SB(0, 0), b2, voffB); PG8_STAGE(PG8_SB(0, 1), b2 + hstep, voffB); PG8_STAGE(PG8_SA(0, 0), a2, voffA);
            PG8_WAIT_V(8); PG8_WAIT_L(0); PG8_BAR; PG8_MMA(1, 0, At, B0); PG8_MMA(1, 1, At, B1); PG8_BAR; PG8_SCHED;
            PG8_LDB(B0, 1, 0); PG8_LDB(B1, 1, 1); PG8_SCHED; PG8_LDA(At, 1, 0); PG8_STAGE(PG8_SA(0, 1), a2 + hstep, voffA);
            PG8_WAIT_V(8); PG8_WAIT_L(0); PG8_BAR; PG8_MMA(0, 0, At, B0); PG8_MMA(0, 1, At, B1); PG8_BAR; PG8_SCHED;
            PG8_LDA(At, 1, 1); PG8_STAGE(PG8_SB(1, 0), b3, voffB); PG8_STAGE(PG8_SB(1, 1), b3 + hstep, voffB); PG8_STAGE(PG8_SA(1, 0), a3, voffA);
            PG8_WAIT_V(8); PG8_WAIT_L(0); PG8_BAR; PG8_MMA(1, 0, At, B0); PG8_MMA(1, 1, At, B1); PG8_BAR; PG8_SCHED;
            } else {
            PG8_LDB(B0, 0, 0); PG8_SCHED; PG8_LDA(At, 0, 0); PG8_STAGE(PG8_SA(1, 1), a1 + hstep, voffA);
            PG8_WAIT_L(8); PG8_BAR; PG8_WAIT_L(0); PG8_MMA(0, 0, At, B0); PG8_BAR; PG8_SCHED;
            PG8_LDB(B1, 0, 1); PG8_STAGE(PG8_SB(0, 0), b2, voffB);
            PG8_BAR; PG8_WAIT_L(0); PG8_MMA(0, 1, At, B1); PG8_BAR;
            PG8_LDA(At, 0, 1); PG8_STAGE(PG8_SA(0, 0), a2, voffA);
            PG8_BAR; PG8_WAIT_L(0); PG8_MMA(1, 0, At, B0); PG8_BAR; PG8_SCHED;
            PG8_STAGE(PG8_SB(0, 1), b2 + hstep, voffB);
            PG8_WAIT_V(6); PG8_BAR; PG8_MMA(1, 1, At, B1); PG8_BAR;
            PG8_LDB(B0, 1, 0); PG8_SCHED; PG8_LDA(At, 1, 0); PG8_STAGE(PG8_SA(0, 1), a2 + hstep, voffA);
            PG8_WAIT_L(8); PG8_BAR; PG8_WAIT_L(0); PG8_MMA(0, 0, At, B0); PG8_BAR; PG8_SCHED;
            PG8_LDB(B1, 1, 1); PG8_STAGE(PG8_SB(1, 0), b3, voffB);
            PG8_BAR; PG8_WAIT_L(0); PG8_MMA(0, 1, At, B1); PG8_BAR;
            PG8_LDA(At, 1, 1); PG8_STAGE(PG8_SA(1, 0), a3, voffA);
            PG8_BAR; PG8_WAIT_L(0); PG8_MMA(1, 0, At, B0); PG8_BAR; PG8_SCHED;
            PG8_STAGE(PG8_SB(1, 1), b3 + hstep, voffB);
            PG8_WAIT_V(6); PG8_BAR; PG8_MMA(1, 1, At, B1); PG8_BAR;
            }
        }
        if constexpr (ALIGN_EPI) { if (wr == 0) PG8_BAR; }
        if constexpr (!Epi::AFTER_DRAIN) { E(acc, cur, wr, wc, fr, fq); S.done(cur); }
        if (!has_next) break;
#pragma unroll
        for (int a = 0; a < 2; ++a)
#pragma unroll
            for (int b = 0; b < 2; ++b)
#pragma unroll
                for (int m = 0; m < 4; ++m)
#pragma unroll
                    for (int n = 0; n < 2; ++n) acc[a][b][m][n] = (f32x4){0.f, 0.f, 0.f, 0.f};
        cur = nxt; cA = nA; cB = nB; ++ui;
        if constexpr (ALIGN_EPI) { if (wr == 1) PG8_BAR; }
    }
    PG8_WAIT_V(0);
    if constexpr (!ALIGN_EPI) { if (wr == 0) PG8_BAR; }
    PG8_BAR;
    if constexpr (Epi::AFTER_DRAIN) { E.fused(acc, cur, wr, wc, fr, fq, lds, wid, lane); S.done(cur); }
#undef PG8_SA
#undef PG8_SB
#undef PG8_STAGE
#undef PG8_LDA
#undef PG8_LDB
#undef PG8_MMA
#undef PG8_WAIT_V
#undef PG8_WAIT_L
#undef PG8_BAR
#undef PG8_SCHED
}
}

constexpr int NWAVES = 8;
constexpr int BATCH = 4, SEQ = 8192, D = 1024, FF = 2816, NPROJ = 3072, PLE = 256, NH = 8, HD = 64, CONVD = 512;
constexpr int M = BATCH * SEQ;
#ifndef PROBE_DUP
#define PROBE_DUP 0
#endif
#ifndef MK_ONE_LAUNCH
#define MK_ONE_LAUNCH 1
#endif
constexpr int N_PHASES = 10;
constexpr size_t MiB = 1u << 20;
constexpr size_t WS_CTL = 0, CTL_ZERO_BYTES = 1 * MiB;
constexpr size_t WS_W1GU = 2 * MiB, WS_W1D = 13 * MiB, WS_WIN = 19 * MiB, WS_WOUT = 25 * MiB, WS_W2GU = 27 * MiB, WS_W2D = 38 * MiB, WS_WPG = 44 * MiB, WS_WPP = 46 * MiB;
constexpr size_t WS_XB = 48 * MiB;
constexpr size_t WS_PB = 112 * MiB;
constexpr size_t WS_HID = 128 * MiB;
constexpr size_t WS_YMIX = 320 * MiB;
constexpr size_t WS_PP = 384 * MiB;
constexpr size_t WS_END = 448 * MiB;
#ifndef ATTN_NAIVE
#define ATTN_NAIVE 0
#endif
constexpr float QSC = ATTN_NAIVE ? 0.125f : 0.125f * 1.4426950408889634f;
constexpr int LDS_BYTES = 147456;

#define GAS __attribute__((address_space(1)))
#define LAS __attribute__((address_space(3)))
typedef unsigned short bf16;
typedef unsigned v4u __attribute__((ext_vector_type(4)));
typedef float f32x4 __attribute__((ext_vector_type(4)));
#define LDS_WAIT() asm volatile("s_waitcnt lgkmcnt(0)" ::: "memory")
__device__ __forceinline__ unsigned pk2(float lo, float hi) { return pg8::cvt_pk_bf16(lo, hi); }
__device__ __forceinline__ float bflo(unsigned w) { return __uint_as_float(w << 16); }
__device__ __forceinline__ float bfhi(unsigned w) { return __uint_as_float(w & 0xffff0000u); }
__device__ __forceinline__ float wave_sum(float v) {
#pragma unroll
    for (int o = 1; o < 64; o <<= 1) v += __shfl_xor(v, o);
    return v;
}

#define XB_TMO      128
#define XB_XCNT(j)  (256  + 64 * (j))
#define XB_XSUB(j)  (1280 + 64 * (j))
#define XB_XGEN(j)  (2304 + 64 * (j))
#define XB_TOP      3328
#define XB_TOPGEN   3392
#define XCD_BAR_WORDS 3456
#define XB_SPIN_CAP (1u << 18)

__device__ __forceinline__ unsigned xb_ld(unsigned* p)              { return __hip_atomic_load(p, __ATOMIC_RELAXED, __HIP_MEMORY_SCOPE_AGENT); }
__device__ __forceinline__ unsigned xb_add(unsigned* p, unsigned v) { return __hip_atomic_fetch_add(p, v, __ATOMIC_RELAXED, __HIP_MEMORY_SCOPE_AGENT); }
__device__ __forceinline__ unsigned xb_xcc_id() { return (unsigned)__builtin_amdgcn_s_getreg((3 << 11) | 20) & 0xFu; }
#define XB_SPIN(cond, bar) do { unsigned _sp = 0; while (cond) { __builtin_amdgcn_s_sleep(1); \
    if ((++_sp & 255u) == 0u) { if (xb_ld(&(bar)[XB_TMO])) break; if (_sp > XB_SPIN_CAP) { atomicAdd(&(bar)[XB_TMO], 1u); break; } } } } while (0)

struct XcdBarrier {
    unsigned* bar; unsigned x;
    volatile LAS unsigned* st;
};

__device__ __forceinline__ XcdBarrier xcd_barrier_post(unsigned* bar, volatile LAS unsigned* st) {
    XcdBarrier b; b.bar = bar; b.x = xb_xcc_id(); b.st = st;
    if (threadIdx.x == 0) (void)xb_add(&bar[XB_XCNT(b.x)], 1u);
    return b;
}
__device__ __forceinline__ void xcd_barrier_complete(unsigned* bar, unsigned x, unsigned& nloc, unsigned& nx) {
    const unsigned G = gridDim.x * gridDim.y * gridDim.z;
    unsigned sum, cnt, mine, sp = 0u;
    for (;;) {
        sum = 0u; cnt = 0u; mine = 0u;
#pragma unroll
        for (unsigned j = 0; j < 16; ++j) { const unsigned c = xb_ld(&bar[XB_XCNT(j)]); sum += c; cnt += (c > 0u) ? 1u : 0u; mine = (j == x) ? c : mine; }
        if (sum == G) break;
        __builtin_amdgcn_s_sleep(1);
        if ((++sp & 255u) == 0u) { if (xb_ld(&bar[XB_TMO])) break; if (sp > XB_SPIN_CAP) { atomicAdd(&bar[XB_TMO], 1u); break; } }
    }
    nloc = mine > 0u ? mine : 1u; nx = cnt > 0u ? cnt : 1u;
}

__device__ __forceinline__ void xcd_barrier(const XcdBarrier& b) {
    asm volatile("s_waitcnt vmcnt(0)" ::: "memory");
    __syncthreads();
    if (threadIdx.x == 0) {
        unsigned* bar = b.bar;
        __builtin_amdgcn_s_waitcnt(0);
        unsigned nloc = b.st[0], nx = b.st[1];
        if (nloc == 0u) { xcd_barrier_complete(bar, b.x, nloc, nx); b.st[0] = nloc; b.st[1] = nx; }
        const unsigned old = xb_add(&bar[XB_XSUB(b.x)], 1u);
        const unsigned gen = old / nloc;
        if (old + 1u == (gen + 1u) * nloc) {
            __builtin_amdgcn_fence(__ATOMIC_RELEASE, "agent");
            asm volatile("s_waitcnt vmcnt(0)" ::: "memory");
            const unsigned og = xb_add(&bar[XB_TOP], 1u);
            const unsigned tg = og / nx;
            if (og + 1u == (tg + 1u) * nx) xb_add(&bar[XB_TOPGEN], 1u);
            else XB_SPIN(xb_ld(&bar[XB_TOPGEN]) == tg, bar);
            __builtin_amdgcn_fence(__ATOMIC_ACQUIRE, "agent");
            xb_add(&bar[XB_XGEN(b.x)], 1u);
            asm volatile("s_waitcnt vmcnt(0)" ::: "memory");
        } else {
            XB_SPIN(xb_ld(&bar[XB_XGEN(b.x)]) == gen, bar);
            __builtin_amdgcn_fence(__ATOMIC_ACQUIRE, "agent");
            asm volatile("s_waitcnt vmcnt(0)" ::: "memory");
        }
    }
    __syncthreads();
}

constexpr size_t WS_BAR = 768 * 1024;
struct Args { const float* in[20]; float* out; unsigned char* ws; int ph_lo, ph_hi; };

__device__ __forceinline__ void tr_item(const float* __restrict__ W, int K, int N, const float* __restrict__ gain, bf16* __restrict__ WT, int dst_row0, LAS float* scr, int k0, int n0, int lane) {
    float w[32]; const float* wp = W + (size_t)(k0 + (lane >> 5)) * N + n0 + (lane & 31);
#pragma unroll
    for (int i = 0; i < 32; ++i) w[i] = wp[(size_t)(2 * i) * N];
    if (gain) {
#pragma unroll
        for (int i = 0; i < 32; ++i) w[i] *= gain[k0 + 2 * i + (lane >> 5)];
    }
#pragma unroll
    for (int i = 0; i < 32; ++i) scr[(2 * i + (lane >> 5)) * 33 + (lane & 31)] = w[i];
    LDS_WAIT(); asm volatile("" ::: "memory");
    const int c = lane & 7;
#pragma unroll
    for (int j = 0; j < 4; ++j) { const int n = (lane >> 3) + 8 * j; const LAS float* s = scr + (8 * c) * 33 + n;
        v4u o; o.x = pk2(s[0 * 33], s[1 * 33]); o.y = pk2(s[2 * 33], s[3 * 33]); o.z = pk2(s[4 * 33], s[5 * 33]); o.w = pk2(s[6 * 33], s[7 * 33]);
        *(v4u*)(WT + (size_t)(dst_row0 + n) * K + k0 + 8 * c) = o; }
    LDS_WAIT(); asm volatile("" ::: "memory");
}
__device__ __forceinline__ bool tr_matrix(int& r, const float* W, int K, int N, const float* gain, bf16* WT, int mode, LAS float* scr, int lane) {
    const int nblk = N / 32, items = (K / 64) * nblk;
    if (r >= items) { r -= items; return false; }
    const int kb = r / nblk, nb = r % nblk, n0 = 32 * nb;
    const int dst = mode == 0 ? n0 : (256 * (n0 >> 7) + (n0 & 127) + (mode == 2 ? 128 : 0));
    tr_item(W, K, N, gain, WT, dst, scr, 64 * kb, n0, lane);
    return true;
}
__device__ __forceinline__ void p0_prep(const Args& a, LAS unsigned char* lds, int gw, int NGW, int lane, int wave) {
    unsigned char* ws = a.ws;
    LAS float* scr = (LAS float*)(lds + wave * 16384);
    constexpr int I_GU = (D / 64) * (FF / 32), I_DN = (FF / 64) * (D / 32), I_IN = (D / 64) * (NPROJ / 32), I_SQ = (D / 64) * (D / 32), I_PP = (PLE / 64) * (D / 32);
    constexpr int NITEMS = 4 * I_GU + 2 * I_DN + I_IN + 2 * I_SQ + I_PP;
    for (int it = gw; it < NITEMS; it += NGW) {
        int r = it;
        if (tr_matrix(r, a.in[3], D, FF, a.in[2], (bf16*)(ws + WS_W1GU), 1, scr, lane)) continue;
        if (tr_matrix(r, a.in[4], D, FF, a.in[2], (bf16*)(ws + WS_W1GU), 2, scr, lane)) continue;
        if (tr_matrix(r, a.in[14], D, FF, a.in[13], (bf16*)(ws + WS_W2GU), 1, scr, lane)) continue;
        if (tr_matrix(r, a.in[15], D, FF, a.in[13], (bf16*)(ws + WS_W2GU), 2, scr, lane)) continue;
        if (tr_matrix(r, a.in[5], FF, D, nullptr, (bf16*)(ws + WS_W1D), 0, scr, lane)) continue;
        if (tr_matrix(r, a.in[16], FF, D, nullptr, (bf16*)(ws + WS_W2D), 0, scr, lane)) continue;
        if (tr_matrix(r, a.in[7], D, NPROJ, a.in[6], (bf16*)(ws + WS_WIN), 0, scr, lane)) continue;
        if (tr_matrix(r, a.in[12], D, D, nullptr, (bf16*)(ws + WS_WOUT), 0, scr, lane)) continue;
        if (tr_matrix(r, a.in[18], D, D, a.in[17], (bf16*)(ws + WS_WPG), 0, scr, lane)) continue;
        tr_matrix(r, a.in[19], PLE, D, nullptr, (bf16*)(ws + WS_WPP), 0, scr, lane);
    }
    const float* __restrict__ x = a.in[0]; bf16* __restrict__ XB = (bf16*)(ws + WS_XB); float* __restrict__ ss1 = (float*)(ws + WS_CTL);
    for (int m0 = gw * 4; m0 < M; m0 += NGW * 4) {
        f32x4 v[4][4];
#pragma unroll
        for (int r = 0; r < 4; ++r)
#pragma unroll
            for (int j = 0; j < 4; ++j) v[r][j] = ((const f32x4*)(x + (size_t)(m0 + r) * D) + lane)[64 * j];
#pragma unroll
        for (int r = 0; r < 4; ++r) { float s = 0.f;
#pragma unroll
            for (int j = 0; j < 4; ++j) s += (v[r][j].x * v[r][j].x + v[r][j].y * v[r][j].y) + (v[r][j].z * v[r][j].z + v[r][j].w * v[r][j].w);
            s = wave_sum(s);
            unsigned long long* o8 = (unsigned long long*)(XB + (size_t)(m0 + r) * D) + lane;
#pragma unroll
            for (int j = 0; j < 4; ++j) o8[64 * j] = (unsigned long long)pk2(v[r][j].x, v[r][j].y) | ((unsigned long long)pk2(v[r][j].z, v[r][j].w) << 32);
            if (lane == 0) ss1[m0 + r] = s; }
    }
    const float* __restrict__ p = a.in[1]; bf16* __restrict__ PB = (bf16*)(ws + WS_PB);
    for (int i0 = gw * 64 + lane; i0 < M * PLE / 8; i0 += NGW * 64 * 4) {
        f32x4 v0[4], v1[4];
#pragma unroll
        for (int r = 0; r < 4; ++r) { const size_t i = (size_t)i0 + (size_t)r * NGW * 64; v0[r] = *(const f32x4*)(p + i * 8); v1[r] = *(const f32x4*)(p + i * 8 + 4); }
#pragma unroll
        for (int r = 0; r < 4; ++r) { const size_t i = (size_t)i0 + (size_t)r * NGW * 64; *(v4u*)(PB + i * 8) = (v4u){pk2(v0[r].x, v0[r].y), pk2(v0[r].z, v0[r].w), pk2(v1[r].x, v1[r].y), pk2(v1[r].z, v1[r].w)}; }
    }
}

__device__ __forceinline__ void unpack8(const v4u w, float (&f)[8]) { f[0] = bflo(w.x); f[1] = bfhi(w.x); f[2] = bflo(w.y); f[3] = bfhi(w.y); f[4] = bflo(w.z); f[5] = bfhi(w.z); f[6] = bflo(w.w); f[7] = bfhi(w.w); }
__device__ __forceinline__ v4u pack8(const float (&f)[8]) { return (v4u){pk2(f[0], f[1]), pk2(f[2], f[3]), pk2(f[4], f[5]), pk2(f[6], f[7])}; }
__device__ __forceinline__ void p4_mixprep(const Args& a, int gw, int NGW, int lane) {
    bf16* PROJ = (bf16*)(a.ws + WS_HID); bf16* YMIX = (bf16*)(a.ws + WS_YMIX);
    const float* cw = a.in[8]; const float* cbp = a.in[9]; const float* gq = a.in[10]; const float* gk = a.in[11];
    float w0[8], w1[8], w2[8], cb[8], gqv[8], gkv[8];
#pragma unroll
    for (int i = 0; i < 8; ++i) { w0[i] = cw[8 * lane + i]; w1[i] = cw[CONVD + 8 * lane + i]; w2[i] = cw[2 * CONVD + 8 * lane + i]; cb[i] = cbp[8 * lane + i];
        gqv[i] = gq[(lane & 7) * 8 + i] * QSC; gkv[i] = gk[(lane & 7) * 8 + i]; }
    for (int ch = gw; ch < M / 16; ch += NGW) {
        const int r0 = ch * 16; float z1[8], z2[8];
        if ((r0 & (SEQ - 1)) == 0) {
#pragma unroll
            for (int i = 0; i < 8; ++i) { z1[i] = 0.f; z2[i] = 0.f; }
        } else {
            float c[8], u[8];
            const bf16* pr = PROJ + (size_t)(r0 - 1) * NPROJ + 8 * lane; unpack8(*(const v4u*)(pr + 512), c); unpack8(*(const v4u*)(pr + 1024), u);
#pragma unroll
            for (int i = 0; i < 8; ++i) z1[i] = c[i] * u[i];
            pr -= NPROJ; unpack8(*(const v4u*)(pr + 512), c); unpack8(*(const v4u*)(pr + 1024), u);
#pragma unroll
            for (int i = 0; i < 8; ++i) z2[i] = c[i] * u[i];
        }
        for (int r = r0; r < r0 + 16; ++r) {
            bf16* pr = PROJ + (size_t)r * NPROJ + 8 * lane;
            float b[8], c[8], u[8], q[8], k[8], y[8];
            unpack8(*(const v4u*)(pr), b); unpack8(*(const v4u*)(pr + 512), c); unpack8(*(const v4u*)(pr + 1024), u);
            unpack8(*(const v4u*)(pr + 1536), q); unpack8(*(const v4u*)(pr + 2048), k);
#pragma unroll
            for (int i = 0; i < 8; ++i) { const float z0 = c[i] * u[i]; y[i] = b[i] * (w0[i] * z2[i] + w1[i] * z1[i] + w2[i] * z0 + cb[i]); z2[i] = z1[i]; z1[i] = z0; }
            *(v4u*)(YMIX + (size_t)r * D + 8 * lane) = pack8(y);
            float sq = 0.f, sk = 0.f;
#pragma unroll
            for (int i = 0; i < 8; ++i) { sq += q[i] * q[i]; sk += k[i] * k[i]; }
            sq += __shfl_xor(sq, 1); sq += __shfl_xor(sq, 2); sq += __shfl_xor(sq, 4);
            sk += __shfl_xor(sk, 1); sk += __shfl_xor(sk, 2); sk += __shfl_xor(sk, 4);
            const float rq = rsqrtf(sq * (1.0f / 64.0f) + 1e-6f), rk = rsqrtf(sk * (1.0f / 64.0f) + 1e-6f);
#pragma unroll
            for (int i = 0; i < 8; ++i) { q[i] *= rq * gqv[i]; k[i] *= rk * gkv[i]; }
            *(v4u*)(pr + 1536) = pack8(q); *(v4u*)(pr + 2048) = pack8(k);
        }
    }
}

__device__ __forceinline__ void p5_attn_naive(const Args& a, int tid) {
    const bf16* PROJ = (const bf16*)(a.ws + WS_HID); bf16* YMIX = (bf16*)(a.ws + WS_YMIX);
    for (int un = blockIdx.x; un < 512; un += gridDim.x) {
        const int bh = un & 31, r = un >> 5, qq = r < 8 ? r : 23 - r, b = bh >> 3, h = bh & 7;
        const int t = qq * 512 + tid;
        const bf16* base = PROJ + (size_t)b * SEQ * NPROJ + h * HD;
        float q[64], o[64];
#pragma unroll
        for (int c = 0; c < 8; ++c) { float f[8]; unpack8(*(const v4u*)(base + (size_t)t * NPROJ + 1536 + 8 * c), f);
#pragma unroll
            for (int e = 0; e < 8; ++e) { q[8 * c + e] = f[e]; o[8 * c + e] = 0.f; } }
        float carry = 0.f;
        for (int j = qq * 512 + 511; j >= 0; --j) {
            const bf16* kr = base + (size_t)j * NPROJ + 2048; float z = 0.f;
#pragma unroll
            for (int c = 0; c < 8; ++c) { float f[8]; unpack8(*(const v4u*)(kr + 8 * c), f);
#pragma unroll
                for (int e = 0; e < 8; ++e) z += q[8 * c + e] * f[e]; }
            const bool act = j < t;
            const float sp = fmaxf(z, 0.f) + __logf(1.0f + __expf(-fabsf(z)));
            const float av = act ? __expf(z - sp + carry) : 0.f;
            carry -= act ? sp : 0.f;
            const bf16* vr = kr + 512;
#pragma unroll
            for (int c = 0; c < 8; ++c) { float f[8]; unpack8(*(const v4u*)(vr + 8 * c), f);
#pragma unroll
                for (int e = 0; e < 8; ++e) o[8 * c + e] += av * f[e]; }
        }
        bf16* orow = YMIX + (size_t)(b * SEQ + t) * D + 512 + h * HD;
#pragma unroll
        for (int c = 0; c < 8; ++c) { float f[8];
#pragma unroll
            for (int e = 0; e < 8; ++e) f[e] = o[8 * c + e];
            *(v4u*)(orow + 8 * c) = pack8(f); }
    }
}

namespace sba {
using bf16x8 = __attribute__((ext_vector_type(8))) short;
using s16x4 = __attribute__((ext_vector_type(4))) short;
using f32x16 = __attribute__((ext_vector_type(16))) float;
typedef short v4i16_t __attribute__((ext_vector_type(4)));
typedef float f32x2_t __attribute__((ext_vector_type(2))); typedef __bf16 bf16x2_t __attribute__((ext_vector_type(2)));
typedef __attribute__((address_space(3))) const char* lds_cptr;
constexpr int SLOTB = 8192, LDS_K = 0, LDS_V = 3 * SLOTB;
__device__ __forceinline__ void glds16(const void* gsrc, unsigned lds_dst) { unsigned keep;
    asm volatile("s_mov_b32 %0, m0\n\ts_mov_b32 m0, %2\n\ts_nop 0\n\tglobal_load_lds_dwordx4 %1, off\n\ts_mov_b32 m0, %0" : "=&s"(keep) : "v"(gsrc), "s"(lds_dst) : "memory"); }
__device__ __forceinline__ unsigned cvtpk_s(float lo, float hi) { f32x2_t v = {lo, hi}; bf16x2_t b = __builtin_convertvector(v, bf16x2_t); return __builtin_bit_cast(unsigned, b); }
__device__ __forceinline__ s16x4 vtr(lds_cptr p) { return __builtin_bit_cast(s16x4, __builtin_amdgcn_ds_read_tr16_b64_v4i16((__attribute__((address_space(3))) v4i16_t*)p)); }
#define SBA_MFMA(a, b, c) __builtin_amdgcn_mfma_f32_32x32x16_bf16((a), (b), (c), 0, 0, 0)

__device__ __forceinline__ void unit(int b, int hd, int qb, const unsigned short* PROJ, unsigned short* YMIX, char* shm) {
    const int tid = threadIdx.x, lane = tid & 63, r32 = lane & 31, hi = lane >> 5; const int wid = __builtin_amdgcn_readfirstlane(tid >> 6);
    const size_t rowbase = (size_t)b * SEQ; const int q0 = qb * 256;
    const unsigned short* Qw = PROJ + (rowbase + q0 + wid * 32) * NPROJ + 1536 + hd * 64;
    const unsigned short* Kh = PROJ + rowbase * NPROJ + 2048 + hd * 64; const unsigned short* Vh = Kh + 512;
    const unsigned lds0 = (unsigned)(uintptr_t)shm;
    const unsigned short* ksrc = Kh + (size_t)lane * NPROJ + wid * 8;
    const unsigned short* vsrc = Vh + (size_t)(16 * (wid & 3) + (lane >> 2)) * NPROJ + (wid >> 2) * 32 + (lane & 3) * 8;
    const unsigned kdst = lds0 + LDS_K + wid * 1024, vdst = lds0 + LDS_V + wid * 1024;
#define DMA_K(t, so) glds16(ksrc + (size_t)(t) * 64 * NPROJ, (unsigned)__builtin_amdgcn_readfirstlane(kdst + (so)))
#define DMA_V(t, so) glds16(vsrc + (size_t)(t) * 64 * NPROJ, (unsigned)__builtin_amdgcn_readfirstlane(vdst + (so)))
#define WAIT_BAR() asm volatile("s_waitcnt vmcnt(0) lgkmcnt(0)\n\ts_barrier" ::: "memory")
#define SBAR() __builtin_amdgcn_sched_barrier(0)
    const lds_cptr shm3 = (lds_cptr)shm;
    const lds_cptr kp0 = shm3 + LDS_K + hi * 1024 + r32 * 16;
    const lds_cptr vp0 = shm3 + LDS_V + ((lane >> 4) & 1) * 32 + (lane & 3) * 8 + (4 * hi + ((lane & 15) >> 2)) * 64;
    const int NT = 4 * (qb + 1);
    const int qrel = wid * 32 + r32;
    asm volatile("s_waitcnt lgkmcnt(0)\n\ts_barrier" ::: "memory");
    DMA_K(NT - 1, 0); DMA_V(NT - 1, 0); DMA_K(NT - 2, SLOTB); DMA_V(NT - 2, SLOTB);
    bf16x8 qr[4];
#pragma unroll
    for (int d0 = 0; d0 < 4; ++d0) qr[d0] = *reinterpret_cast<const bf16x8*>(&Qw[(size_t)r32 * NPROJ + d0 * 16 + hi * 8]);
    f32x16 o[2]; o[0] = f32x16{}; o[1] = f32x16{};
    const f32x16 zero16 = f32x16{};
    float carry = 1.0f;
    WAIT_BAR();
    f32x16 pc0, pc1;
    {
#pragma unroll
        for (int d0 = 0; d0 < 4; ++d0) {
            const bf16x8 b0 = *(const __attribute__((address_space(3))) bf16x8*)(kp0 + d0 * 2048);
            const bf16x8 b1 = *(const __attribute__((address_space(3))) bf16x8*)(kp0 + d0 * 2048 + 512);
            pc0 = SBA_MFMA(b0, qr[d0], d0 ? pc0 : zero16); pc1 = SBA_MFMA(b1, qr[d0], d0 ? pc1 : zero16);
        }
        const int kb = 64 * 3 + 4 * hi;
#pragma unroll
        for (int r = 0; r < 16; ++r) { const int kv = kb + (r & 3) + 8 * (r >> 2); if (kv >= qrel) pc0[r] = -INFINITY; if (kv + 32 >= qrel) pc1[r] = -INFINITY; }
    }
    int s_cur = 0, s_nxt = SLOTB, s_nn = 2 * SLOTB;
    for (int t = NT - 1; t >= 0; --t) {
        WAIT_BAR();
        if (t >= 2) { DMA_K(t - 2, s_nn); DMA_V(t - 2, s_nn); }
        bf16x8 kf[8]; s16x4 vlo[8], vhi[8];
        { const lds_cptr kp = kp0 + s_nxt;
#pragma unroll
          for (int d0 = 0; d0 < 4; ++d0) { kf[2 * d0] = *(const __attribute__((address_space(3))) bf16x8*)(kp + d0 * 2048); kf[2 * d0 + 1] = *(const __attribute__((address_space(3))) bf16x8*)(kp + d0 * 2048 + 512); }
          const lds_cptr vp = vp0 + s_cur;
#pragma unroll
          for (int i = 0; i < 8; ++i) { vlo[i] = vtr(vp + (i >> 2) * 4096 + (i & 3) * 1024); vhi[i] = vtr(vp + (i >> 2) * 4096 + (i & 3) * 1024 + 512); } }
        f32x16 pn0, pn1; float av[2][16]; float st = carry; unsigned pw[4][4];
#define VFR(i) ((bf16x8){vlo[i][0], vlo[i][1], vlo[i][2], vlo[i][3], vhi[i][0], vhi[i][1], vhi[i][2], vhi[i][3]})
#define PAF(ks) __builtin_bit_cast(bf16x8, (v4u){pw[ks][0], pw[ks][1], pw[ks][2], pw[ks][3]})
#pragma unroll
        for (int j = 0; j < 8; ++j) {
            const int p = 1 - (j >> 2), g = 3 - (j & 3);
            SBAR();
            if ((j & 1) == 0) pn0 = SBA_MFMA(kf[j], qr[j >> 1], j ? pn0 : zero16); else pn1 = SBA_MFMA(kf[j], qr[j >> 1], (j >> 1) ? pn1 : zero16);
            if (j >= 2) { const int ks = 3 - ((j - 2) >> 1), d0 = j & 1; o[d0] = SBA_MFMA(PAF(ks), VFR(d0 * 4 + ks), o[d0]); }
            float k4[4];
#pragma unroll
            for (int e = 0; e < 4; ++e) { const float z = p ? pc1[4 * g + e] : pc0[4 * g + e]; k4[e] = __builtin_amdgcn_rcpf(1.0f + __builtin_amdgcn_exp2f(z)); }
            const float s1 = k4[3] * k4[2], s0 = s1 * k4[1], G = s0 * k4[0];
            const auto rr = __builtin_amdgcn_permlane32_swap(__float_as_uint(G), __float_as_uint(G), false, false);
            const float Glo = __uint_as_float(rr[0]), Ghi = __uint_as_float(rr[1]);
            const float base = st * (hi ? 1.0f : Ghi);
            av[p][4 * g + 3] = (1.0f - k4[3]) * base; av[p][4 * g + 2] = (1.0f - k4[2]) * (base * k4[3]); av[p][4 * g + 1] = (1.0f - k4[1]) * (base * s1); av[p][4 * g] = (1.0f - k4[0]) * (base * s0);
            st = st * (Glo * Ghi);
            if (j & 1) { const int ks = 3 - (j >> 1);
#pragma unroll
                for (int i = 0; i < 4; ++i) pw[ks][i] = cvtpk_s(av[ks >> 1][8 * (ks & 1) + 2 * i], av[ks >> 1][8 * (ks & 1) + 2 * i + 1]); }
        }
        SBAR();
        o[0] = SBA_MFMA(PAF(0), VFR(0), o[0]); o[1] = SBA_MFMA(PAF(0), VFR(4), o[1]);
        carry = st;
        pc0 = pn0; pc1 = pn1;
        if (t - 1 >= NT - 4) {
            const int kb = 64 * (t - 1 - (NT - 4)) + 4 * hi;
#pragma unroll
            for (int r = 0; r < 16; ++r) { const int kv = kb + (r & 3) + 8 * (r >> 2); if (kv >= qrel) pc0[r] = -INFINITY; if (kv + 32 >= qrel) pc1[r] = -INFINITY; }
        }
        { const int s = s_cur; s_cur = s_nxt; s_nxt = s_nn; s_nn = s; }
    }
#undef VFR
#undef PAF
    unsigned short* Ow = YMIX + (rowbase + q0 + wid * 32) * D + 512 + hd * 64;
#pragma unroll
    for (int r = 0; r < 16; ++r) { const int orow = (r & 3) + 8 * (r >> 2) + 4 * hi;
#pragma unroll
        for (int d0 = 0; d0 < 2; ++d0) Ow[(size_t)orow * D + d0 * 32 + r32] = (unsigned short)(cvtpk_s(o[d0][r], 0.f) & 0xffffu); }
#undef DMA_K
#undef DMA_V
#undef WAIT_BAR
#undef SBAR
}
__device__ __forceinline__ void phase(const unsigned short* PROJ, unsigned short* YMIX, char* shm) {
    const int G = gridDim.x, bx = blockIdx.x; const int vcu = (G % 8 == 0) ? (bx % 8) * (G / 8) + bx / 8 : bx;
    for (int v = vcu; v < 256; v += G) { const int bh = v >> 3, s = v & 7;
#pragma unroll 1
        for (int i = 0; i < 4; ++i) { const int qb = (i == 0) ? 31 - s : (i == 1) ? 16 + s : (i == 2) ? 15 - s : s; unit(bh >> 3, bh & 7, qb, PROJ, YMIX, shm); } }
}
}

__global__ void __launch_bounds__(NWAVES * 64, 2) mk_fwd(Args args) {
    extern __shared__ __attribute__((aligned(16))) unsigned char lds_raw[];
    LAS unsigned char* lds = (LAS unsigned char*)lds_raw;
    const int tid = threadIdx.x, lane = tid & 63, wave = __builtin_amdgcn_readfirstlane(tid >> 6);
    const int G = gridDim.x, gw = blockIdx.x * NWAVES + wave, NGW = G * NWAVES;
    unsigned char* ws = args.ws;
    float* ss1 = (float*)(ws + WS_CTL); float* ss2 = ss1 + M; float* ss3 = ss2 + M; float* ss4 = ss3 + M;
    bf16* XB = (bf16*)(ws + WS_XB); bf16* PB = (bf16*)(ws + WS_PB); bf16* HID = (bf16*)(ws + WS_HID); bf16* PROJ = HID; bf16* YMIX = (bf16*)(ws + WS_YMIX); bf16* PP = (bf16*)(ws + WS_PP);
    const int lo = args.ph_lo, hi = args.ph_hi;
    volatile LAS unsigned* MISC = (volatile LAS unsigned*)(lds + 131072);
    if (tid < 32) MISC[tid] = 0u;
    __syncthreads();
    XcdBarrier bar; bar.bar = (unsigned*)(ws + WS_BAR); bar.x = 0; bar.st = nullptr;
    if (hi - lo > 1) bar = xcd_barrier_post((unsigned*)(ws + WS_BAR), MISC + 8);
#define IN(k) (lo <= (k) && (k) < hi)
#define SEAM(k) do { if (IN(k) && IN((k) + 1)) { if ((k) == 0) cg::this_grid().sync(); else xcd_barrier(bar); } } while (0)
    typedef pg8::StaticOrder SO;
    if (IN(0)) { p0_prep(args, lds, gw, NGW, lane, wave); } SEAM(0);
    if (IN(1)) {
        { pg8::Gemm g{XB, (const bf16*)(ws + WS_W1GU), M, 2 * FF, D}; SO S; S.init(M, 2 * FF, G, (int)blockIdx.x); pg8::EpiSwiGLU E{HID, FF, ss1};
          pg8::gemm_phase<pg8::EpiSwiGLU, SO, true, true>(lds, g, S, E); }
        { pg8::Gemm g{PB, (const bf16*)(ws + WS_WPP), M, D, PLE}; SO S; S.init(M, D, G, (int)blockIdx.x); pg8::EpiScaleBf16 E{PP, D, nullptr};
          pg8::gemm_phase<pg8::EpiScaleBf16, SO, true, true>(lds, g, S, E); }
    } SEAM(1);
    if (IN(2)) { pg8::Gemm g{HID, (const bf16*)(ws + WS_W1D), M, D, FF}; SO S; S.init(M, D, G, (int)blockIdx.x); pg8::EpiResid<true> E{args.in[0], XB, ss2, 0.5f};
        pg8::gemm_phase<pg8::EpiResid<true>, SO, true, true>(lds, g, S, E); } SEAM(2);
    if (IN(3)) { pg8::Gemm g{XB, (const bf16*)(ws + WS_WIN), M, NPROJ, D}; SO S; S.init(M, NPROJ, G, (int)blockIdx.x); pg8::EpiScaleBf16 E{PROJ, NPROJ, ss2};
        pg8::gemm_phase<pg8::EpiScaleBf16, SO, true, true>(lds, g, S, E); } SEAM(3);
    if (IN(4)) { p4_mixprep(args, gw, NGW, lane); } SEAM(4);
    if (IN(5)) { if (ATTN_NAIVE) p5_attn_naive(args, tid); else sba::phase(PROJ, YMIX, (char*)lds_raw); } SEAM(5);
    if (IN(6)) { pg8::Gemm g{YMIX, (const bf16*)(ws + WS_WOUT), M, D, D}; SO S; S.init(M, D, G, (int)blockIdx.x); pg8::EpiResid<false> E{nullptr, XB, ss3, 1.0f};
        pg8::gemm_phase<pg8::EpiResid<false>, SO, true, true>(lds, g, S, E); } SEAM(6);
    if (IN(7)) { pg8::Gemm g{XB, (const bf16*)(ws + WS_W2GU), M, 2 * FF, D}; SO S; S.init(M, 2 * FF, G, (int)blockIdx.x); pg8::EpiSwiGLU E{HID, FF, ss3};
        pg8::gemm_phase<pg8::EpiSwiGLU, SO, true, true>(lds, g, S, E); } SEAM(7);
    if (IN(8)) { pg8::Gemm g{HID, (const bf16*)(ws + WS_W2D), M, D, FF}; SO S; S.init(M, D, G, (int)blockIdx.x); pg8::EpiResid<false> E{nullptr, XB, ss4, 0.5f};
        pg8::gemm_phase<pg8::EpiResid<false>, SO, true, true>(lds, g, S, E); } SEAM(8);
    if (IN(9)) { pg8::Gemm g{XB, (const bf16*)(ws + WS_WPG), M, D, D}; SO S; S.init(M, D, G, (int)blockIdx.x); pg8::EpiPle E{XB, args.out, PP, ss4};
        pg8::gemm_phase<pg8::EpiPle, SO, true, true>(lds, g, S, E); }
#undef IN
#undef SEAM
}

extern "C" void kernel_launch(void* const* d_in, const int* in_sizes, int n_in, void* d_out, int out_size, void* d_ws, size_t ws_size, hipStream_t stream) {
    static int grid = 0;
    if (grid == 0) {
        if (n_in != 20 || out_size != M * D || ws_size < WS_END) { fprintf(stderr, "kernel_launch: unexpected shapes (n_in %d out %d ws %zu)\n", n_in, out_size, ws_size); grid = -1; return; }
        int dev = 0, cus = 0, per_cu = 0;
        if (hipGetDevice(&dev) != hipSuccess || hipDeviceGetAttribute(&cus, hipDeviceAttributeMultiprocessorCount, dev) != hipSuccess) { grid = -1; return; }
        if (hipFuncSetAttribute((const void*)mk_fwd, hipFuncAttributeMaxDynamicSharedMemorySize, LDS_BYTES) != hipSuccess) { fprintf(stderr, "kernel_launch: hipFuncSetAttribute failed\n"); grid = -1; return; }
        if (hipOccupancyMaxActiveBlocksPerMultiprocessor(&per_cu, (const void*)mk_fwd, NWAVES * 64, LDS_BYTES) != hipSuccess || per_cu < 1) { fprintf(stderr, "kernel_launch: occupancy query says %d\n", per_cu); per_cu = 1; }
        (void)hipGetLastError();
        grid = cus;
    }
    if (grid < 0) return;
    (void)hipMemsetAsync((char*)d_ws + WS_CTL, 0, CTL_ZERO_BYTES, stream);
    Args a{};
    for (int i = 0; i < 20; ++i) a.in[i] = (const float*)d_in[i];
    a.out = (float*)d_out; a.ws = (unsigned char*)d_ws;
#if MK_ONE_LAUNCH
    a.ph_lo = 0; a.ph_hi = N_PHASES;
    void* kargs[] = {&a};
    hipError_t e = hipLaunchCooperativeKernel((const void*)mk_fwd, dim3(grid), dim3(NWAVES * 64), kargs, LDS_BYTES, stream);
    if (e != hipSuccess) fprintf(stderr, "kernel_launch: cooperative launch failed: %s\n", hipGetErrorString(e));
#else
    for (int ph = 0; ph < N_PHASES; ++ph) for (int rep = 0; rep < 1 + ((PROBE_DUP >> ph) & 1); ++rep) { a.ph_lo = ph; a.ph_hi = ph + 1; hipLaunchKernelGGL(mk_fwd, dim3(grid), dim3(NWAVES * 64), LDS_BYTES, stream, a); }
#endif
}
```

```cpp
#include <hip/hip_runtime.h>
#include <hip/hip_cooperative_groups.h>
#include <cstdio>
#include <cstdint>
namespace cg = cooperative_groups;
namespace pg8 {
#define PG8_LAS __attribute__((address_space(3)))
typedef unsigned short bf16_t;
typedef short bf16x8 __attribute__((ext_vector_type(8)));
typedef float f32x4 __attribute__((ext_vector_type(4)));
typedef unsigned u32x4 __attribute__((ext_vector_type(4)));
constexpr int BM = 256, BK = 64, HALF = 128, HTB = HALF * BK * 2  , STAGE_BYTES = 8 * HTB, NXCD = 8, WGM = 8;

__host__ __device__ __forceinline__ int lds_byte(int r, int c) { const int st = (r >> 4) * 2 + (c >> 5), rr = r & 15, cc = c & 31, ob = rr * 64 + cc * 2; return st * 1024 + (ob ^ (((ob >> 9) & 1) << 5)); }
__host__ __device__ __forceinline__ void stage_rc(int b, int& R, int& C) { const int st = b / 1024, sb = b % 1024, swz = sb ^ (((sb >> 9) & 1) << 5); R = (st >> 1) * 16 + swz / 64; C = (st & 1) * 32 + (swz % 64) / 2; }
__host__ __device__ __forceinline__ int perm32(int rho) { const int n = rho >> 4, i = rho & 15; return 8 * (i >> 2) + 4 * n + (i & 3); }

struct Unit { int pm, pn; };
struct Gemm { const bf16_t* A; const bf16_t* Bt; int M, N, K; };

struct StaticOrder {
    int nM, nN, nwg, G, c;
    __host__ __device__ void init(int M, int N, int G_, int c_) { nM = M / BM; nN = N / BM; nwg = nM * nN; G = G_; c = c_; }
    __host__ __device__ bool next(int i, Unit& u) const {
        const long L = (long)i * G + c; if (L >= nwg) return false;
        int wgid = (int)L; { const int q = nwg / NXCD, r = nwg % NXCD, xcd = wgid % NXCD, off = wgid / NXCD; wgid = (xcd < r ? xcd * (q + 1) : r * (q + 1) + (xcd - r) * q) + off; }
        const int nig = WGM * nN, gid = wgid / nig, fm = gid * WGM, gsz = (nM - fm) < WGM ? (nM - fm) : WGM;
        u.pm = fm + ((wgid % nig) % gsz); u.pn = (wgid % nig) / gsz; return true;
    }
    __device__ __forceinline__ void a_ready(const Unit&) const {}
    __device__ __forceinline__ void done(const Unit&) const {}
};

__device__ __forceinline__ unsigned cvt_pk_bf16(float lo, float hi) { unsigned r; asm volatile("v_cvt_pk_bf16_f32 %0, %1, %2" : "=v"(r) : "v"(lo), "v"(hi)); return r; }
typedef float f32x2 __attribute__((ext_vector_type(2)));
__device__ __forceinline__ float rs_of(float ss) { return rsqrtf(ss * (1.0f / 1024.0f) + 1e-6f); }
struct EpiSwiGLU {
    static constexpr bool PERM = true, AFTER_DRAIN = false;
    bf16_t* H; int ldh; const float* ss;
    __device__ __forceinline__ void operator()(const f32x4 (&acc)[2][2][4][2], const Unit& u, int wr, int wc, int fr, int fq) const {
        const int row0 = u.pm * BM + wr * 64 + fr, col0 = u.pn * HALF + wc * 32 + 8 * fq;
#pragma unroll
        for (int ai = 0; ai < 2; ++ai)
#pragma unroll
            for (int m = 0; m < 4; ++m) {
                const int row = row0 + ai * HALF + m * 16; const float rs = rs_of(ss[row]);
                unsigned ww[4];
#pragma unroll
                for (int n = 0; n < 2; ++n) { const f32x4 g = acc[ai][0][m][n] * rs, up = acc[ai][1][m][n] * rs; f32x4 hh;
#pragma unroll
                    for (int e = 0; e < 4; ++e) hh[e] = g[e] * __builtin_amdgcn_rcpf(1.0f + __builtin_amdgcn_exp2f(-1.4426950408889634f * g[e])) * up[e];
                    ww[2 * n] = cvt_pk_bf16(hh[0], hh[1]); ww[2 * n + 1] = cvt_pk_bf16(hh[2], hh[3]); }
                *(u32x4*)(H + (size_t)row * ldh + col0) = (u32x4){ww[0], ww[1], ww[2], ww[3]};
            }
    }
};
template <bool XF32> struct EpiResid {
    static constexpr bool PERM = true, AFTER_DRAIN = false;
    const float* xold; bf16_t* xb; float* ssq; float alpha;
    __device__ __forceinline__ void operator()(const f32x4 (&acc)[2][2][4][2], const Unit& u, int wr, int wc, int fr, int fq) const {
        const int row0 = u.pm * BM + wr * 64 + fr, colb = u.pn * BM + wc * 32 + 8 * fq;
#pragma unroll
        for (int ai = 0; ai < 2; ++ai)
#pragma unroll
            for (int m = 0; m < 4; ++m) {
                const int row = row0 + ai * HALF + m * 16; float s = 0.f;
#pragma unroll
                for (int bj = 0; bj < 2; ++bj) { const size_t off = (size_t)row * 1024 + colb + bj * HALF;
                    f32x4 o0, o1;
                    if (XF32) { o0 = *(const f32x4*)(xold + off); o1 = *(const f32x4*)(xold + off + 4); }
                    else { const u32x4 pw = *(const u32x4*)(xb + off);
                        o0[0] = __uint_as_float(pw[0] << 16); o0[1] = __uint_as_float(pw[0] & 0xffff0000u); o0[2] = __uint_as_float(pw[1] << 16); o0[3] = __uint_as_float(pw[1] & 0xffff0000u);
                        o1[0] = __uint_as_float(pw[2] << 16); o1[1] = __uint_as_float(pw[2] & 0xffff0000u); o1[2] = __uint_as_float(pw[3] << 16); o1[3] = __uint_as_float(pw[3] & 0xffff0000u); }
                    const f32x4 v0 = o0 + acc[ai][bj][m][0] * alpha, v1 = o1 + acc[ai][bj][m][1] * alpha;
                    *(u32x4*)(xb + off) = (u32x4){cvt_pk_bf16(v0[0], v0[1]), cvt_pk_bf16(v0[2], v0[3]), cvt_pk_bf16(v1[0], v1[1]), cvt_pk_bf16(v1[2], v1[3])};
                    s += (v0[0] * v0[0] + v0[1] * v0[1]) + (v0[2] * v0[2] + v0[3] * v0[3]) + (v1[0] * v1[0] + v1[1] * v1[1]) + (v1[2] * v1[2] + v1[3] * v1[3]); }
                s += __shfl_xor(s, 16); s += __shfl_xor(s, 32);
                if (fq == 0) __hip_atomic_fetch_add(ssq + row, s, __ATOMIC_RELAXED, __HIP_MEMORY_SCOPE_AGENT);
            }
    }
};
struct EpiScaleBf16 {
    static constexpr bool PERM = true, AFTER_DRAIN = false;
    bf16_t* O; int ldc; const float* ss;
    __device__ __forceinline__ void operator()(const f32x4 (&acc)[2][2][4][2], const Unit& u, int wr, int wc, int fr, int fq) const {
        const int row0 = u.pm * BM + wr * 64 + fr, colb = u.pn * BM + wc * 32 + 8 * fq;
#pragma unroll
        for (int ai = 0; ai < 2; ++ai)
#pragma unroll
            for (int m = 0; m < 4; ++m) {
                const int row = row0 + ai * HALF + m * 16; const float rs = ss ? rs_of(ss[row]) : 1.0f;
#pragma unroll
                for (int bj = 0; bj < 2; ++bj) { const f32x4 v0 = acc[ai][bj][m][0] * rs, v1 = acc[ai][bj][m][1] * rs;
                    *(u32x4*)(O + (size_t)row * ldc + colb + bj * HALF) = (u32x4){cvt_pk_bf16(v0[0], v0[1]), cvt_pk_bf16(v0[2], v0[3]), cvt_pk_bf16(v1[0], v1[1]), cvt_pk_bf16(v1[2], v1[3])}; }
            }
    }
};
struct EpiPle {
    static constexpr bool PERM = true, AFTER_DRAIN = false;
    const bf16_t* xold; float* out; const bf16_t* PP; const float* ss;
    __device__ __forceinline__ void operator()(const f32x4 (&acc)[2][2][4][2], const Unit& u, int wr, int wc, int fr, int fq) const {
        const int row0 = u.pm * BM + wr * 64 + fr, colb = u.pn * BM + wc * 32 + 8 * fq;
#pragma unroll
        for (int ai = 0; ai < 2; ++ai)
#pragma unroll
            for (int m = 0; m < 4; ++m) {
                const int row = row0 + ai * HALF + m * 16; const float rs = rs_of(ss[row]) * -1.4426950408889634f;
#pragma unroll
                for (int bj = 0; bj < 2; ++bj) { const size_t off = (size_t)row * 1024 + colb + bj * HALF;
                    const u32x4 xw = *(const u32x4*)(xold + off); const u32x4 pw = *(const u32x4*)(PP + off); f32x4 o0, o1;
                    o0[0] = __uint_as_float(xw[0] << 16); o0[1] = __uint_as_float(xw[0] & 0xffff0000u); o0[2] = __uint_as_float(xw[1] << 16); o0[3] = __uint_as_float(xw[1] & 0xffff0000u);
                    o1[0] = __uint_as_float(xw[2] << 16); o1[1] = __uint_as_float(xw[2] & 0xffff0000u); o1[2] = __uint_as_float(xw[3] << 16); o1[3] = __uint_as_float(xw[3] & 0xffff0000u);
                    f32x4 p0, p1; p0[0] = __uint_as_float(pw[0] << 16); p0[1] = __uint_as_float(pw[0] & 0xffff0000u); p0[2] = __uint_as_float(pw[1] << 16); p0[3] = __uint_as_float(pw[1] & 0xffff0000u);
                    p1[0] = __uint_as_float(pw[2] << 16); p1[1] = __uint_as_float(pw[2] & 0xffff0000u); p1[2] = __uint_as_float(pw[3] << 16); p1[3] = __uint_as_float(pw[3] & 0xffff0000u);
                    f32x4 v0, v1;
#pragma unroll
                    for (int e = 0; e < 4; ++e) { v0[e] = o0[e] + __builtin_amdgcn_rcpf(1.0f + __builtin_amdgcn_exp2f(acc[ai][bj][m][0][e] * rs)) * p0[e];
                                                  v1[e] = o1[e] + __builtin_amdgcn_rcpf(1.0f + __builtin_amdgcn_exp2f(acc[ai][bj][m][1][e] * rs)) * p1[e]; }
                    *(f32x4*)(out + off) = v0; *(f32x4*)(out + off + 4) = v1; }
            }
    }
};
template <class Epi, class Sched, bool ALIGN_EPI = false, bool SP2 = false>
__device__ __forceinline__ void gemm_phase(PG8_LAS unsigned char* lds, const Gemm g, const Sched& S, const Epi& E) {
    const int tid = threadIdx.x, wid = __builtin_amdgcn_readfirstlane(tid >> 6), lane = tid & 63, wr = wid >> 2, wc = wid & 3, fr = lane & 15, fq = lane >> 4;
    const int K = g.K, nt = K / BK;
    unsigned voffA[2], voffB[2];
#pragma unroll
    for (int i = 0; i < 2; ++i) { int R, C; stage_rc(tid * 16 + i * 8192, R, C); const int Rb = Epi::PERM ? ((R & ~31) + perm32(R & 31)) : R;
        voffA[i] = (unsigned)(R * K + C) * 2u; voffB[i] = (unsigned)(Rb * K + C) * 2u; }
    const size_t kstep = (size_t)(BK * 2);
    const size_t hstep = (size_t)HALF * K * 2;
    const size_t tstep = 2 * hstep;
    const unsigned ldsw = (unsigned)wid * 1024u;
    const int aoff = lds_byte(wr * 64 + fr, fq * 8), boff = lds_byte(wc * 32 + fr, fq * 8);
#define PG8_SA(b, h) (((b) * 2 + (h)) * HTB)
#define PG8_SB(b, h) ((4 + (b) * 2 + (h)) * HTB)
#define PG8_STAGE(bufoff, gbase, voff) do { _Pragma("unroll") for (int _i = 0; _i < 2; ++_i) \
        __builtin_amdgcn_global_load_lds((const unsigned*)((const char*)(gbase) + (voff)[_i]), (PG8_LAS unsigned*)(lds + (bufoff) + ldsw + _i * 8192), 16, 0, 0); } while (0)
#define PG8_LDA(dst, b, h) do { _Pragma("unroll") for (int m = 0; m < 4; ++m) _Pragma("unroll") for (int k = 0; k < 2; ++k) dst[m][k] = *(const PG8_LAS bf16x8*)(lds + PG8_SA(b, h) + aoff + m * 2048 + k * 1024); } while (0)
#define PG8_LDB(dst, b, h) do { _Pragma("unroll") for (int n = 0; n < 2; ++n) _Pragma("unroll") for (int k = 0; k < 2; ++k) dst[n][k] = *(const PG8_LAS bf16x8*)(lds + PG8_SB(b, h) + boff + n * 2048 + k * 1024); } while (0)
#define PG8_MMA(ai, bj, At, Bt) do { __builtin_amdgcn_s_setprio(1); _Pragma("unroll") for (int m = 0; m < 4; ++m) _Pragma("unroll") for (int n = 0; n < 2; ++n) _Pragma("unroll") for (int k = 0; k < 2; ++k) \
        acc[ai][bj][m][n] = __builtin_amdgcn_mfma_f32_16x16x32_bf16(Bt[n][k], At[m][k], acc[ai][bj][m][n], 0, 0, 0); __builtin_amdgcn_s_setprio(0); } while (0)
#define PG8_WAIT_V(n) asm volatile("s_waitcnt vmcnt(" #n ")" ::: "memory")
#define PG8_WAIT_L(n) asm volatile("s_waitcnt lgkmcnt(" #n ")" ::: "memory")
#define PG8_BAR __builtin_amdgcn_s_barrier()
#define PG8_SCHED __builtin_amdgcn_sched_barrier(0)
    Unit cur, nxt; int ui = 0;
    if (!S.next(0, cur)) return;
    f32x4 acc[2][2][4][2];
#pragma unroll
    for (int a = 0; a < 2; ++a)
#pragma unroll
        for (int b = 0; b < 2; ++b)
#pragma unroll
            for (int m = 0; m < 4; ++m)
#pragma unroll
                for (int n = 0; n < 2; ++n) acc[a][b][m][n] = (f32x4){0.f, 0.f, 0.f, 0.f};
    bf16x8 At[4][2], B0[2][2], B1[2][2];
    const char* cA = (const char*)g.A + (size_t)cur.pm * tstep; const char* cB = (const char*)g.Bt + (size_t)cur.pn * tstep;
    S.a_ready(cur);
    if constexpr (SP2) {
        PG8_STAGE(PG8_SB(0, 0), cB, voffB); PG8_STAGE(PG8_SB(0, 1), cB + hstep, voffB); PG8_STAGE(PG8_SA(0, 0), cA, voffA); PG8_STAGE(PG8_SA(0, 1), cA + hstep, voffA);
        if (wr == 1) PG8_BAR;
        PG8_WAIT_V(2); PG8_BAR;
        PG8_STAGE(PG8_SB(1, 0), cB + kstep, voffB); PG8_STAGE(PG8_SA(1, 0), cA + kstep, voffA); PG8_STAGE(PG8_SB(1, 1), cB + hstep + kstep, voffB);
        PG8_WAIT_V(6); PG8_BAR;
    } else {
        PG8_STAGE(PG8_SB(0, 0), cB, voffB); PG8_STAGE(PG8_SA(0, 0), cA, voffA); PG8_STAGE(PG8_SB(0, 1), cB + hstep, voffB); PG8_STAGE(PG8_SA(0, 1), cA + hstep, voffA);
        if (wr == 1) PG8_BAR;
        PG8_WAIT_V(4); PG8_BAR;
        PG8_STAGE(PG8_SB(1, 0), cB + kstep, voffB); PG8_STAGE(PG8_SA(1, 0), cA + kstep, voffA); PG8_STAGE(PG8_SB(1, 1), cB + hstep + kstep, voffB);
        PG8_WAIT_V(6); PG8_BAR;
    }
    for (;;) {
        const bool has_next = S.next(ui + 1, nxt);
        const char* nA = has_next ? (const char*)g.A + (size_t)nxt.pm * tstep : cA; const char* nB = has_next ? (const char*)g.Bt + (size_t)nxt.pn * tstep : cB;
        for (int t = 0; t < nt; t += 2) {
            const bool last = (t == nt - 2);
            const char* a1 = cA + (size_t)(t + 1) * kstep;
            const char* a2 = last ? nA : cA + (size_t)(t + 2) * kstep; const char* b2 = last ? nB : cB + (size_t)(t + 2) * kstep;
            const char* a3 = a2 + kstep; const char* b3 = b2 + kstep;
            if (last && has_next) S.a_ready(nxt);
            if constexpr (SP2) {
            PG8_LDB(B0, 0, 0); PG8_LDB(B1, 0, 1); PG8_SCHED; PG8_LDA(At, 0, 0); PG8_STAGE(PG8_SA(1, 1), a1 + hstep, voffA);
            PG8_WAIT_V(8); PG8_WAIT_L(0); PG8_BAR; PG8_MMA(0, 0, At, B0); PG8_MMA(0, 1, At, B1); PG8_BAR; PG8_SCHED;
            PG8_LDA(At, 0, 1); PG8_STAGE(PG8_SB(0, 0), b2, voffB); PG8_STAGE(PG8_SB(0, 1), b2 + hstep, voffB); PG8_STAGE(PG8_SA(0, 0), a2, voffA);
            PG8_WAIT_V(8); PG8_WAIT_L(0); PG8_BAR; PG8_MMA(1, 0, At, B0); PG8_MMA(1, 1, At, B1); PG8_BAR; PG8_SCHED;
            PG8_LDB(B0, 1, 0); PG8_LDB(B1, 1, 1); PG8_SCHED; PG8_LDA(At, 1, 0); PG8_STAGE(PG8_SA(0, 1), a2 + hstep, voffA);
            PG8_WAIT_V(8); PG8_WAIT_L(0); PG8_BAR; PG8_MMA(0, 0, At, B0); PG8_MMA(0, 1, At, B1); PG8_BAR; PG8_SCHED;
            PG8_LDA(At, 1, 1); PG8_STAGE(PG8_SB(1, 0), b3, voffB); PG8_STAGE(PG8_SB(1, 1), b3 + hstep, voffB); PG8_STAGE(PG8_SA(1, 0), a3, voffA);
            PG8_WAIT_V(8); PG8_WAIT_L(0); PG8_BAR; PG8_MMA(1, 0, At, B0); PG8_MMA(1, 1, At, B1); PG8_BAR; PG8_SCHED;
            } else {
            PG8_LDB(B0, 0, 0); PG8_SCHED; PG8_LDA(At, 0, 0); PG8_STAGE(PG8_SA(1, 1), a1 + hstep, voffA);
            PG8_WAIT_L(8); PG8_BAR; PG8_WAIT_L(0); PG8_MMA(0, 0, At, B0); PG8_BAR; PG8_SCHED;
            PG8_LDB(B1, 0, 1); PG8_STAGE(PG8_SB(0, 0), b2, voffB);
            PG8_BAR; PG8_WAIT_L(0); PG8_MMA(0, 1, At, B1); PG8_BAR;
            PG8_LDA(At, 0, 1); PG8_STAGE(PG8_SA(0, 0), a2, voffA);
            PG8_BAR; PG8_WAIT_L(0); PG8_MMA(1, 0, At, B0); PG8_BAR; PG8_SCHED;
            PG8_STAGE(PG8_SB(0, 1), b2 + hstep, voffB);
            PG8_WAIT_V(6); PG8_BAR; PG8_MMA(1, 1, At, B1); PG8_BAR;
            PG8_LDB(B0, 1, 0); PG8_SCHED; PG8_LDA(At, 1, 0); PG8_STAGE(PG8_SA(0, 1), a2 + hstep, voffA);
            PG8_WAIT_L(8); PG8_BAR; PG8_WAIT_L(0); PG8_MMA(0, 0, At, B0); PG8_BAR; PG8_SCHED;
            PG8_LDB(B1, 1, 1); PG8_STAGE(PG8_SB(1, 0), b3, voffB);
            PG8_BAR; PG8_WAIT_L(0); PG8_MMA(0, 1, At, B1); PG8_BAR;
            PG8_LDA(At, 1, 1); PG8_STAGE(PG8_SA(1, 0), a3, voffA);
            PG8_BAR; PG8_WAIT_L(0); PG8_MMA(1, 0, At, B0); PG8_BAR; PG8_SCHED;
            PG8_STAGE(PG8_SB(1, 1), b3 + hstep, voffB);
            PG8_WAIT_V(6); PG8_BAR; PG8_MMA(1, 1, At, B1); PG8_BAR;
            }
        }
        if constexpr (ALIGN_EPI) { if (wr == 0) PG8_BAR; }
        if constexpr (!Epi::AFTER_DRAIN) { E(acc, cur, wr, wc, fr, fq); S.done(cur); }
        if (!has_next) break;
#pragma unroll
        for (int a = 0; a < 2; ++a)
#pragma unroll
            for (int b = 0; b < 2; ++b)
#pragma unroll
                for (int m = 0; m < 4; ++m)
#pragma unroll
                    for (int n = 0; n < 2; ++n) acc[a][b][m][n] = (f32x4){0.f, 0.f, 0.f, 0.f};
        cur = nxt; cA = nA; cB = nB; ++ui;
        if constexpr (ALIGN_EPI) { if (wr == 1) PG8_BAR; }
    }
    PG8_WAIT_V(0);
    if constexpr (!ALIGN_EPI) { if (wr == 0) PG8_BAR; }
    PG8_BAR;
    if constexpr (Epi::AFTER_DRAIN) { E.fused(acc, cur, wr, wc, fr, fq, lds, wid, lane); S.done(cur); }
#undef PG8_SA
#undef PG8_SB
#undef PG8_STAGE
#undef PG8_LDA
#undef PG8_LDB
#undef PG8_MMA
#undef PG8_WAIT_V
#undef PG8_WAIT_L
#undef PG8_BAR
#undef PG8_SCHED
}
}

constexpr int NWAVES = 8;
constexpr int BATCH = 4, SEQ = 8192, D = 1024, FF = 2816, NPROJ = 3072, PLE = 256, NH = 8, HD = 64, CONVD = 512;
constexpr int M = BATCH * SEQ;
#ifndef PROBE_DUP
#define PROBE_DUP 0
#endif
#ifndef MK_ONE_LAUNCH
#define MK_ONE_LAUNCH 1
#endif
constexpr int N_PHASES = 10;
constexpr size_t MiB = 1u << 20;
constexpr size_t WS_CTL = 0, CTL_ZERO_BYTES = 1 * MiB;
constexpr size_t WS_W1GU = 2 * MiB, WS_W1D = 13 * MiB, WS_WIN = 19 * MiB, WS_WOUT = 25 * MiB, WS_W2GU = 27 * MiB, WS_W2D = 38 * MiB, WS_WPG = 44 * MiB, WS_WPP = 46 * MiB;
constexpr size_t WS_XB = 48 * MiB;
constexpr size_t WS_PB = 112 * MiB;
constexpr size_t WS_HID = 128 * MiB;
constexpr size_t WS_YMIX = 320 * MiB;
constexpr size_t WS_PP = 384 * MiB;
constexpr size_t WS_END = 448 * MiB;
#ifndef ATTN_NAIVE
#define ATTN_NAIVE 0
#endif
constexpr float QSC = ATTN_NAIVE ? 0.125f : 0.125f * 1.4426950408889634f;
constexpr int LDS_BYTES = 147456;

#define GAS __attribute__((address_space(1)))
#define LAS __attribute__((address_space(3)))
typedef unsigned short bf16;
typedef unsigned v4u __attribute__((ext_vector_type(4)));
typedef float f32x4 __attribute__((ext_vector_type(4)));
#define LDS_WAIT() asm volatile("s_waitcnt lgkmcnt(0)" ::: "memory")
__device__ __forceinline__ unsigned pk2(float lo, float hi) { return pg8::cvt_pk_bf16(lo, hi); }
__device__ __forceinline__ float bflo(unsigned w) { return __uint_as_float(w << 16); }
__device__ __forceinline__ float bfhi(unsigned w) { return __uint_as_float(w & 0xffff0000u); }
__device__ __forceinline__ float wave_sum(float v) {
#pragma unroll
    for (int o = 1; o < 64; o <<= 1) v += __shfl_xor(v, o);
    return v;
}

#define XB_TMO      128
#define XB_XCNT(j)  (256  + 64 * (j))
#define XB_XSUB(j)  (1280 + 64 * (j))
#define XB_XGEN(j)  (2304 + 64 * (j))
#define XB_TOP      3328
#define XB_TOPGEN   3392
#define XCD_BAR_WORDS 3456
#define XB_SPIN_CAP (1u << 18)

__device__ __forceinline__ unsigned xb_ld(unsigned* p)              { return __hip_atomic_load(p, __ATOMIC_RELAXED, __HIP_MEMORY_SCOPE_AGENT); }
__device__ __forceinline__ unsigned xb_add(unsigned* p, unsigned v) { return __hip_atomic_fetch_add(p, v, __ATOMIC_RELAXED, __HIP_MEMORY_SCOPE_AGENT); }
__device__ __forceinline__ unsigned xb_xcc_id() { return (unsigned)__builtin_amdgcn_s_getreg((3 << 11) | 20) & 0xFu; }
#define XB_SPIN(cond, bar) do { unsigned _sp = 0; while (cond) { __builtin_amdgcn_s_sleep(1); \
    if ((++_sp & 255u) == 0u) { if (xb_ld(&(bar)[XB_TMO])) break; if (_sp > XB_SPIN_CAP) { atomicAdd(&(bar)[XB_TMO], 1u); break; } } } } while (0)

struct XcdBarrier {
    unsigned* bar; unsigned x;
    volatile LAS unsigned* st;
};

__device__ __forceinline__ XcdBarrier xcd_barrier_post(unsigned* bar, volatile LAS unsigned* st) {
    XcdBarrier b; b.bar = bar; b.x = xb_xcc_id(); b.st = st;
    if (threadIdx.x == 0) (void)xb_add(&bar[XB_XCNT(b.x)], 1u);
    return b;
}
__device__ __forceinline__ void xcd_barrier_complete(unsigned* bar, unsigned x, unsigned& nloc, unsigned& nx) {
    const unsigned G = gridDim.x * gridDim.y * gridDim.z;
    unsigned sum, cnt, mine, sp = 0u;
    for (;;) {
        sum = 0u; cnt = 0u; mine = 0u;
#pragma unroll
        for (unsigned j = 0; j < 16; ++j) { const unsigned c = xb_ld(&bar[XB_XCNT(j)]); sum += c; cnt += (c > 0u) ? 1u : 0u; mine = (j == x) ? c : mine; }
        if (sum == G) break;
        __builtin_amdgcn_s_sleep(1);
        if ((++sp & 255u) == 0u) { if (xb_ld(&bar[XB_TMO])) break; if (sp > XB_SPIN_CAP) { atomicAdd(&bar[XB_TMO], 1u); break; } }
    }
    nloc = mine > 0u ? mine : 1u; nx = cnt > 0u ? cnt : 1u;
}

__device__ __forceinline__ void xcd_barrier(const XcdBarrier& b) {
    asm volatile("s_waitcnt vmcnt(0)" ::: "memory");
    __syncthreads();
    if (threadIdx.x == 0) {
        unsigned* bar = b.bar;
        __builtin_amdgcn_s_waitcnt(0);
        unsigned nloc = b.st[0], nx = b.st[1];
        if (nloc == 0u) { xcd_barrier_complete(bar, b.x, nloc, nx); b.st[0] = nloc; b.st[1] = nx; }
        const unsigned old = xb_add(&bar[XB_XSUB(b.x)], 1u);
        const unsigned gen = old / nloc;
        if (old + 1u == (gen + 1u) * nloc) {
            __builtin_amdgcn_fence(__ATOMIC_RELEASE, "agent");
            asm volatile("s_waitcnt vmcnt(0)" ::: "memory");
            const unsigned og = xb_add(&bar[XB_TOP], 1u);
            const unsigned tg = og / nx;
            if (og + 1u == (tg + 1u) * nx) xb_add(&bar[XB_TOPGEN], 1u);
            else XB_SPIN(xb_ld(&bar[XB_TOPGEN]) == tg, bar);
            __builtin_amdgcn_fence(__ATOMIC_ACQUIRE, "agent");
            xb_add(&bar[XB_XGEN(b.x)], 1u);
            asm volatile("s_waitcnt vmcnt(0)" ::: "memory");
        } else {
            XB_SPIN(xb_ld(&bar[XB_XGEN(b.x)]) == gen, bar);
            __builtin_amdgcn_fence(__ATOMIC_ACQUIRE, "agent");
            asm volatile("s_waitcnt vmcnt(0)" ::: "memory");
        }
    }
    __syncthreads();
}

constexpr size_t WS_BAR = 768 * 1024;
struct Args { const float* in[20]; float* out; unsigned char* ws; int ph_lo, ph_hi; };

__device__ __forceinline__ void tr_item(const float* __restrict__ W, int K, int N, const float* __restrict__ gain, bf16* __restrict__ WT, int dst_row0, LAS float* scr, int k0, int n0, int lane) {
    float w[32]; const float* wp = W + (size_t)(k0 + (lane >> 5)) * N + n0 + (lane & 31);
#pragma unroll
    for (int i = 0; i < 32; ++i) w[i] = wp[(size_t)(2 * i) * N];
    if (gain) {
#pragma unroll
        for (int i = 0; i < 32; ++i) w[i] *= gain[k0 + 2 * i + (lane >> 5)];
    }
#pragma unroll
    for (int i = 0; i < 32; ++i) scr[(2 * i + (lane >> 5)) * 33 + (lane & 31)] = w[i];
    LDS_WAIT(); asm volatile("" ::: "memory");
    const int c = lane & 7;
#pragma unroll
    for (int j = 0; j < 4; ++j) { const int n = (lane >> 3) + 8 * j; const LAS float* s = scr + (8 * c) * 33 + n;
        v4u o; o.x = pk2(s[0 * 33], s[1 * 33]); o.y = pk2(s[2 * 33], s[3 * 33]); o.z = pk2(s[4 * 33], s[5 * 33]); o.w = pk2(s[6 * 33], s[7 * 33]);
        *(v4u*)(WT + (size_t)(dst_row0 + n) * K + k0 + 8 * c) = o; }
    LDS_WAIT(); asm volatile("" ::: "memory");
}
__device__ __forceinline__ bool tr_matrix(int& r, const float* W, int K, int N, const float* gain, bf16* WT, int mode, LAS float* scr, int lane) {
    const int nblk = N / 32, items = (K / 64) * nblk;
    if (r >= items) { r -= items; return false; }
    const int kb = r / nblk, nb = r % nblk, n0 = 32 * nb;
    const int dst = mode == 0 ? n0 : (256 * (n0 >> 7) + (n0 & 127) + (mode == 2 ? 128 : 0));
    tr_item(W, K, N, gain, WT, dst, scr, 64 * kb, n0, lane);
    return true;
}
__device__ __forceinline__ void p0_prep(const Args& a, LAS unsigned char* lds, int gw, int NGW, int lane, int wave) {
    unsigned char* ws = a.ws;
    LAS float* scr = (LAS float*)(lds + wave * 16384);
    constexpr int I_GU = (D / 64) * (FF / 32), I_DN = (FF / 64) * (D / 32), I_IN = (D / 64) * (NPROJ / 32), I_SQ = (D / 64) * (D / 32), I_PP = (PLE / 64) * (D / 32);
    constexpr int NITEMS = 4 * I_GU + 2 * I_DN + I_IN + 2 * I_SQ + I_PP;
    for (int it = gw; it < NITEMS; it += NGW) {
        int r = it;
        if (tr_matrix(r, a.in[3], D, FF, a.in[2], (bf16*)(ws + WS_W1GU), 1, scr, lane)) continue;
        if (tr_matrix(r, a.in[4], D, FF, a.in[2], (bf16*)(ws + WS_W1GU), 2, scr, lane)) continue;
        if (tr_matrix(r, a.in[14], D, FF, a.in[13], (bf16*)(ws + WS_W2GU), 1, scr, lane)) continue;
        if (tr_matrix(r, a.in[15], D, FF, a.in[13], (bf16*)(ws + WS_W2GU), 2, scr, lane)) continue;
        if (tr_matrix(r, a.in[5], FF, D, nullptr, (bf16*)(ws + WS_W1D), 0, scr, lane)) continue;
        if (tr_matrix(r, a.in[16], FF, D, nullptr, (bf16*)(ws + WS_W2D), 0, scr, lane)) continue;
        if (tr_matrix(r, a.in[7], D, NPROJ, a.in[6], (bf16*)(ws + WS_WIN), 0, scr, lane)) continue;
        if (tr_matrix(r, a.in[12], D, D, nullptr, (bf16*)(ws + WS_WOUT), 0, scr, lane)) continue;
        if (tr_matrix(r, a.in[18], D, D, a.in[17], (bf16*)(ws + WS_WPG), 0, scr, lane)) continue;
        tr_matrix(r, a.in[19], PLE, D, nullptr, (bf16*)(ws + WS_WPP), 0, scr, lane);
    }
    const float* __restrict__ x = a.in[0]; bf16* __restrict__ XB = (bf16*)(ws + WS_XB); float* __restrict__ ss1 = (float*)(ws + WS_CTL);
    for (int m0 = gw * 4; m0 < M; m0 += NGW * 4) {
        f32x4 v[4][4];
#pragma unroll
        for (int r = 0; r < 4; ++r)
#pragma unroll
            for (int j = 0; j < 4; ++j) v[r][j] = ((const f32x4*)(x + (size_t)(m0 + r) * D) + lane)[64 * j];
#pragma unroll
        for (int r = 0; r < 4; ++r) { float s = 0.f;
#pragma unroll
            for (int j = 0; j < 4; ++j) s += (v[r][j].x * v[r][j].x + v[r][j].y * v[r][j].y) + (v[r][j].z * v[r][j].z + v[r][j].w * v[r][j].w);
            s = wave_sum(s);
            unsigned long long* o8 = (unsigned long long*)(XB + (size_t)(m0 + r) * D) + lane;
#pragma unroll
            for (int j = 0; j < 4; ++j) o8[64 * j] = (unsigned long long)pk2(v[r][j].x, v[r][j].y) | ((unsigned long long)pk2(v[r][j].z, v[r][j].w) << 32);
            if (lane == 0) ss1[m0 + r] = s; }
    }
    const float* __restrict__ p = a.in[1]; bf16* __restrict__ PB = (bf16*)(ws + WS_PB);
    for (int i0 = gw * 64 + lane; i0 < M * PLE / 8; i0 += NGW * 64 * 4) {
        f32x4 v0[4], v1[4];
#pragma unroll
        for (int r = 0; r < 4; ++r) { const size_t i = (size_t)i0 + (size_t)r * NGW * 64; v0[r] = *(const f32x4*)(p + i * 8); v1[r] = *(const f32x4*)(p + i * 8 + 4); }
#pragma unroll
        for (int r = 0; r < 4; ++r) { const size_t i = (size_t)i0 + (size_t)r * NGW * 64; *(v4u*)(PB + i * 8) = (v4u){pk2(v0[r].x, v0[r].y), pk2(v0[r].z, v0[r].w), pk2(v1[r].x, v1[r].y), pk2(v1[r].z, v1[r].w)}; }
    }
}

__device__ __forceinline__ void unpack8(const v4u w, float (&f)[8]) { f[0] = bflo(w.x); f[1] = bfhi(w.x); f[2] = bflo(w.y); f[3] = bfhi(w.y); f[4] = bflo(w.z); f[5] = bfhi(w.z); f[6] = bflo(w.w); f[7] = bfhi(w.w); }
__device__ __forceinline__ v4u pack8(const float (&f)[8]) { return (v4u){pk2(f[0], f[1]), pk2(f[2], f[3]), pk2(f[4], f[5]), pk2(f[6], f[7])}; }
__device__ __forceinline__ void p4_mixprep(const Args& a, int gw, int NGW, int lane) {
    bf16* PROJ = (bf16*)(a.ws + WS_HID); bf16* YMIX = (bf16*)(a.ws + WS_YMIX);
    const float* cw = a.in[8]; const float* cbp = a.in[9]; const float* gq = a.in[10]; const float* gk = a.in[11];
    float w0[8], w1[8], w2[8], cb[8], gqv[8], gkv[8];
#pragma unroll
    for (int i = 0; i < 8; ++i) { w0[i] = cw[8 * lane + i]; w1[i] = cw[CONVD + 8 * lane + i]; w2[i] = cw[2 * CONVD + 8 * lane + i]; cb[i] = cbp[8 * lane + i];
        gqv[i] = gq[(lane & 7) * 8 + i] * QSC; gkv[i] = gk[(lane & 7) * 8 + i]; }
    for (int ch = gw; ch < M / 16; ch += NGW) {
        const int r0 = ch * 16; float z1[8], z2[8];
        if ((r0 & (SEQ - 1)) == 0) {
#pragma unroll
            for (int i = 0; i < 8; ++i) { z1[i] = 0.f; z2[i] = 0.f; }
        } else {
            float c[8], u[8];
            const bf16* pr = PROJ + (size_t)(r0 - 1) * NPROJ + 8 * lane; unpack8(*(const v4u*)(pr + 512), c); unpack8(*(const v4u*)(pr + 1024), u);
#pragma unroll
            for (int i = 0; i < 8; ++i) z1[i] = c[i] * u[i];
            pr -= NPROJ; unpack8(*(const v4u*)(pr + 512), c); unpack8(*(const v4u*)(pr + 1024), u);
#pragma unroll
            for (int i = 0; i < 8; ++i) z2[i] = c[i] * u[i];
        }
        for (int r = r0; r < r0 + 16; ++r) {
            bf16* pr = PROJ + (size_t)r * NPROJ + 8 * lane;
            float b[8], c[8], u[8], q[8], k[8], y[8];
            unpack8(*(const v4u*)(pr), b); unpack8(*(const v4u*)(pr + 512), c); unpack8(*(const v4u*)(pr + 1024), u);
            unpack8(*(const v4u*)(pr + 1536), q); unpack8(*(const v4u*)(pr + 2048), k);
#pragma unroll
            for (int i = 0; i < 8; ++i) { const float z0 = c[i] * u[i]; y[i] = b[i] * (w0[i] * z2[i] + w1[i] * z1[i] + w2[i] * z0 + cb[i]); z2[i] = z1[i]; z1[i] = z0; }
            *(v4u*)(YMIX + (size_t)r * D + 8 * lane) = pack8(y);
            float sq = 0.f, sk = 0.f;
#pragma unroll
            for (int i = 0; i < 8; ++i) { sq += q[i] * q[i]; sk += k[i] * k[i]; }
            sq += __shfl_xor(sq, 1); sq += __shfl_xor(sq, 2); sq += __shfl_xor(sq, 4);
            sk += __shfl_xor(sk, 1); sk += __shfl_xor(sk, 2); sk += __shfl_xor(sk, 4);
            const float rq = rsqrtf(sq * (1.0f / 64.0f) + 1e-6f), rk = rsqrtf(sk * (1.0f / 64.0f) + 1e-6f);
#pragma unroll
            for (int i = 0; i < 8; ++i) { q[i] *= rq * gqv[i]; k[i] *= rk * gkv[i]; }
            *(v4u*)(pr + 1536) = pack8(q); *(v4u*)(pr + 2048) = pack8(k);
        }
    }
}

__device__ __forceinline__ void p5_attn_naive(const Args& a, int tid) {
    const bf16* PROJ = (const bf16*)(a.ws + WS_HID); bf16* YMIX = (bf16*)(a.ws + WS_YMIX);
    for (int un = blockIdx.x; un < 512; un += gridDim.x) {
        const int bh = un & 31, r = un >> 5, qq = r < 8 ? r : 23 - r, b = bh >> 3, h = bh & 7;
        const int t = qq * 512 + tid;
        const bf16* base = PROJ + (size_t)b * SEQ * NPROJ + h * HD;
        float q[64], o[64];
#pragma unroll
        for (int c = 0; c < 8; ++c) { float f[8]; unpack8(*(const v4u*)(base + (size_t)t * NPROJ + 1536 + 8 * c), f);
#pragma unroll
            for (int e = 0; e < 8; ++e) { q[8 * c + e] = f[e]; o[8 * c + e] = 0.f; } }
        float carry = 0.f;
        for (int j = qq * 512 + 511; j >= 0; --j) {
            const bf16* kr = base + (size_t)j * NPROJ + 2048; float z = 0.f;
#pragma unroll
            for (int c = 0; c < 8; ++c) { float f[8]; unpack8(*(const v4u*)(kr + 8 * c), f);
#pragma unroll
                for (int e = 0; e < 8; ++e) z += q[8 * c + e] * f[e]; }
            const bool act = j < t;
            const float sp = fmaxf(z, 0.f) + __logf(1.0f + __expf(-fabsf(z)));
            const float av = act ? __expf(z - sp + carry) : 0.f;
            carry -= act ? sp : 0.f;
            const bf16* vr = kr + 512;
#pragma unroll
            for (int c = 0; c < 8; ++c) { float f[8]; unpack8(*(const v4u*)(vr + 8 * c), f);
#pragma unroll
                for (int e = 0; e < 8; ++e) o[8 * c + e] += av * f[e]; }
        }
        bf16* orow = YMIX + (size_t)(b * SEQ + t) * D + 512 + h * HD;
#pragma unroll
        for (int c = 0; c < 8; ++c) { float f[8];
#pragma unroll
            for (int e = 0; e < 8; ++e) f[e] = o[8 * c + e];
            *(v4u*)(orow + 8 * c) = pack8(f); }
    }
}

namespace sba {
using bf16x8 = __attribute__((ext_vector_type(8))) short;
using s16x4 = __attribute__((ext_vector_type(4))) short;
using f32x16 = __attribute__((ext_vector_type(16))) float;
typedef short v4i16_t __attribute__((ext_vector_type(4)));
typedef float f32x2_t __attribute__((ext_vector_type(2))); typedef __bf16 bf16x2_t __attribute__((ext_vector_type(2)));
typedef __attribute__((address_space(3))) const char* lds_cptr;
constexpr int SLOTB = 8192, LDS_K = 0, LDS_V = 3 * SLOTB, LDS_FLG = 6 * SLOTB;
constexpr float CARRY_DEAD = 1e-30f;
__device__ __forceinline__ void glds16(const void* gsrc, unsigned lds_dst) { unsigned keep;
    asm volatile("s_mov_b32 %0, m0\n\ts_mov_b32 m0, %2\n\ts_nop 0\n\tglobal_load_lds_dwordx4 %1, off\n\ts_mov_b32 m0, %0" : "=&s"(keep) : "v"(gsrc), "s"(lds_dst) : "memory"); }
__device__ __forceinline__ unsigned cvtpk_s(float lo, float hi) { f32x2_t v = {lo, hi}; bf16x2_t b = __builtin_convertvector(v, bf16x2_t); return __builtin_bit_cast(unsigned, b); }
__device__ __forceinline__ s16x4 vtr(lds_cptr p) { return __builtin_bit_cast(s16x4, __builtin_amdgcn_ds_read_tr16_b64_v4i16((__attribute__((address_space(3))) v4i16_t*)p)); }
#define SBA_MFMA(a, b, c) __builtin_amdgcn_mfma_f32_32x32x16_bf16((a), (b), (c), 0, 0, 0)

#define SBA_WAIT_BAR() asm volatile("s_waitcnt vmcnt(0) lgkmcnt(0)\n\ts_barrier" ::: "memory")
#define SBA_SBAR() __builtin_amdgcn_sched_barrier(0)
struct Ctx { const unsigned short* ksrc; const unsigned short* vsrc; unsigned kdst, vdst; lds_cptr kp0, vp0; __attribute__((address_space(3))) unsigned* flg; int NT, qrel, hi, wid, lane; int s_cur, s_nxt, s_nn; };
__device__ __forceinline__ void band_mask(f32x16& p0, f32x16& p1, int jb, int qrel, int hi) {
    const int kb = 64 * jb + 4 * hi;
#pragma unroll
    for (int r = 0; r < 16; ++r) { const int kv = kb + (r & 3) + 8 * (r >> 2); if (kv >= qrel) p0[r] = -INFINITY; if (kv + 32 >= qrel) p1[r] = -INFINITY; }
}
__device__ __forceinline__ bool step(Ctx& c, int t, const f32x16& PC0, const f32x16& PC1, f32x16& PN0, f32x16& PN1, f32x16 (&o)[2], const bf16x8 (&qr)[4], float& carry) {
    SBA_WAIT_BAR();
    if (t < c.NT - 1) {
        const __attribute__((address_space(3))) v4u* f = (const __attribute__((address_space(3))) v4u*)(c.flg + ((t + 1) & 1) * 8); const v4u f0 = f[0], f1 = f[1];
        if (((f0.x | f0.y) | (f0.z | f0.w) | (f1.x | f1.y) | (f1.z | f1.w)) == 0u) return false;
    }
    if (t >= 2) { glds16(c.ksrc + (size_t)(t - 2) * 64 * NPROJ, (unsigned)__builtin_amdgcn_readfirstlane(c.kdst + c.s_nn)); glds16(c.vsrc + (size_t)(t - 2) * 64 * NPROJ, (unsigned)__builtin_amdgcn_readfirstlane(c.vdst + c.s_nn)); }
    bf16x8 kf[8]; s16x4 vlo[8], vhi[8];
    { const lds_cptr kp = c.kp0 + c.s_nxt;
#pragma unroll
      for (int d0 = 0; d0 < 4; ++d0) { kf[2 * d0] = *(const __attribute__((address_space(3))) bf16x8*)(kp + d0 * 2048); kf[2 * d0 + 1] = *(const __attribute__((address_space(3))) bf16x8*)(kp + d0 * 2048 + 512); }
      const lds_cptr vp = c.vp0 + c.s_cur;
#pragma unroll
      for (int i = 0; i < 8; ++i) { vlo[i] = vtr(vp + (i >> 2) * 4096 + (i & 3) * 1024); vhi[i] = vtr(vp + (i >> 2) * 4096 + (i & 3) * 1024 + 512); } }
    const f32x16 zero16 = f32x16{};
    float st = carry; unsigned pw[4][4];
#define VFR(i) ((bf16x8){vlo[i][0], vlo[i][1], vlo[i][2], vlo[i][3], vhi[i][0], vhi[i][1], vhi[i][2], vhi[i][3]})
#define PAF(ks) __builtin_bit_cast(bf16x8, (v4u){pw[ks][0], pw[ks][1], pw[ks][2], pw[ks][3]})
#pragma unroll
    for (int jj = 0; jj < 4; ++jj) {
        const int ks = 3 - jj, p = ks >> 1;
        SBA_SBAR();
        PN0 = SBA_MFMA(kf[2 * jj], qr[jj], jj ? PN0 : zero16); PN1 = SBA_MFMA(kf[2 * jj + 1], qr[jj], jj ? PN1 : zero16);
        if (jj >= 1) { o[0] = SBA_MFMA(PAF(ks + 1), VFR(ks + 1), o[0]); o[1] = SBA_MFMA(PAF(ks + 1), VFR(4 + ks + 1), o[1]); }
        float a8[8];
#pragma unroll
        for (int gi = 0; gi < 2; ++gi) {
            const int g = 2 * (ks & 1) + 1 - gi; float k4[4];
#pragma unroll
            for (int e = 0; e < 4; ++e) { const float z = p ? PC1[4 * g + e] : PC0[4 * g + e]; k4[e] = __builtin_amdgcn_rcpf(1.0f + __builtin_amdgcn_exp2f(z)); }
            const float r3 = k4[3], r2 = r3 * k4[2], r1 = r2 * k4[1], G = r1 * k4[0];
            const auto rr = __builtin_amdgcn_permlane32_swap(__float_as_uint(G), __float_as_uint(G), false, false);
            const float Glo = __uint_as_float(rr[0]), Ghi = __uint_as_float(rr[1]);
            const float base = st * (c.hi ? 1.0f : Ghi);
            a8[4 * (1 - gi) + 3] = base * (1.0f - r3); a8[4 * (1 - gi) + 2] = base * (r3 - r2); a8[4 * (1 - gi) + 1] = base * (r2 - r1); a8[4 * (1 - gi)] = base * (r1 - G);
            st = st * (Glo * Ghi);
        }
#pragma unroll
        for (int i = 0; i < 4; ++i) pw[ks][i] = cvtpk_s(a8[2 * i], a8[2 * i + 1]);
    }
    SBA_SBAR();
    o[0] = SBA_MFMA(PAF(0), VFR(0), o[0]); o[1] = SBA_MFMA(PAF(0), VFR(4), o[1]);
#undef VFR
#undef PAF
    carry = st;
    { const unsigned long long alive = __ballot(st > CARRY_DEAD); if (c.lane == 0) c.flg[(t & 1) * 8 + c.wid] = alive ? 1u : 0u; }
    if (t - 1 >= c.NT - 4) band_mask(PN0, PN1, t - 1 - (c.NT - 4), c.qrel, c.hi);
    { const int s = c.s_cur; c.s_cur = c.s_nxt; c.s_nxt = c.s_nn; c.s_nn = s; }
    return true;
}
__device__ __forceinline__ void unit(int b, int hd, int qb, const unsigned short* PROJ, unsigned short* YMIX, char* shm) {
    const int tid = threadIdx.x, lane = tid & 63, r32 = lane & 31, hi = lane >> 5; const int wid = __builtin_amdgcn_readfirstlane(tid >> 6);
    const size_t rowbase = (size_t)b * SEQ; const int q0 = qb * 256;
    const unsigned short* Qw = PROJ + (rowbase + q0 + wid * 32) * NPROJ + 1536 + hd * 64;
    const unsigned short* Kh = PROJ + rowbase * NPROJ + 2048 + hd * 64; const unsigned short* Vh = Kh + 512;
    const unsigned lds0 = (unsigned)(uintptr_t)shm;
    const lds_cptr shm3 = (lds_cptr)shm;
    Ctx c;
    c.ksrc = Kh + (size_t)lane * NPROJ + wid * 8;
    c.vsrc = Vh + (size_t)(16 * (wid & 3) + (lane >> 2)) * NPROJ + (wid >> 2) * 32 + (lane & 3) * 8;
    c.kdst = lds0 + LDS_K + wid * 1024; c.vdst = lds0 + LDS_V + wid * 1024;
    c.kp0 = shm3 + LDS_K + hi * 1024 + r32 * 16;
    c.vp0 = shm3 + LDS_V + ((lane >> 4) & 1) * 32 + (lane & 3) * 8 + (4 * hi + ((lane & 15) >> 2)) * 64;
    c.flg = (__attribute__((address_space(3))) unsigned*)(shm3 + LDS_FLG); c.wid = wid; c.lane = lane;
    c.NT = 4 * (qb + 1); c.qrel = wid * 32 + r32; c.hi = hi; c.s_cur = 0; c.s_nxt = SLOTB; c.s_nn = 2 * SLOTB;
    const int NT = c.NT;
    asm volatile("s_waitcnt lgkmcnt(0)\n\ts_barrier" ::: "memory");
    glds16(c.ksrc + (size_t)(NT - 1) * 64 * NPROJ, (unsigned)__builtin_amdgcn_readfirstlane(c.kdst)); glds16(c.vsrc + (size_t)(NT - 1) * 64 * NPROJ, (unsigned)__builtin_amdgcn_readfirstlane(c.vdst));
    glds16(c.ksrc + (size_t)(NT - 2) * 64 * NPROJ, (unsigned)__builtin_amdgcn_readfirstlane(c.kdst + SLOTB)); glds16(c.vsrc + (size_t)(NT - 2) * 64 * NPROJ, (unsigned)__builtin_amdgcn_readfirstlane(c.vdst + SLOTB));
    bf16x8 qr[4];
#pragma unroll
    for (int d0 = 0; d0 < 4; ++d0) qr[d0] = *reinterpret_cast<const bf16x8*>(&Qw[(size_t)r32 * NPROJ + d0 * 16 + hi * 8]);
    f32x16 o[2]; o[0] = f32x16{}; o[1] = f32x16{};
    float carry = 1.0f;
    SBA_WAIT_BAR();
    f32x16 pA0, pA1, pB0, pB1;
    { const f32x16 zero16 = f32x16{};
#pragma unroll
      for (int d0 = 0; d0 < 4; ++d0) {
          const bf16x8 b0 = *(const __attribute__((address_space(3))) bf16x8*)(c.kp0 + d0 * 2048);
          const bf16x8 b1 = *(const __attribute__((address_space(3))) bf16x8*)(c.kp0 + d0 * 2048 + 512);
          pA0 = SBA_MFMA(b0, qr[d0], d0 ? pA0 : zero16); pA1 = SBA_MFMA(b1, qr[d0], d0 ? pA1 : zero16);
      }
      band_mask(pA0, pA1, 3, c.qrel, hi); }
    for (int t = NT - 1; t > 0; t -= 2) {
        if (!step(c, t, pA0, pA1, pB0, pB1, o, qr, carry)) break;
        if (!step(c, t - 1, pB0, pB1, pA0, pA1, o, qr, carry)) break;
    }
    unsigned short* Ow = YMIX + (rowbase + q0 + wid * 32) * D + 512 + hd * 64;
#pragma unroll
    for (int r = 0; r < 16; ++r) { const int orow = (r & 3) + 8 * (r >> 2) + 4 * hi;
#pragma unroll
        for (int d0 = 0; d0 < 2; ++d0) Ow[(size_t)orow * D + d0 * 32 + r32] = (unsigned short)(cvtpk_s(o[d0][r], 0.f) & 0xffffu); }
}
__device__ __forceinline__ void phase(const unsigned short* PROJ, unsigned short* YMIX, char* shm) {
    const int G = gridDim.x, bx = blockIdx.x; const int vcu = (G % 8 == 0) ? (bx % 8) * (G / 8) + bx / 8 : bx;
    for (int v = vcu; v < 256; v += G) { const int bh = v >> 3, s = v & 7;
#pragma unroll 1
        for (int i = 0; i < 4; ++i) { const int qb = (i == 0) ? 31 - s : (i == 1) ? 16 + s : (i == 2) ? 15 - s : s; unit(bh >> 3, bh & 7, qb, PROJ, YMIX, shm); } }
}
}

__global__ void __launch_bounds__(NWAVES * 64, 2) mk_fwd(Args args) {
    extern __shared__ __attribute__((aligned(16))) unsigned char lds_raw[];
    LAS unsigned char* lds = (LAS unsigned char*)lds_raw;
    const int tid = threadIdx.x, lane = tid & 63, wave = __builtin_amdgcn_readfirstlane(tid >> 6);
    const int G = gridDim.x, gw = blockIdx.x * NWAVES + wave, NGW = G * NWAVES;
    unsigned char* ws = args.ws;
    float* ss1 = (float*)(ws + WS_CTL); float* ss2 = ss1 + M; float* ss3 = ss2 + M; float* ss4 = ss3 + M;
    bf16* XB = (bf16*)(ws + WS_XB); bf16* PB = (bf16*)(ws + WS_PB); bf16* HID = (bf16*)(ws + WS_HID); bf16* PROJ = HID; bf16* YMIX = (bf16*)(ws + WS_YMIX); bf16* PP = (bf16*)(ws + WS_PP);
    const int lo = args.ph_lo, hi = args.ph_hi;
    volatile LAS unsigned* MISC = (volatile LAS unsigned*)(lds + 131072);
    if (tid < 32) MISC[tid] = 0u;
    __syncthreads();
    XcdBarrier bar; bar.bar = (unsigned*)(ws + WS_BAR); bar.x = 0; bar.st = nullptr;
    if (hi - lo > 1) bar = xcd_barrier_post((unsigned*)(ws + WS_BAR), MISC + 8);
#define IN(k) (lo <= (k) && (k) < hi)
#define SEAM(k) do { if (IN(k) && IN((k) + 1)) { if ((k) == 0) cg::this_grid().sync(); else xcd_barrier(bar); } } while (0)
    typedef pg8::StaticOrder SO;
    if (IN(0)) { p0_prep(args, lds, gw, NGW, lane, wave); } SEAM(0);
    if (IN(1)) {
        { pg8::Gemm g{XB, (const bf16*)(ws + WS_W1GU), M, 2 * FF, D}; SO S; S.init(M, 2 * FF, G, (int)blockIdx.x); pg8::EpiSwiGLU E{HID, FF, ss1};
          pg8::gemm_phase<pg8::EpiSwiGLU, SO, true, true>(lds, g, S, E); }
        { pg8::Gemm g{PB, (const bf16*)(ws + WS_WPP), M, D, PLE}; SO S; S.init(M, D, G, (int)blockIdx.x); pg8::EpiScaleBf16 E{PP, D, nullptr};
          pg8::gemm_phase<pg8::EpiScaleBf16, SO, true, true>(lds, g, S, E); }
    } SEAM(1);
    if (IN(2)) { pg8::Gemm g{HID, (const bf16*)(ws + WS_W1D), M, D, FF}; SO S; S.init(M, D, G, (int)blockIdx.x); pg8::EpiResid<true> E{args.in[0], XB, ss2, 0.5f};
        pg8::gemm_phase<pg8::EpiResid<true>, SO, true, true>(lds, g, S, E); } SEAM(2);
    if (IN(3)) { pg8::Gemm g{XB, (const bf16*)(ws + WS_WIN), M, NPROJ, D}; SO S; S.init(M, NPROJ, G, (int)blockIdx.x); pg8::EpiScaleBf16 E{PROJ, NPROJ, ss2};
        pg8::gemm_phase<pg8::EpiScaleBf16, SO, true, true>(lds, g, S, E); } SEAM(3);
    if (IN(4)) { p4_mixprep(args, gw, NGW, lane); } SEAM(4);
    if (IN(5)) { if (ATTN_NAIVE) p5_attn_naive(args, tid); else sba::phase(PROJ, YMIX, (char*)lds_raw); } SEAM(5);
    if (IN(6)) { pg8::Gemm g{YMIX, (const bf16*)(ws + WS_WOUT), M, D, D}; SO S; S.init(M, D, G, (int)blockIdx.x); pg8::EpiResid<false> E{nullptr, XB, ss3, 1.0f};
        pg8::gemm_phase<pg8::EpiResid<false>, SO, true, true>(lds, g, S, E); } SEAM(6);
    if (IN(7)) { pg8::Gemm g{XB, (const bf16*)(ws + WS_W2GU), M, 2 * FF, D}; SO S; S.init(M, 2 * FF, G, (int)blockIdx.x); pg8::EpiSwiGLU E{HID, FF, ss3};
        pg8::gemm_phase<pg8::EpiSwiGLU, SO, true, true>(lds, g, S, E); } SEAM(7);
    if (IN(8)) { pg8::Gemm g{HID, (const bf16*)(ws + WS_W2D), M, D, FF}; SO S; S.init(M, D, G, (int)blockIdx.x); pg8::EpiResid<false> E{nullptr, XB, ss4, 0.5f};
        pg8::gemm_phase<pg8::EpiResid<false>, SO, true, true>(lds, g, S, E); } SEAM(8);
    if (IN(9)) { pg8::Gemm g{XB, (const bf16*)(ws + WS_WPG), M, D, D}; SO S; S.init(M, D, G, (int)blockIdx.x); pg8::EpiPle E{XB, args.out, PP, ss4};
        pg8::gemm_phase<pg8::EpiPle, SO, true, true>(lds, g, S, E); }
#undef IN
#undef SEAM
}

extern "C" void kernel_launch(void* const* d_in, const int* in_sizes, int n_in, void* d_out, int out_size, void* d_ws, size_t ws_size, hipStream_t stream) {
    static int grid = 0;
    if (grid == 0) {
        if (n_in != 20 || out_size != M * D || ws_size < WS_END) { fprintf(stderr, "kernel_launch: unexpected shapes (n_in %d out %d ws %zu)\n", n_in, out_size, ws_size); grid = -1; return; }
        int dev = 0, cus = 0, per_cu = 0;
        if (hipGetDevice(&dev) != hipSuccess || hipDeviceGetAttribute(&cus, hipDeviceAttributeMultiprocessorCount, dev) != hipSuccess) { grid = -1; return; }
        if (hipFuncSetAttribute((const void*)mk_fwd, hipFuncAttributeMaxDynamicSharedMemorySize, LDS_BYTES) != hipSuccess) { fprintf(stderr, "kernel_launch: hipFuncSetAttribute failed\n"); grid = -1; return; }
        if (hipOccupancyMaxActiveBlocksPerMultiprocessor(&per_cu, (const void*)mk_fwd, NWAVES * 64, LDS_BYTES) != hipSuccess || per_cu < 1) { fprintf(stderr, "kernel_launch: occupancy query says %d\n", per_cu); per_cu = 1; }
        (void)hipGetLastError();
        grid = cus;
    }
    if (grid < 0) return;
    (void)hipMemsetAsync((char*)d_ws + WS_CTL, 0, CTL_ZERO_BYTES, stream);
    Args a{};
    for (int i = 0; i < 20; ++i) a.in[i] = (const float*)d_in[i];
    a.out = (float*)d_out; a.ws = (unsigned char*)d_ws;
#if MK_ONE_LAUNCH
    a.ph_lo = 0; a.ph_hi = N_PHASES;
    void* kargs[] = {&a};
    hipError_t e = hipLaunchCooperativeKernel((const void*)mk_fwd, dim3(grid), dim3(NWAVES * 64), kargs, LDS_BYTES, stream);
    if (e != hipSuccess) fprintf(stderr, "kernel_launch: cooperative launch failed: %s\n", hipGetErrorString(e));
#else
    for (int ph = 0; ph < N_PHASES; ++ph) for (int rep = 0; rep < 1 + ((PROBE_DUP >> ph) & 1); ++rep) { a.ph_lo = ph; a.ph_hi = ph + 1; hipLaunchKernelGGL(mk_fwd, dim3(grid), dim3(NWAVES * 64), LDS_BYTES, stream, a); }
#endif
}
```

```cpp
#include <hip/hip_runtime.h>
#include <hip/hip_cooperative_groups.h>
#include <cstdio>
#include <cstdint>
namespace cg = cooperative_groups;
namespace pg8 {
#define PG8_LAS __attribute__((address_space(3)))
typedef unsigned short bf16_t;
typedef short bf16x8 __attribute__((ext_vector_type(8)));
typedef float f32x4 __attribute__((ext_vector_type(4)));
typedef unsigned u32x4 __attribute__((ext_vector_type(4)));
constexpr int BM = 256, BK = 64, HALF = 128, HTB = HALF * BK * 2  , STAGE_BYTES = 8 * HTB, NXCD = 8, WGM = 8;

__host__ __device__ __forceinline__ int lds_byte(int r, int c) { const int st = (r >> 4) * 2 + (c >> 5), rr = r & 15, cc = c & 31, ob = rr * 64 + cc * 2; return st * 1024 + (ob ^ (((ob >> 9) & 1) << 5)); }
__host__ __device__ __forceinline__ void stage_rc(int b, int& R, int& C) { const int st = b / 1024, sb = b % 1024, swz = sb ^ (((sb >> 9) & 1) << 5); R = (st >> 1) * 16 + swz / 64; C = (st & 1) * 32 + (swz % 64) / 2; }
__host__ __device__ __forceinline__ int perm32(int rho) { const int n = rho >> 4, i = rho & 15; return 8 * (i >> 2) + 4 * n + (i & 3); }

struct Unit { int pm, pn; };
struct Gemm { const bf16_t* A; const bf16_t* Bt; int M, N, K; };

struct StaticOrder {
    int nM, nN, nwg, G, c;
    __host__ __device__ void init(int M, int N, int G_, int c_) { nM = M / BM; nN = N / BM; nwg = nM * nN; G = G_; c = c_; }
    __host__ __device__ bool next(int i, Unit& u) const {
        const long L = (long)i * G + c; if (L >= nwg) return false;
        int wgid = (int)L; { const int q = nwg / NXCD, r = nwg % NXCD, xcd = wgid % NXCD, off = wgid / NXCD; wgid = (xcd < r ? xcd * (q + 1) : r * (q + 1) + (xcd - r) * q) + off; }
        const int nig = WGM * nN, gid = wgid / nig, fm = gid * WGM, gsz = (nM - fm) < WGM ? (nM - fm) : WGM;
        u.pm = fm + ((wgid % nig) % gsz); u.pn = (wgid % nig) / gsz; return true;
    }
    __device__ __forceinline__ void a_ready(const Unit&) const {}
    __device__ __forceinline__ void done(const Unit&) const {}
};

__device__ __forceinline__ unsigned cvt_pk_bf16(float lo, float hi) { unsigned r; asm volatile("v_cvt_pk_bf16_f32 %0, %1, %2" : "=v"(r) : "v"(lo), "v"(hi)); return r; }
typedef float f32x2 __attribute__((ext_vector_type(2)));
__device__ __forceinline__ float rs_of(float ss) { return rsqrtf(ss * (1.0f / 1024.0f) + 1e-6f); }
struct EpiSwiGLU {
    static constexpr bool PERM = true, AFTER_DRAIN = false;
    bf16_t* H; int ldh; const float* ss;
    __device__ __forceinline__ void operator()(const f32x4 (&acc)[2][2][4][2], const Unit& u, int wr, int wc, int fr, int fq) const {
        const int row0 = u.pm * BM + wr * 64 + fr, col0 = u.pn * HALF + wc * 32 + 8 * fq;
#pragma unroll
        for (int ai = 0; ai < 2; ++ai)
#pragma unroll
            for (int m = 0; m < 4; ++m) {
                const int row = row0 + ai * HALF + m * 16; const float rs = rs_of(ss[row]);
                unsigned ww[4];
#pragma unroll
                for (int n = 0; n < 2; ++n) { const f32x4 g = acc[ai][0][m][n] * rs, up = acc[ai][1][m][n] * rs; f32x4 hh;
#pragma unroll
                    for (int e = 0; e < 4; ++e) hh[e] = g[e] * __builtin_amdgcn_rcpf(1.0f + __builtin_amdgcn_exp2f(-1.4426950408889634f * g[e])) * up[e];
                    ww[2 * n] = cvt_pk_bf16(hh[0], hh[1]); ww[2 * n + 1] = cvt_pk_bf16(hh[2], hh[3]); }
                __builtin_nontemporal_store((u32x4){ww[0], ww[1], ww[2], ww[3]}, (u32x4*)(H + (size_t)row * ldh + col0));
            }
    }
};
template <bool XF32> struct EpiResid {
    static constexpr bool PERM = true, AFTER_DRAIN = false;
    const float* xold; bf16_t* xb; float* ssq; float alpha;
    __device__ __forceinline__ void operator()(const f32x4 (&acc)[2][2][4][2], const Unit& u, int wr, int wc, int fr, int fq) const {
        const int row0 = u.pm * BM + wr * 64 + fr, colb = u.pn * BM + wc * 64 + 8 * fq;
#pragma unroll
        for (int ai = 0; ai < 2; ++ai)
#pragma unroll
            for (int m = 0; m < 4; ++m) {
                const int row = row0 + ai * HALF + m * 16; float s = 0.f;
#pragma unroll
                for (int bj = 0; bj < 2; ++bj) { const size_t off = (size_t)row * 1024 + colb + bj * 32;
                    f32x4 o0, o1;
                    if (XF32) { o0 = *(const f32x4*)(xold + off); o1 = *(const f32x4*)(xold + off + 4); }
                    else { const u32x4 pw = *(const u32x4*)(xb + off);
                        o0[0] = __uint_as_float(pw[0] << 16); o0[1] = __uint_as_float(pw[0] & 0xffff0000u); o0[2] = __uint_as_float(pw[1] << 16); o0[3] = __uint_as_float(pw[1] & 0xffff0000u);
                        o1[0] = __uint_as_float(pw[2] << 16); o1[1] = __uint_as_float(pw[2] & 0xffff0000u); o1[2] = __uint_as_float(pw[3] << 16); o1[3] = __uint_as_float(pw[3] & 0xffff0000u); }
                    const f32x4 v0 = o0 + acc[ai][bj][m][0] * alpha, v1 = o1 + acc[ai][bj][m][1] * alpha;
                    *(u32x4*)(xb + off) = (u32x4){cvt_pk_bf16(v0[0], v0[1]), cvt_pk_bf16(v0[2], v0[3]), cvt_pk_bf16(v1[0], v1[1]), cvt_pk_bf16(v1[2], v1[3])};
                    s += (v0[0] * v0[0] + v0[1] * v0[1]) + (v0[2] * v0[2] + v0[3] * v0[3]) + (v1[0] * v1[0] + v1[1] * v1[1]) + (v1[2] * v1[2] + v1[3] * v1[3]); }
                s += __shfl_xor(s, 16); s += __shfl_xor(s, 32);
                if (fq == 0) __hip_atomic_fetch_add(ssq + row, s, __ATOMIC_RELAXED, __HIP_MEMORY_SCOPE_AGENT);
            }
    }
};
struct EpiScaleBf16 {
    static constexpr bool PERM = true, AFTER_DRAIN = false;
    bf16_t* O; int ldc; const float* ss;
    __device__ __forceinline__ void operator()(const f32x4 (&acc)[2][2][4][2], const Unit& u, int wr, int wc, int fr, int fq) const {
        const int row0 = u.pm * BM + wr * 64 + fr, colb = u.pn * BM + wc * 64 + 8 * fq;
#pragma unroll
        for (int ai = 0; ai < 2; ++ai)
#pragma unroll
            for (int m = 0; m < 4; ++m) {
                const int row = row0 + ai * HALF + m * 16; const float rs = ss ? rs_of(ss[row]) : 1.0f;
#pragma unroll
                for (int bj = 0; bj < 2; ++bj) { const f32x4 v0 = acc[ai][bj][m][0] * rs, v1 = acc[ai][bj][m][1] * rs;
                    __builtin_nontemporal_store((u32x4){cvt_pk_bf16(v0[0], v0[1]), cvt_pk_bf16(v0[2], v0[3]), cvt_pk_bf16(v1[0], v1[1]), cvt_pk_bf16(v1[2], v1[3])}, (u32x4*)(O + (size_t)row * ldc + colb + bj * 32)); }
            }
    }
};
struct EpiProj {
    static constexpr bool PERM = true, AFTER_DRAIN = false;
    bf16_t* O; const float* ss; const float* gq; const float* gk; float qsc;
    __device__ __forceinline__ void operator()(const f32x4 (&acc)[2][2][4][2], const Unit& u, int wr, int wc, int fr, int fq) const {
        const int row0 = u.pm * BM + wr * 64 + fr, colb = u.pn * BM + wc * 64 + 8 * fq;
        const int sec = u.pn >> 1; const bool qk = (sec == 3) || (sec == 4);
        f32x4 g[2][2];
        if (qk) { const float* gp = sec == 3 ? gq : gk; const float sc = sec == 3 ? qsc : 1.0f;
#pragma unroll
            for (int bj = 0; bj < 2; ++bj)
#pragma unroll
                for (int n = 0; n < 2; ++n) g[bj][n] = *(const f32x4*)(gp + 32 * bj + 8 * fq + 4 * n) * sc; }
#pragma unroll
        for (int ai = 0; ai < 2; ++ai)
#pragma unroll
            for (int m = 0; m < 4; ++m) {
                const int row = row0 + ai * HALF + m * 16; const float rs = rs_of(ss[row]);
                f32x4 v[2][2];
#pragma unroll
                for (int bj = 0; bj < 2; ++bj)
#pragma unroll
                    for (int n = 0; n < 2; ++n) v[bj][n] = acc[ai][bj][m][n] * rs;
                if (qk) { float s = 0.f;
#pragma unroll
                    for (int bj = 0; bj < 2; ++bj)
#pragma unroll
                        for (int n = 0; n < 2; ++n) s += (v[bj][n][0] * v[bj][n][0] + v[bj][n][1] * v[bj][n][1]) + (v[bj][n][2] * v[bj][n][2] + v[bj][n][3] * v[bj][n][3]);
                    s += __shfl_xor(s, 16); s += __shfl_xor(s, 32);
                    const float r = rsqrtf(s * (1.0f / 64.0f) + 1e-6f);
#pragma unroll
                    for (int bj = 0; bj < 2; ++bj)
#pragma unroll
                        for (int n = 0; n < 2; ++n) v[bj][n] = v[bj][n] * g[bj][n] * r; }
#pragma unroll
                for (int bj = 0; bj < 2; ++bj)
                    __builtin_nontemporal_store((u32x4){cvt_pk_bf16(v[bj][0][0], v[bj][0][1]), cvt_pk_bf16(v[bj][0][2], v[bj][0][3]), cvt_pk_bf16(v[bj][1][0], v[bj][1][1]), cvt_pk_bf16(v[bj][1][2], v[bj][1][3])},
                                                (u32x4*)(O + (size_t)row * 3072 + colb + bj * 32));
            }
    }
};
struct EpiPle {
    static constexpr bool PERM = true, AFTER_DRAIN = false;
    const bf16_t* xold; float* out; const bf16_t* PP; const float* ss;
    __device__ __forceinline__ void operator()(const f32x4 (&acc)[2][2][4][2], const Unit& u, int wr, int wc, int fr, int fq) const {
        const int row0 = u.pm * BM + wr * 64 + fr, colb = u.pn * BM + wc * 64 + 8 * fq;
#pragma unroll
        for (int ai = 0; ai < 2; ++ai)
#pragma unroll
            for (int m = 0; m < 4; ++m) {
                const int row = row0 + ai * HALF + m * 16; const float rs = rs_of(ss[row]) * -1.4426950408889634f;
#pragma unroll
                for (int bj = 0; bj < 2; ++bj) { const size_t off = (size_t)row * 1024 + colb + bj * 32;
                    const u32x4 xw = *(const u32x4*)(xold + off); const u32x4 pw = *(const u32x4*)(PP + off); f32x4 o0, o1;
                    o0[0] = __uint_as_float(xw[0] << 16); o0[1] = __uint_as_float(xw[0] & 0xffff0000u); o0[2] = __uint_as_float(xw[1] << 16); o0[3] = __uint_as_float(xw[1] & 0xffff0000u);
                    o1[0] = __uint_as_float(xw[2] << 16); o1[1] = __uint_as_float(xw[2] & 0xffff0000u); o1[2] = __uint_as_float(xw[3] << 16); o1[3] = __uint_as_float(xw[3] & 0xffff0000u);
                    f32x4 p0, p1; p0[0] = __uint_as_float(pw[0] << 16); p0[1] = __uint_as_float(pw[0] & 0xffff0000u); p0[2] = __uint_as_float(pw[1] << 16); p0[3] = __uint_as_float(pw[1] & 0xffff0000u);
                    p1[0] = __uint_as_float(pw[2] << 16); p1[1] = __uint_as_float(pw[2] & 0xffff0000u); p1[2] = __uint_as_float(pw[3] << 16); p1[3] = __uint_as_float(pw[3] & 0xffff0000u);
                    f32x4 v0, v1;
#pragma unroll
                    for (int e = 0; e < 4; ++e) { v0[e] = o0[e] + __builtin_amdgcn_rcpf(1.0f + __builtin_amdgcn_exp2f(acc[ai][bj][m][0][e] * rs)) * p0[e];
                                                  v1[e] = o1[e] + __builtin_amdgcn_rcpf(1.0f + __builtin_amdgcn_exp2f(acc[ai][bj][m][1][e] * rs)) * p1[e]; }
                    *(f32x4*)(out + off) = v0; *(f32x4*)(out + off + 4) = v1; }
            }
    }
};
template <class Epi, class Sched, bool ALIGN_EPI = false, bool SP2 = false>
__device__ __forceinline__ void gemm_phase(PG8_LAS unsigned char* lds, const Gemm g, const Sched& S, const Epi& E) {
    const int tid = threadIdx.x, wid = __builtin_amdgcn_readfirstlane(tid >> 6), lane = tid & 63, wr = wid >> 2, wc = wid & 3, fr = lane & 15, fq = lane >> 4;
    const int K = g.K, nt = K / BK;
    unsigned voffA[2], voffB[2];
#pragma unroll
    for (int i = 0; i < 2; ++i) { int R, C; stage_rc(tid * 16 + i * 8192, R, C); const int Rb = Epi::PERM ? ((R & ~31) + perm32(R & 31)) : R;
        voffA[i] = (unsigned)(R * K + C) * 2u; voffB[i] = (unsigned)(Rb * K + C) * 2u; }
    const size_t kstep = (size_t)(BK * 2);
    const size_t hstep = (size_t)HALF * K * 2;
    const size_t tstep = 2 * hstep;
    const unsigned ldsw = (unsigned)wid * 1024u;
    const int aoff = lds_byte(wr * 64 + fr, fq * 8), boff = lds_byte(wc * 32 + fr, fq * 8);
#define PG8_SA(b, h) (((b) * 2 + (h)) * HTB)
#define PG8_SB(b, h) ((4 + (b) * 2 + (h)) * HTB)
#define PG8_STAGE(bufoff, gbase, voff) do { _Pragma("unroll") for (int _i = 0; _i < 2; ++_i) \
        __builtin_amdgcn_global_load_lds((const unsigned*)((const char*)(gbase) + (voff)[_i]), (PG8_LAS unsigned*)(lds + (bufoff) + ldsw + _i * 8192), 16, 0, 0); } while (0)
#define PG8_LDA(dst, b, h) do { _Pragma("unroll") for (int m = 0; m < 4; ++m) _Pragma("unroll") for (int k = 0; k < 2; ++k) dst[m][k] = *(const PG8_LAS bf16x8*)(lds + PG8_SA(b, h) + aoff + m * 2048 + k * 1024); } while (0)
#define PG8_LDB(dst, b, h) do { _Pragma("unroll") for (int n = 0; n < 2; ++n) _Pragma("unroll") for (int k = 0; k < 2; ++k) dst[n][k] = *(const PG8_LAS bf16x8*)(lds + PG8_SB(b, h) + boff + n * 2048 + k * 1024); } while (0)
#define PG8_MMA(ai, bj, At, Bt) do { __builtin_amdgcn_s_setprio(1); _Pragma("unroll") for (int m = 0; m < 4; ++m) _Pragma("unroll") for (int n = 0; n < 2; ++n) _Pragma("unroll") for (int k = 0; k < 2; ++k) \
        acc[ai][bj][m][n] = __builtin_amdgcn_mfma_f32_16x16x32_bf16(Bt[n][k], At[m][k], acc[ai][bj][m][n], 0, 0, 0); __builtin_amdgcn_s_setprio(0); } while (0)
#define PG8_WAIT_V(n) asm volatile("s_waitcnt vmcnt(" #n ")" ::: "memory")
#define PG8_WAIT_L(n) asm volatile("s_waitcnt lgkmcnt(" #n ")" ::: "memory")
#define PG8_BAR __builtin_amdgcn_s_barrier()
#define PG8_SCHED __builtin_amdgcn_sched_barrier(0)
    Unit cur, nxt; int ui = 0;
    if (!S.next(0, cur)) return;
    f32x4 acc[2][2][4][2];
#pragma unroll
    for (int a = 0; a < 2; ++a)
#pragma unroll
        for (int b = 0; b < 2; ++b)
#pragma unroll
            for (int m = 0; m < 4; ++m)
#pragma unroll
                for (int n = 0; n < 2; ++n) acc[a][b][m][n] = (f32x4){0.f, 0.f, 0.f, 0.f};
    bf16x8 At[4][2], B0[2][2], B1[2][2];
    const char* cA = (const char*)g.A + (size_t)cur.pm * tstep; const char* cB = (const char*)g.Bt + (size_t)cur.pn * tstep;
    S.a_ready(cur);
    if constexpr (SP2) {
        PG8_STAGE(PG8_SB(0, 0), cB, voffB); PG8_STAGE(PG8_SB(0, 1), cB + hstep, voffB); PG8_STAGE(PG8_SA(0, 0), cA, voffA); PG8_STAGE(PG8_SA(0, 1), cA + hstep, voffA);
        if (wr == 1) PG8_BAR;
        PG8_WAIT_V(2); PG8_BAR;
        PG8_STAGE(PG8_SB(1, 0), cB + kstep, voffB); PG8_STAGE(PG8_SA(1, 0), cA + kstep, voffA); PG8_STAGE(PG8_SB(1, 1), cB + hstep + kstep, voffB);
        PG8_WAIT_V(6); PG8_BAR;
    } else {
        PG8_STAGE(PG8_SB(0, 0), cB, voffB); PG8_STAGE(PG8_SA(0, 0), cA, voffA); PG8_STAGE(PG8_SB(0, 1), cB + hstep, voffB); PG8_STAGE(PG8_SA(0, 1), cA + hstep, voffA);
        if (wr == 1) PG8_BAR;
        PG8_WAIT_V(4); PG8_BAR;
        PG8_STAGE(PG8_SB(1, 0), cB + kstep, voffB); PG8_STAGE(PG8_SA(1, 0), cA + kstep, voffA); PG8_STAGE(PG8_SB(1, 1), cB + hstep + kstep, voffB);
        PG8_WAIT_V(6); PG8_BAR;
    }
    for (;;) {
        const bool has_next = S.next(ui + 1, nxt);
        const char* nA = has_next ? (const char*)g.A + (size_t)nxt.pm * tstep : cA; const char* nB = has_next ? (const char*)g.Bt + (size_t)nxt.pn * tstep : cB;
        for (int t = 0; t < nt; t += 2) {
            const bool last = (t == nt - 2);
            const char* a1 = cA + (size_t)(t + 1) * kstep;
            const char* a2 = last ? nA : cA + (size_t)(t + 2) * kstep; const char* b2 = last ? nB : cB + (size_t)(t + 2) * kstep;
            const char* a3 = a2 + kstep; const char* b3 = b2 + kstep;
            if (last && has_next) S.a_ready(nxt);
            if constexpr (SP2) {
            PG8_LDB(B0, 0, 0); PG8_LDB(B1, 0, 1); PG8_SCHED; PG8_LDA(At, 0, 0); PG8_STAGE(PG8_SA(1, 1), a1 + hstep, voffA);
            PG8_WAIT_V(8); PG8_WAIT_L(0); PG8_BAR; PG8_MMA(0, 0, At, B0); PG8_MMA(0, 1, At, B1); PG8_BAR; PG8_SCHED;
            PG8_LDA(At, 0, 1); PG8_STAGE(PG8_SB(0, 0), b2, voffB); PG8_STAGE(PG8_SB(0, 1), b2 + hstep, voffB); PG8_STAGE(PG8_SA(0, 0), a2, voffA);
            PG8_WAIT_V(8); PG8_WAIT_L(0); PG8_BAR; PG8_MMA(1, 0, At, B0); PG8_MMA(1, 1, At, B1); PG8_BAR; PG8_SCHED;
            PG8_LDB(B0, 1, 0); PG8_LDB(B1, 1, 1); PG8_SCHED; PG8_LDA(At, 1, 0); PG8_STAGE(PG8_SA(0, 1), a2 + hstep, voffA);
            PG8_WAIT_V(8); PG8_WAIT_L(0); PG8_BAR; PG8_MMA(0, 0, At, B0); PG8_MMA(0, 1, At, B1); PG8_BAR; PG8_SCHED;
            PG8_LDA(At, 1, 1); PG8_STAGE(PG8_SB(1, 0), b3, voffB); PG8_STAGE(PG8_SB(1, 1), b3 + hstep, voffB); PG8_STAGE(PG8_SA(1, 0), a3, voffA);
            PG8_WAIT_V(8); PG8_WAIT_L(0); PG8_BAR; PG8_MMA(1, 0, At, B0); PG8_MMA(1, 1, At, B1); PG8_BAR; PG8_SCHED;
            } else {
            PG8_LDB(B0, 0, 0); PG8_SCHED; PG8_LDA(At, 0, 0); PG8_STAGE(PG8_SA(1, 1), a1 + hstep, voffA);
            PG8_WAIT_L(8); PG8_BAR; PG8_WAIT_L(0); PG8_MMA(0, 0, At, B0); PG8_BAR; PG8_SCHED;
            PG8_LDB(B1, 0, 1); PG8_STAGE(PG8_SB(0, 0), b2, voffB);
            PG8_BAR; PG8_WAIT_L(0); PG8_MMA(0, 1, At, B1); PG8_BAR;
            PG8_LDA(At, 0, 1); PG8_STAGE(PG8_SA(0, 0), a2, voffA);
            PG8_BAR; PG8_WAIT_L(0); PG8_MMA(1, 0, At, B0); PG8_BAR; PG8_SCHED;
            PG8_STAGE(PG8_SB(0, 1), b2 + hstep, voffB);
            PG8_WAIT_V(6); PG8_BAR; PG8_MMA(1, 1, At, B1); PG8_BAR;
            PG8_LDB(B0, 1, 0); PG8_SCHED; PG8_LDA(At, 1, 0); PG8_STAGE(PG8_SA(0, 1), a2 + hstep, voffA);
            PG8_WAIT_L(8); PG8_BAR; PG8_WAIT_L(0); PG8_MMA(0, 0, At, B0); PG8_BAR; PG8_SCHED;
            PG8_LDB(B1, 1, 1); PG8_STAGE(PG8_SB(1, 0), b3, voffB);
            PG8_BAR; PG8_WAIT_L(0); PG8_MMA(0, 1, At, B1); PG8_BAR;
            PG8_LDA(At, 1, 1); PG8_STAGE(PG8_SA(1, 0), a3, voffA);
            PG8_BAR; PG8_WAIT_L(0); PG8_MMA(1, 0, At, B0); PG8_BAR; PG8_SCHED;
            PG8_STAGE(PG8_SB(1, 1), b3 + hstep, voffB);
            PG8_WAIT_V(6); PG8_BAR; PG8_MMA(1, 1, At, B1); PG8_BAR;
            }
        }
        if constexpr (ALIGN_EPI) { if (wr == 0) PG8_BAR; }
        if constexpr (!Epi::AFTER_DRAIN) { E(acc, cur, wr, wc, fr, fq); S.done(cur); }
        if (!has_next) break;
#pragma unroll
        for (int a = 0; a < 2; ++a)
#pragma unroll
            for (int b = 0; b < 2; ++b)
#pragma unroll
                for (int m = 0; m < 4; ++m)
#pragma unroll
                    for (int n = 0; n < 2; ++n) acc[a][b][m][n] = (f32x4){0.f, 0.f, 0.f, 0.f};
        cur = nxt; cA = nA; cB = nB; ++ui;
        if constexpr (ALIGN_EPI) { if (wr == 1) PG8_BAR; }
    }
    PG8_WAIT_V(0);
    if constexpr (!ALIGN_EPI) { if (wr == 0) PG8_BAR; }
    PG8_BAR;
    if constexpr (Epi::AFTER_DRAIN) { E.fused(acc, cur, wr, wc, fr, fq, lds, wid, lane); S.done(cur); }
#undef PG8_SA
#undef PG8_SB
#undef PG8_STAGE
#undef PG8_LDA
#undef PG8_LDB
#undef PG8_MMA
#undef PG8_WAIT_V
#undef PG8_WAIT_L
#undef PG8_BAR
#undef PG8_SCHED
}
}

constexpr int NWAVES = 8;
constexpr int BATCH = 4, SEQ = 8192, D = 1024, FF = 2816, NPROJ = 3072, PLE = 256, NH = 8, HD = 64, CONVD = 512;
constexpr int M = BATCH * SEQ;
#ifndef PROBE_DUP
#define PROBE_DUP 0
#endif
#ifndef MK_ONE_LAUNCH
#define MK_ONE_LAUNCH 1
#endif
constexpr int N_PHASES = 10;
constexpr size_t MiB = 1u << 20;
constexpr size_t WS_CTL = 0, CTL_ZERO_BYTES = 1 * MiB;
constexpr size_t WS_W1GU = 2 * MiB, WS_W1D = 13 * MiB, WS_WIN = 19 * MiB, WS_WOUT = 25 * MiB, WS_W2GU = 27 * MiB, WS_W2D = 38 * MiB, WS_WPG = 44 * MiB, WS_WPP = 46 * MiB;
constexpr size_t WS_XB = 48 * MiB;
constexpr size_t WS_PB = 112 * MiB;
constexpr size_t WS_HID = 128 * MiB;
constexpr size_t WS_YMIX = 320 * MiB;
constexpr size_t WS_PP = 384 * MiB;
constexpr size_t WS_END = 448 * MiB;
#ifndef ATTN_NAIVE
#define ATTN_NAIVE 0
#endif
constexpr float QSC = ATTN_NAIVE ? 0.125f : 0.125f * 1.4426950408889634f;
constexpr int LDS_BYTES = 147456;

#define GAS __attribute__((address_space(1)))
#define LAS __attribute__((address_space(3)))
typedef unsigned short bf16;
typedef unsigned v4u __attribute__((ext_vector_type(4)));
typedef float f32x4 __attribute__((ext_vector_type(4)));
#define LDS_WAIT() asm volatile("s_waitcnt lgkmcnt(0)" ::: "memory")
__device__ __forceinline__ unsigned pk2(float lo, float hi) { return pg8::cvt_pk_bf16(lo, hi); }
__device__ __forceinline__ float bflo(unsigned w) { return __uint_as_float(w << 16); }
__device__ __forceinline__ float bfhi(unsigned w) { return __uint_as_float(w & 0xffff0000u); }
__device__ __forceinline__ float wave_sum(float v) {
#pragma unroll
    for (int o = 1; o < 64; o <<= 1) v += __shfl_xor(v, o);
    return v;
}

#define XB_TMO      128
#define XB_XCNT(j)  (256  + 64 * (j))
#define XB_XSUB(j)  (1280 + 64 * (j))
#define XB_XGEN(j)  (2304 + 64 * (j))
#define XB_TOP      3328
#define XB_TOPGEN   3392
#define XCD_BAR_WORDS 3456
#define XB_SPIN_CAP (1u << 18)

__device__ __forceinline__ unsigned xb_ld(unsigned* p)              { return __hip_atomic_load(p, __ATOMIC_RELAXED, __HIP_MEMORY_SCOPE_AGENT); }
__device__ __forceinline__ unsigned xb_add(unsigned* p, unsigned v) { return __hip_atomic_fetch_add(p, v, __ATOMIC_RELAXED, __HIP_MEMORY_SCOPE_AGENT); }
__device__ __forceinline__ unsigned xb_xcc_id() { return (unsigned)__builtin_amdgcn_s_getreg((3 << 11) | 20) & 0xFu; }
#define XB_SPIN(cond, bar) do { unsigned _sp = 0; while (cond) { __builtin_amdgcn_s_sleep(1); \
    if ((++_sp & 255u) == 0u) { if (xb_ld(&(bar)[XB_TMO])) break; if (_sp > XB_SPIN_CAP) { atomicAdd(&(bar)[XB_TMO], 1u); break; } } } } while (0)

struct XcdBarrier {
    unsigned* bar; unsigned x;
    volatile LAS unsigned* st;
};

__device__ __forceinline__ XcdBarrier xcd_barrier_post(unsigned* bar, volatile LAS unsigned* st) {
    XcdBarrier b; b.bar = bar; b.x = xb_xcc_id(); b.st = st;
    if (threadIdx.x == 0) (void)xb_add(&bar[XB_XCNT(b.x)], 1u);
    return b;
}
__device__ __forceinline__ void xcd_barrier_complete(unsigned* bar, unsigned x, unsigned& nloc, unsigned& nx) {
    const unsigned G = gridDim.x * gridDim.y * gridDim.z;
    unsigned sum, cnt, mine, sp = 0u;
    for (;;) {
        sum = 0u; cnt = 0u; mine = 0u;
#pragma unroll
        for (unsigned j = 0; j < 16; ++j) { const unsigned c = xb_ld(&bar[XB_XCNT(j)]); sum += c; cnt += (c > 0u) ? 1u : 0u; mine = (j == x) ? c : mine; }
        if (sum == G) break;
        __builtin_amdgcn_s_sleep(1);
        if ((++sp & 255u) == 0u) { if (xb_ld(&bar[XB_TMO])) break; if (sp > XB_SPIN_CAP) { atomicAdd(&bar[XB_TMO], 1u); break; } }
    }
    nloc = mine > 0u ? mine : 1u; nx = cnt > 0u ? cnt : 1u;
}

__device__ __forceinline__ void xcd_barrier(const XcdBarrier& b) {
    asm volatile("s_waitcnt vmcnt(0)" ::: "memory");
    __syncthreads();
    if (threadIdx.x == 0) {
        unsigned* bar = b.bar;
        __builtin_amdgcn_s_waitcnt(0);
        unsigned nloc = b.st[0], nx = b.st[1];
        if (nloc == 0u) { xcd_barrier_complete(bar, b.x, nloc, nx); b.st[0] = nloc; b.st[1] = nx; }
        const unsigned old = xb_add(&bar[XB_XSUB(b.x)], 1u);
        const unsigned gen = old / nloc;
        if (old + 1u == (gen + 1u) * nloc) {
            __builtin_amdgcn_fence(__ATOMIC_RELEASE, "agent");
            asm volatile("s_waitcnt vmcnt(0)" ::: "memory");
            const unsigned og = xb_add(&bar[XB_TOP], 1u);
            const unsigned tg = og / nx;
            if (og + 1u == (tg + 1u) * nx) xb_add(&bar[XB_TOPGEN], 1u);
            else XB_SPIN(xb_ld(&bar[XB_TOPGEN]) == tg, bar);
            __builtin_amdgcn_fence(__ATOMIC_ACQUIRE, "agent");
            xb_add(&bar[XB_XGEN(b.x)], 1u);
            asm volatile("s_waitcnt vmcnt(0)" ::: "memory");
        } else {
            XB_SPIN(xb_ld(&bar[XB_XGEN(b.x)]) == gen, bar);
            __builtin_amdgcn_fence(__ATOMIC_ACQUIRE, "agent");
            asm volatile("s_waitcnt vmcnt(0)" ::: "memory");
        }
    }
    __syncthreads();
}

constexpr size_t WS_BAR = 768 * 1024;
struct Args { const float* in[20]; float* out; unsigned char* ws; int ph_lo, ph_hi; };

__device__ __forceinline__ void tr_item(const float* __restrict__ W, int K, int N, const float* __restrict__ gain, bf16* __restrict__ WT, int dst_row0, LAS float* scr, int k0, int n0, int lane) {
    float w[32]; const float* wp = W + (size_t)(k0 + (lane >> 5)) * N + n0 + (lane & 31);
#pragma unroll
    for (int i = 0; i < 32; ++i) w[i] = wp[(size_t)(2 * i) * N];
    if (gain) {
#pragma unroll
        for (int i = 0; i < 32; ++i) w[i] *= gain[k0 + 2 * i + (lane >> 5)];
    }
#pragma unroll
    for (int i = 0; i < 32; ++i) scr[(2 * i + (lane >> 5)) * 33 + (lane & 31)] = w[i];
    LDS_WAIT(); asm volatile("" ::: "memory");
    const int c = lane & 7;
#pragma unroll
    for (int j = 0; j < 4; ++j) { const int n = (lane >> 3) + 8 * j; const LAS float* s = scr + (8 * c) * 33 + n;
        v4u o; o.x = pk2(s[0 * 33], s[1 * 33]); o.y = pk2(s[2 * 33], s[3 * 33]); o.z = pk2(s[4 * 33], s[5 * 33]); o.w = pk2(s[6 * 33], s[7 * 33]);
        *(v4u*)(WT + (size_t)(dst_row0 + n) * K + k0 + 8 * c) = o; }
    LDS_WAIT(); asm volatile("" ::: "memory");
}
__device__ __forceinline__ bool tr_matrix(int& r, const float* W, int K, int N, const float* gain, bf16* WT, int mode, LAS float* scr, int lane) {
    const int nblk = N / 32, items = (K / 64) * nblk;
    if (r >= items) { r -= items; return false; }
    const int kb = r / nblk, nb = r % nblk, n0 = 32 * nb;
    const int dst = mode == 3 ? (256 * (n0 >> 8) + 128 * ((n0 >> 5) & 1) + 32 * ((n0 >> 6) & 3)) : (256 * (n0 >> 7) + (n0 & 127) + (mode == 2 ? 128 : 0));
    tr_item(W, K, N, gain, WT, dst, scr, 64 * kb, n0, lane);
    return true;
}
__device__ __forceinline__ void p0_prep(const Args& a, LAS unsigned char* lds, int gw, int NGW, int lane, int wave) {
    unsigned char* ws = a.ws;
    LAS float* scr = (LAS float*)(lds + wave * 16384);
    constexpr int I_GU = (D / 64) * (FF / 32), I_DN = (FF / 64) * (D / 32), I_IN = (D / 64) * (NPROJ / 32), I_SQ = (D / 64) * (D / 32), I_PP = (PLE / 64) * (D / 32);
    constexpr int NITEMS = 4 * I_GU + 2 * I_DN + I_IN + 2 * I_SQ + I_PP;
    for (int it = gw; it < NITEMS; it += NGW) {
        int r = it;
        if (tr_matrix(r, a.in[3], D, FF, a.in[2], (bf16*)(ws + WS_W1GU), 1, scr, lane)) continue;
        if (tr_matrix(r, a.in[4], D, FF, a.in[2], (bf16*)(ws + WS_W1GU), 2, scr, lane)) continue;
        if (tr_matrix(r, a.in[14], D, FF, a.in[13], (bf16*)(ws + WS_W2GU), 1, scr, lane)) continue;
        if (tr_matrix(r, a.in[15], D, FF, a.in[13], (bf16*)(ws + WS_W2GU), 2, scr, lane)) continue;
        if (tr_matrix(r, a.in[5], FF, D, nullptr, (bf16*)(ws + WS_W1D), 3, scr, lane)) continue;
        if (tr_matrix(r, a.in[16], FF, D, nullptr, (bf16*)(ws + WS_W2D), 3, scr, lane)) continue;
        if (tr_matrix(r, a.in[7], D, NPROJ, a.in[6], (bf16*)(ws + WS_WIN), 3, scr, lane)) continue;
        if (tr_matrix(r, a.in[12], D, D, nullptr, (bf16*)(ws + WS_WOUT), 3, scr, lane)) continue;
        if (tr_matrix(r, a.in[18], D, D, a.in[17], (bf16*)(ws + WS_WPG), 3, scr, lane)) continue;
        tr_matrix(r, a.in[19], PLE, D, nullptr, (bf16*)(ws + WS_WPP), 3, scr, lane);
    }
    const float* __restrict__ x = a.in[0]; bf16* __restrict__ XB = (bf16*)(ws + WS_XB); float* __restrict__ ss1 = (float*)(ws + WS_CTL);
    for (int m0 = gw * 4; m0 < M; m0 += NGW * 4) {
        f32x4 v[4][4];
#pragma unroll
        for (int r = 0; r < 4; ++r)
#pragma unroll
            for (int j = 0; j < 4; ++j) v[r][j] = ((const f32x4*)(x + (size_t)(m0 + r) * D) + lane)[64 * j];
#pragma unroll
        for (int r = 0; r < 4; ++r) { float s = 0.f;
#pragma unroll
            for (int j = 0; j < 4; ++j) s += (v[r][j].x * v[r][j].x + v[r][j].y * v[r][j].y) + (v[r][j].z * v[r][j].z + v[r][j].w * v[r][j].w);
            s = wave_sum(s);
            unsigned long long* o8 = (unsigned long long*)(XB + (size_t)(m0 + r) * D) + lane;
#pragma unroll
            for (int j = 0; j < 4; ++j) o8[64 * j] = (unsigned long long)pk2(v[r][j].x, v[r][j].y) | ((unsigned long long)pk2(v[r][j].z, v[r][j].w) << 32);
            if (lane == 0) ss1[m0 + r] = s; }
    }
    const float* __restrict__ p = a.in[1]; bf16* __restrict__ PB = (bf16*)(ws + WS_PB);
    for (int i0 = gw * 64 + lane; i0 < M * PLE / 8; i0 += NGW * 64 * 4) {
        f32x4 v0[4], v1[4];
#pragma unroll
        for (int r = 0; r < 4; ++r) { const size_t i = (size_t)i0 + (size_t)r * NGW * 64; v0[r] = *(const f32x4*)(p + i * 8); v1[r] = *(const f32x4*)(p + i * 8 + 4); }
#pragma unroll
        for (int r = 0; r < 4; ++r) { const size_t i = (size_t)i0 + (size_t)r * NGW * 64; *(v4u*)(PB + i * 8) = (v4u){pk2(v0[r].x, v0[r].y), pk2(v0[r].z, v0[r].w), pk2(v1[r].x, v1[r].y), pk2(v1[r].z, v1[r].w)}; }
    }
}

__device__ __forceinline__ void unpack8(const v4u w, float (&f)[8]) { f[0] = bflo(w.x); f[1] = bfhi(w.x); f[2] = bflo(w.y); f[3] = bfhi(w.y); f[4] = bflo(w.z); f[5] = bfhi(w.z); f[6] = bflo(w.w); f[7] = bfhi(w.w); }
__device__ __forceinline__ v4u pack8(const float (&f)[8]) { return (v4u){pk2(f[0], f[1]), pk2(f[2], f[3]), pk2(f[4], f[5]), pk2(f[6], f[7])}; }
__device__ __forceinline__ void conv_phase(const Args& a, int gw, int NGW, int lane) {
    const bf16* __restrict__ PROJ = (const bf16*)(a.ws + WS_HID); bf16* __restrict__ YMIX = (bf16*)(a.ws + WS_YMIX);
    const float* cw = a.in[8]; const float* cbp = a.in[9];
    float w0[8], w1[8], w2[8], cb[8];
#pragma unroll
    for (int i = 0; i < 8; ++i) { w0[i] = cw[8 * lane + i]; w1[i] = cw[CONVD + 8 * lane + i]; w2[i] = cw[2 * CONVD + 8 * lane + i]; cb[i] = cbp[8 * lane + i]; }
    for (int ch = gw; ch < M / 4; ch += NGW) {
        const int r0 = ch * 4; const bool first = (r0 & (SEQ - 1)) == 0;
        const bf16* pr = PROJ + (size_t)r0 * NPROJ + 8 * lane;
        v4u bw[4], cwv[6], uw[6];
#pragma unroll
        for (int r = 0; r < 4; ++r) bw[r] = *(const v4u*)(pr + (size_t)r * NPROJ);
#pragma unroll
        for (int r = 0; r < 6; ++r) { const bool ok = r >= 2 || !first; const bf16* q = pr + ((size_t)(ok ? r : 2) - 2) * NPROJ; cwv[r] = *(const v4u*)(q + 512); uw[r] = *(const v4u*)(q + 1024); }
        float z1[8], z2[8];
        { float c[8], u[8]; unpack8(cwv[0], c); unpack8(uw[0], u);
#pragma unroll
          for (int i = 0; i < 8; ++i) z2[i] = first ? 0.f : c[i] * u[i];
          unpack8(cwv[1], c); unpack8(uw[1], u);
#pragma unroll
          for (int i = 0; i < 8; ++i) z1[i] = first ? 0.f : c[i] * u[i]; }
#pragma unroll
        for (int r = 0; r < 4; ++r) { float b[8], c[8], u[8], y[8]; unpack8(bw[r], b); unpack8(cwv[r + 2], c); unpack8(uw[r + 2], u);
#pragma unroll
            for (int i = 0; i < 8; ++i) { const float z0 = c[i] * u[i]; y[i] = b[i] * (w0[i] * z2[i] + w1[i] * z1[i] + w2[i] * z0 + cb[i]); z2[i] = z1[i]; z1[i] = z0; }
            *(v4u*)(YMIX + (size_t)(r0 + r) * D + 8 * lane) = pack8(y); }
    }
}

__device__ __forceinline__ void p5_attn_naive(const Args& a, int tid) {
    const bf16* PROJ = (const bf16*)(a.ws + WS_HID); bf16* YMIX = (bf16*)(a.ws + WS_YMIX);
    for (int un = blockIdx.x; un < 512; un += gridDim.x) {
        const int bh = un & 31, r = un >> 5, qq = r < 8 ? r : 23 - r, b = bh >> 3, h = bh & 7;
        const int t = qq * 512 + tid;
        const bf16* base = PROJ + (size_t)b * SEQ * NPROJ + h * HD;
        float q[64], o[64];
#pragma unroll
        for (int c = 0; c < 8; ++c) { float f[8]; unpack8(*(const v4u*)(base + (size_t)t * NPROJ + 1536 + 8 * c), f);
#pragma unroll
            for (int e = 0; e < 8; ++e) { q[8 * c + e] = f[e]; o[8 * c + e] = 0.f; } }
        float carry = 0.f;
        for (int j = qq * 512 + 511; j >= 0; --j) {
            const bf16* kr = base + (size_t)j * NPROJ + 2048; float z = 0.f;
#pragma unroll
            for (int c = 0; c < 8; ++c) { float f[8]; unpack8(*(const v4u*)(kr + 8 * c), f);
#pragma unroll
                for (int e = 0; e < 8; ++e) z += q[8 * c + e] * f[e]; }
            const bool act = j < t;
            const float sp = fmaxf(z, 0.f) + __logf(1.0f + __expf(-fabsf(z)));
            const float av = act ? __expf(z - sp + carry) : 0.f;
            carry -= act ? sp : 0.f;
            const bf16* vr = kr + 512;
#pragma unroll
            for (int c = 0; c < 8; ++c) { float f[8]; unpack8(*(const v4u*)(vr + 8 * c), f);
#pragma unroll
                for (int e = 0; e < 8; ++e) o[8 * c + e] += av * f[e]; }
        }
        bf16* orow = YMIX + (size_t)(b * SEQ + t) * D + 512 + h * HD;
#pragma unroll
        for (int c = 0; c < 8; ++c) { float f[8];
#pragma unroll
            for (int e = 0; e < 8; ++e) f[e] = o[8 * c + e];
            *(v4u*)(orow + 8 * c) = pack8(f); }
    }
}

namespace sba {
using bf16x8 = __attribute__((ext_vector_type(8))) short;
using s16x4 = __attribute__((ext_vector_type(4))) short;
using f32x16 = __attribute__((ext_vector_type(16))) float;
typedef short v4i16_t __attribute__((ext_vector_type(4)));
typedef float f32x2_t __attribute__((ext_vector_type(2))); typedef __bf16 bf16x2_t __attribute__((ext_vector_type(2)));
typedef __attribute__((address_space(3))) const char* lds_cptr;
constexpr int SLOTB = 8192, LDS_K = 0, LDS_V = 3 * SLOTB, LDS_FLG = 6 * SLOTB;
constexpr float CARRY_DEAD = 1e-30f;
__device__ __forceinline__ void glds16(const void* gsrc, unsigned lds_dst) { unsigned keep;
    asm volatile("s_mov_b32 %0, m0\n\ts_mov_b32 m0, %2\n\ts_nop 0\n\tglobal_load_lds_dwordx4 %1, off\n\ts_mov_b32 m0, %0" : "=&s"(keep) : "v"(gsrc), "s"(lds_dst) : "memory"); }
__device__ __forceinline__ unsigned cvtpk_s(float lo, float hi) { f32x2_t v = {lo, hi}; bf16x2_t b = __builtin_convertvector(v, bf16x2_t); return __builtin_bit_cast(unsigned, b); }
__device__ __forceinline__ s16x4 vtr(lds_cptr p) { return __builtin_bit_cast(s16x4, __builtin_amdgcn_ds_read_tr16_b64_v4i16((__attribute__((address_space(3))) v4i16_t*)p)); }
#define SBA_MFMA(a, b, c) __builtin_amdgcn_mfma_f32_32x32x16_bf16((a), (b), (c), 0, 0, 0)

#define SBA_WAIT_BAR() asm volatile("s_waitcnt vmcnt(0) lgkmcnt(0)\n\ts_barrier" ::: "memory")
#define SBA_SBAR() __builtin_amdgcn_sched_barrier(0)
struct Ctx { const unsigned short* ksrc; const unsigned short* vsrc; unsigned kdst, vdst; lds_cptr kp0, vp0; __attribute__((address_space(3))) unsigned* flg; int NT, qrel, hi, wid, lane; int s_cur, s_nxt, s_nn; };
__device__ __forceinline__ void band_mask(f32x16& p0, f32x16& p1, int jb, int qrel, int hi) {
    const int kb = 64 * jb + 4 * hi;
#pragma unroll
    for (int r = 0; r < 16; ++r) { const int kv = kb + (r & 3) + 8 * (r >> 2); if (kv >= qrel) p0[r] = -INFINITY; if (kv + 32 >= qrel) p1[r] = -INFINITY; }
}
__device__ __forceinline__ bool step(Ctx& c, int t, const f32x16& PC0, const f32x16& PC1, f32x16& PN0, f32x16& PN1, f32x16 (&o)[2], const bf16x8 (&qr)[4], float& carry) {
    SBA_WAIT_BAR();
    if (t < c.NT - 1) {
        const __attribute__((address_space(3))) v4u* f = (const __attribute__((address_space(3))) v4u*)(c.flg + ((t + 1) & 1) * 8); const v4u f0 = f[0], f1 = f[1];
        if (((f0.x | f0.y) | (f0.z | f0.w) | (f1.x | f1.y) | (f1.z | f1.w)) == 0u) return false;
    }
    if (t >= 2) { glds16(c.ksrc + (size_t)(t - 2) * 64 * NPROJ, (unsigned)__builtin_amdgcn_readfirstlane(c.kdst + c.s_nn)); glds16(c.vsrc + (size_t)(t - 2) * 64 * NPROJ, (unsigned)__builtin_amdgcn_readfirstlane(c.vdst + c.s_nn)); }
    bf16x8 kf[8]; s16x4 vlo[8], vhi[8];
    { const lds_cptr kp = c.kp0 + c.s_nxt;
#pragma unroll
      for (int d0 = 0; d0 < 4; ++d0) { kf[2 * d0] = *(const __attribute__((address_space(3))) bf16x8*)(kp + d0 * 2048); kf[2 * d0 + 1] = *(const __attribute__((address_space(3))) bf16x8*)(kp + d0 * 2048 + 512); }
      const lds_cptr vp = c.vp0 + c.s_cur;
#pragma unroll
      for (int i = 0; i < 8; ++i) { vlo[i] = vtr(vp + (i >> 2) * 4096 + (i & 3) * 1024); vhi[i] = vtr(vp + (i >> 2) * 4096 + (i & 3) * 1024 + 512); } }
    const f32x16 zero16 = f32x16{};
    float st = carry; unsigned pw[4][4];
#define VFR(i) ((bf16x8){vlo[i][0], vlo[i][1], vlo[i][2], vlo[i][3], vhi[i][0], vhi[i][1], vhi[i][2], vhi[i][3]})
#define PAF(ks) __builtin_bit_cast(bf16x8, (v4u){pw[ks][0], pw[ks][1], pw[ks][2], pw[ks][3]})
#pragma unroll
    for (int jj = 0; jj < 4; ++jj) {
        const int ks = 3 - jj, p = ks >> 1;
        SBA_SBAR();
        PN0 = SBA_MFMA(kf[2 * jj], qr[jj], jj ? PN0 : zero16); PN1 = SBA_MFMA(kf[2 * jj + 1], qr[jj], jj ? PN1 : zero16);
        if (jj >= 1) { o[0] = SBA_MFMA(PAF(ks + 1), VFR(ks + 1), o[0]); o[1] = SBA_MFMA(PAF(ks + 1), VFR(4 + ks + 1), o[1]); }
        float a8[8];
#pragma unroll
        for (int gi = 0; gi < 2; ++gi) {
            const int g = 2 * (ks & 1) + 1 - gi; float k4[4];
#pragma unroll
            for (int e = 0; e < 4; ++e) { const float z = p ? PC1[4 * g + e] : PC0[4 * g + e]; k4[e] = __builtin_amdgcn_rcpf(1.0f + __builtin_amdgcn_exp2f(z)); }
            const float r3 = k4[3], r2 = r3 * k4[2], r1 = r2 * k4[1], G = r1 * k4[0];
            const auto rr = __builtin_amdgcn_permlane32_swap(__float_as_uint(G), __float_as_uint(G), false, false);
            const float Glo = __uint_as_float(rr[0]), Ghi = __uint_as_float(rr[1]);
            const float base = st * (c.hi ? 1.0f : Ghi);
            a8[4 * (1 - gi) + 3] = base * (1.0f - r3); a8[4 * (1 - gi) + 2] = base * (r3 - r2); a8[4 * (1 - gi) + 1] = base * (r2 - r1); a8[4 * (1 - gi)] = base * (r1 - G);
            st = st * (Glo * Ghi);
        }
#pragma unroll
        for (int i = 0; i < 4; ++i) pw[ks][i] = cvtpk_s(a8[2 * i], a8[2 * i + 1]);
    }
    SBA_SBAR();
    o[0] = SBA_MFMA(PAF(0), VFR(0), o[0]); o[1] = SBA_MFMA(PAF(0), VFR(4), o[1]);
#undef VFR
#undef PAF
    carry = st;
    { const unsigned long long alive = __ballot(st > CARRY_DEAD); if (c.lane == 0) c.flg[(t & 1) * 8 + c.wid] = alive ? 1u : 0u; }
    if (t - 1 >= c.NT - 4) band_mask(PN0, PN1, t - 1 - (c.NT - 4), c.qrel, c.hi);
    { const int s = c.s_cur; c.s_cur = c.s_nxt; c.s_nxt = c.s_nn; c.s_nn = s; }
    return true;
}
__device__ __forceinline__ void unit(int b, int hd, int qb, const unsigned short* PROJ, unsigned short* YMIX, char* shm) {
    const int tid = threadIdx.x, lane = tid & 63, r32 = lane & 31, hi = lane >> 5; const int wid = __builtin_amdgcn_readfirstlane(tid >> 6);
    const size_t rowbase = (size_t)b * SEQ; const int q0 = qb * 256;
    const unsigned short* Qw = PROJ + (rowbase + q0 + wid * 32) * NPROJ + 1536 + hd * 64;
    const unsigned short* Kh = PROJ + rowbase * NPROJ + 2048 + hd * 64; const unsigned short* Vh = Kh + 512;
    const unsigned lds0 = (unsigned)(uintptr_t)shm;
    const lds_cptr shm3 = (lds_cptr)shm;
    Ctx c;
    c.ksrc = Kh + (size_t)lane * NPROJ + wid * 8;
    c.vsrc = Vh + (size_t)(16 * (wid & 3) + (lane >> 2)) * NPROJ + (wid >> 2) * 32 + (lane & 3) * 8;
    c.kdst = lds0 + LDS_K + wid * 1024; c.vdst = lds0 + LDS_V + wid * 1024;
    c.kp0 = shm3 + LDS_K + hi * 1024 + r32 * 16;
    c.vp0 = shm3 + LDS_V + ((lane >> 4) & 1) * 32 + (lane & 3) * 8 + (4 * hi + ((lane & 15) >> 2)) * 64;
    c.flg = (__attribute__((address_space(3))) unsigned*)(shm3 + LDS_FLG); c.wid = wid; c.lane = lane;
    c.NT = 4 * (qb + 1); c.qrel = wid * 32 + r32; c.hi = hi; c.s_cur = 0; c.s_nxt = SLOTB; c.s_nn = 2 * SLOTB;
    const int NT = c.NT;
    asm volatile("s_waitcnt lgkmcnt(0)\n\ts_barrier" ::: "memory");
    glds16(c.ksrc + (size_t)(NT - 1) * 64 * NPROJ, (unsigned)__builtin_amdgcn_readfirstlane(c.kdst)); glds16(c.vsrc + (size_t)(NT - 1) * 64 * NPROJ, (unsigned)__builtin_amdgcn_readfirstlane(c.vdst));
    glds16(c.ksrc + (size_t)(NT - 2) * 64 * NPROJ, (unsigned)__builtin_amdgcn_readfirstlane(c.kdst + SLOTB)); glds16(c.vsrc + (size_t)(NT - 2) * 64 * NPROJ, (unsigned)__builtin_amdgcn_readfirstlane(c.vdst + SLOTB));
    bf16x8 qr[4];
#pragma unroll
    for (int d0 = 0; d0 < 4; ++d0) qr[d0] = *reinterpret_cast<const bf16x8*>(&Qw[(size_t)r32 * NPROJ + d0 * 16 + hi * 8]);
    f32x16 o[2]; o[0] = f32x16{}; o[1] = f32x16{};
    float carry = 1.0f;
    SBA_WAIT_BAR();
    f32x16 pA0, pA1, pB0, pB1;
    { const f32x16 zero16 = f32x16{};
#pragma unroll
      for (int d0 = 0; d0 < 4; ++d0) {
          const bf16x8 b0 = *(const __attribute__((address_space(3))) bf16x8*)(c.kp0 + d0 * 2048);
          const bf16x8 b1 = *(const __attribute__((address_space(3))) bf16x8*)(c.kp0 + d0 * 2048 + 512);
          pA0 = SBA_MFMA(b0, qr[d0], d0 ? pA0 : zero16); pA1 = SBA_MFMA(b1, qr[d0], d0 ? pA1 : zero16);
      }
      band_mask(pA0, pA1, 3, c.qrel, hi); }
    for (int t = NT - 1; t > 0; t -= 2) {
        if (!step(c, t, pA0, pA1, pB0, pB1, o, qr, carry)) break;
        if (!step(c, t - 1, pB0, pB1, pA0, pA1, o, qr, carry)) break;
    }
    unsigned short* Ow = YMIX + (rowbase + q0 + wid * 32) * D + 512 + hd * 64;
#pragma unroll
    for (int r = 0; r < 16; ++r) { const int orow = (r & 3) + 8 * (r >> 2) + 4 * hi;
#pragma unroll
        for (int d0 = 0; d0 < 2; ++d0) Ow[(size_t)orow * D + d0 * 32 + r32] = (unsigned short)(cvtpk_s(o[d0][r], 0.f) & 0xffffu); }
}
__device__ __forceinline__ void phase(const unsigned short* PROJ, unsigned short* YMIX, char* shm) {
    const int G = gridDim.x, bx = blockIdx.x; const int vcu = (G % 8 == 0) ? (bx % 8) * (G / 8) + bx / 8 : bx;
    for (int v = vcu; v < 256; v += G) { const int bh = v >> 3, s = v & 7;
#pragma unroll 1
        for (int i = 0; i < 4; ++i) { const int qb = (i == 0) ? 31 - s : (i == 1) ? 16 + s : (i == 2) ? 15 - s : s; unit(bh >> 3, bh & 7, qb, PROJ, YMIX, shm); } }
}
}

__global__ void __launch_bounds__(NWAVES * 64, 2) mk_fwd(Args args) {
    extern __shared__ __attribute__((aligned(16))) unsigned char lds_raw[];
    LAS unsigned char* lds = (LAS unsigned char*)lds_raw;
    const int tid = threadIdx.x, lane = tid & 63, wave = __builtin_amdgcn_readfirstlane(tid >> 6);
    const int G = gridDim.x, gw = blockIdx.x * NWAVES + wave, NGW = G * NWAVES;
    unsigned char* ws = args.ws;
    float* ss1 = (float*)(ws + WS_CTL); float* ss2 = ss1 + M; float* ss3 = ss2 + M; float* ss4 = ss3 + M;
    bf16* XB = (bf16*)(ws + WS_XB); bf16* PB = (bf16*)(ws + WS_PB); bf16* HID = (bf16*)(ws + WS_HID); bf16* PROJ = HID; bf16* YMIX = (bf16*)(ws + WS_YMIX); bf16* PP = (bf16*)(ws + WS_PP);
    const int lo = args.ph_lo, hi = args.ph_hi;
    volatile LAS unsigned* MISC = (volatile LAS unsigned*)(lds + 131072);
    if (tid < 32) MISC[tid] = 0u;
    __syncthreads();
    XcdBarrier bar; bar.bar = (unsigned*)(ws + WS_BAR); bar.x = 0; bar.st = nullptr;
    if (hi - lo > 1) bar = xcd_barrier_post((unsigned*)(ws + WS_BAR), MISC + 8);
#define IN(k) (lo <= (k) && (k) < hi)
#define SEAM(k) do { if (IN(k) && IN((k) + 1)) { if ((k) == 0) cg::this_grid().sync(); else xcd_barrier(bar); } } while (0)
    typedef pg8::StaticOrder SO;
    if (IN(0)) { p0_prep(args, lds, gw, NGW, lane, wave); } SEAM(0);
    if (IN(1)) {
        { pg8::Gemm g{XB, (const bf16*)(ws + WS_W1GU), M, 2 * FF, D}; SO S; S.init(M, 2 * FF, G, (int)blockIdx.x); pg8::EpiSwiGLU E{HID, FF, ss1};
          pg8::gemm_phase<pg8::EpiSwiGLU, SO, true, true>(lds, g, S, E); }
        { pg8::Gemm g{PB, (const bf16*)(ws + WS_WPP), M, D, PLE}; SO S; S.init(M, D, G, (int)blockIdx.x); pg8::EpiScaleBf16 E{PP, D, nullptr};
          pg8::gemm_phase<pg8::EpiScaleBf16, SO, true, true>(lds, g, S, E); }
    } SEAM(1);
    if (IN(2)) { pg8::Gemm g{HID, (const bf16*)(ws + WS_W1D), M, D, FF}; SO S; S.init(M, D, G, (int)blockIdx.x); pg8::EpiResid<false> E{nullptr, XB, ss2, 0.5f};
        pg8::gemm_phase<pg8::EpiResid<false>, SO, true, true>(lds, g, S, E); } SEAM(2);
    if (IN(3)) { pg8::Gemm g{XB, (const bf16*)(ws + WS_WIN), M, NPROJ, D}; SO S; S.init(M, NPROJ, G, (int)blockIdx.x); pg8::EpiProj E{PROJ, ss2, args.in[10], args.in[11], QSC};
        pg8::gemm_phase<pg8::EpiProj, SO, true, true>(lds, g, S, E); } SEAM(3);
    if (IN(5)) { if (ATTN_NAIVE) p5_attn_naive(args, tid); else sba::phase(PROJ, YMIX, (char*)lds_raw); conv_phase(args, gw, NGW, lane); } SEAM(5);
    if (IN(6)) { pg8::Gemm g{YMIX, (const bf16*)(ws + WS_WOUT), M, D, D}; SO S; S.init(M, D, G, (int)blockIdx.x); pg8::EpiResid<false> E{nullptr, XB, ss3, 1.0f};
        pg8::gemm_phase<pg8::EpiResid<false>, SO, true, true>(lds, g, S, E); } SEAM(6);
    if (IN(7)) { pg8::Gemm g{XB, (const bf16*)(ws + WS_W2GU), M, 2 * FF, D}; SO S; S.init(M, 2 * FF, G, (int)blockIdx.x); pg8::EpiSwiGLU E{HID, FF, ss3};
        pg8::gemm_phase<pg8::EpiSwiGLU, SO, true, true>(lds, g, S, E); } SEAM(7);
    if (IN(8)) { pg8::Gemm g{HID, (const bf16*)(ws + WS_W2D), M, D, FF}; SO S; S.init(M, D, G, (int)blockIdx.x); pg8::EpiResid<false> E{nullptr, XB, ss4, 0.5f};
        pg8::gemm_phase<pg8::EpiResid<false>, SO, true, true>(lds, g, S, E); } SEAM(8);
    if (IN(9)) { pg8::Gemm g{XB, (const bf16*)(ws + WS_WPG), M, D, D}; SO S; S.init(M, D, G, (int)blockIdx.x); pg8::EpiPle E{XB, args.out, PP, ss4};
        pg8::gemm_phase<pg8::EpiPle, SO, true, true>(lds, g, S, E); }
#undef IN
#undef SEAM
}

extern "C" void kernel_launch(void* const* d_in, const int* in_sizes, int n_in, void* d_out, int out_size, void* d_ws, size_t ws_size, hipStream_t stream) {
    static int grid = 0;
    if (grid == 0) {
        if (n_in != 20 || out_size != M * D || ws_size < WS_END) { fprintf(stderr, "kernel_launch: unexpected shapes (n_in %d out %d ws %zu)\n", n_in, out_size, ws_size); grid = -1; return; }
        int dev = 0, cus = 0, per_cu = 0;
        if (hipGetDevice(&dev) != hipSuccess || hipDeviceGetAttribute(&cus, hipDeviceAttributeMultiprocessorCount, dev) != hipSuccess) { grid = -1; return; }
        if (hipFuncSetAttribute((const void*)mk_fwd, hipFuncAttributeMaxDynamicSharedMemorySize, LDS_BYTES) != hipSuccess) { fprintf(stderr, "kernel_launch: hipFuncSetAttribute failed\n"); grid = -1; return; }
        if (hipOccupancyMaxActiveBlocksPerMultiprocessor(&per_cu, (const void*)mk_fwd, NWAVES * 64, LDS_BYTES) != hipSuccess || per_cu < 1) { fprintf(stderr, "kernel_launch: occupancy query says %d\n", per_cu); per_cu = 1; }
        (void)hipGetLastError();
        grid = cus;
    }
    if (grid < 0) return;
    (void)hipMemsetAsync((char*)d_ws + WS_CTL, 0, CTL_ZERO_BYTES, stream);
    Args a{};
    for (int i = 0; i < 20; ++i) a.in[i] = (const float*)d_in[i];
    a.out = (float*)d_out; a.ws = (unsigned char*)d_ws;
#if MK_ONE_LAUNCH
    a.ph_lo = 0; a.ph_hi = N_PHASES;
    void* kargs[] = {&a};
    hipError_t e = hipLaunchCooperativeKernel((const void*)mk_fwd, dim3(grid), dim3(NWAVES * 64), kargs, LDS_BYTES, stream);
    if (e != hipSuccess) fprintf(stderr, "kernel_launch: cooperative launch failed: %s\n", hipGetErrorString(e));
#else
    for (int ph = 0; ph < N_PHASES; ++ph) for (int rep = 0; rep < 1 + ((PROBE_DUP >> ph) & 1); ++rep) { a.ph_lo = ph; a.ph_hi = ph + 1; hipLaunchKernelGGL(mk_fwd, dim3(grid), dim3(NWAVES * 64), LDS_BYTES, stream, a); }
#endif
}
```

```cpp
#include <hip/hip_runtime.h>
#include <hip/hip_cooperative_groups.h>
#include <cstdio>
#include <cstdint>
namespace cg = cooperative_groups;
__device__ __forceinline__ int lane_now() { int l_; asm volatile("v_mbcnt_lo_u32_b32 %0, -1, 0\n\tv_mbcnt_hi_u32_b32 %0, -1, %0" : "=v"(l_)); return l_; }
namespace pg8 {
#define PG8_LAS __attribute__((address_space(3)))
typedef unsigned short bf16_t;
typedef short bf16x8 __attribute__((ext_vector_type(8)));
typedef float f32x4 __attribute__((ext_vector_type(4)));
typedef unsigned u32x4 __attribute__((ext_vector_type(4)));
constexpr int BM = 256, BK = 64, HALF = 128, HTB = HALF * BK * 2  , STAGE_BYTES = 8 * HTB, NXCD = 8, WGM = 4;

__host__ __device__ __forceinline__ int lds_byte(int r, int c) { const int st = (r >> 4) * 2 + (c >> 5), rr = r & 15, cc = c & 31, ob = rr * 64 + cc * 2; return st * 1024 + (ob ^ (((ob >> 9) & 1) << 5)); }
__host__ __device__ __forceinline__ void stage_rc(int b, int& R, int& C) { const int st = b / 1024, sb = b % 1024, swz = sb ^ (((sb >> 9) & 1) << 5); R = (st >> 1) * 16 + swz / 64; C = (st & 1) * 32 + (swz % 64) / 2; }
__host__ __device__ __forceinline__ int perm32(int rho) { const int n = rho >> 4, i = rho & 15; return 8 * (i >> 2) + 4 * n + (i & 3); }

struct Unit { int pm, pn, idx; };
struct Gemm { const bf16_t* A; const bf16_t* Bt; int M, N, K; };

struct StaticOrder {
    int nM, nN, nwg, G, c;
    __host__ __device__ void init(int M, int N, int G_, int c_) { nM = M / BM; nN = N / BM; nwg = nM * nN; G = G_; c = c_; }
    __host__ __device__ bool next(int i, Unit& u) const {
        const long L = (long)i * G + c; if (L >= nwg) return false;
        int wgid = (int)L; { const int q = nwg / NXCD, r = nwg % NXCD, xcd = wgid % NXCD, off = wgid / NXCD; wgid = (xcd < r ? xcd * (q + 1) : r * (q + 1) + (xcd - r) * q) + off; }
        const int nig = WGM * nN, gid = wgid / nig, fm = gid * WGM, gsz = (nM - fm) < WGM ? (nM - fm) : WGM;
        u.pm = fm + ((wgid % nig) % gsz); u.pn = (wgid % nig) / gsz; u.idx = i; return true;
    }
    __device__ __forceinline__ void a_ready(const Unit&) const {}
    __device__ __forceinline__ void done(const Unit&) const {}
};

__device__ __forceinline__ unsigned cvt_pk_bf16(float lo, float hi) { unsigned r; asm volatile("v_cvt_pk_bf16_f32 %0, %1, %2" : "=v"(r) : "v"(lo), "v"(hi)); return r; }
typedef float f32x2 __attribute__((ext_vector_type(2)));
__device__ __forceinline__ float rs_of(float ss) { return rsqrtf(ss * (1.0f / 1024.0f) + 1e-6f); }
struct EpiSwiGLU {
    static constexpr bool PERM = true, AFTER_DRAIN = false; static constexpr int NST = 8;
    bf16_t* H; int ldh; const PG8_LAS float* rst;
    __device__ __forceinline__ void operator()(const f32x4 (&acc)[2][2][4][2], const Unit& u, int wr, int wc, int fr, int fq) const {
        const int row0 = u.pm * BM + wr * 64 + fr, col0 = u.pn * HALF + wc * 32 + 8 * fq;
#pragma unroll
        for (int ai = 0; ai < 2; ++ai)
#pragma unroll
            for (int m = 0; m < 4; ++m) {
                const int row = row0 + ai * HALF + m * 16; const float rs = rst[u.idx * 256 + wr * 64 + fr + ai * HALF + m * 16];
                unsigned ww[4];
                const float rsl = rs * -1.4426950408889634f, rs2 = rs * rs;
#pragma unroll
                for (int n = 0; n < 2; ++n) { const f32x4 g = acc[ai][0][m][n], up = acc[ai][1][m][n]; f32x4 hh;
#pragma unroll
                    for (int e = 0; e < 4; ++e) hh[e] = (g[e] * up[e]) * (rs2 * __builtin_amdgcn_rcpf(1.0f + __builtin_amdgcn_exp2f(g[e] * rsl)));
                    ww[2 * n] = cvt_pk_bf16(hh[0], hh[1]); ww[2 * n + 1] = cvt_pk_bf16(hh[2], hh[3]); }
                __builtin_nontemporal_store((u32x4){ww[0], ww[1], ww[2], ww[3]}, (u32x4*)(H + (size_t)row * ldh + col0));
            }
    }
};
template <bool XF32> struct EpiResid {
    static constexpr bool PERM = true, AFTER_DRAIN = false; static constexpr int NST = 16;
    const float* xold; bf16_t* xb; float* ssq; float alpha;
    __device__ __forceinline__ void operator()(const f32x4 (&acc)[2][2][4][2], const Unit& u, int wr, int wc, int fr, int fq) const {
        const int row0 = u.pm * BM + wr * 64 + fr, colb = u.pn * BM + wc * 64 + 8 * fq;
#pragma unroll
        for (int ai = 0; ai < 2; ++ai)
#pragma unroll
            for (int m = 0; m < 4; ++m) {
                const int row = row0 + ai * HALF + m * 16; float s = 0.f;
#pragma unroll
                for (int bj = 0; bj < 2; ++bj) { const size_t off = (size_t)row * 1024 + colb + bj * 32;
                    f32x4 o0, o1;
                    if (XF32) { o0 = *(const f32x4*)(xold + off); o1 = *(const f32x4*)(xold + off + 4); }
                    else { const u32x4 pw = *(const u32x4*)(xb + off);
                        o0[0] = __uint_as_float(pw[0] << 16); o0[1] = __uint_as_float(pw[0] & 0xffff0000u); o0[2] = __uint_as_float(pw[1] << 16); o0[3] = __uint_as_float(pw[1] & 0xffff0000u);
                        o1[0] = __uint_as_float(pw[2] << 16); o1[1] = __uint_as_float(pw[2] & 0xffff0000u); o1[2] = __uint_as_float(pw[3] << 16); o1[3] = __uint_as_float(pw[3] & 0xffff0000u); }
                    const f32x4 v0 = o0 + acc[ai][bj][m][0] * alpha, v1 = o1 + acc[ai][bj][m][1] * alpha;
                    *(u32x4*)(xb + off) = (u32x4){cvt_pk_bf16(v0[0], v0[1]), cvt_pk_bf16(v0[2], v0[3]), cvt_pk_bf16(v1[0], v1[1]), cvt_pk_bf16(v1[2], v1[3])};
                    s += (v0[0] * v0[0] + v0[1] * v0[1]) + (v0[2] * v0[2] + v0[3] * v0[3]) + (v1[0] * v1[0] + v1[1] * v1[1]) + (v1[2] * v1[2] + v1[3] * v1[3]); }
                s += __shfl_xor(s, 16); s += __shfl_xor(s, 32);
                if (fq == 0) __hip_atomic_fetch_add(ssq + row, s, __ATOMIC_RELAXED, __HIP_MEMORY_SCOPE_AGENT);
            }
    }
};
struct EpiScaleBf16 {
    static constexpr bool PERM = true, AFTER_DRAIN = false; static constexpr int NST = 16;
    bf16_t* O; int ldc; const float* ss;
    __device__ __forceinline__ void operator()(const f32x4 (&acc)[2][2][4][2], const Unit& u, int wr, int wc, int fr, int fq) const {
        const int row0 = u.pm * BM + wr * 64 + fr, colb = u.pn * BM + wc * 64 + 8 * fq;
#pragma unroll
        for (int ai = 0; ai < 2; ++ai)
#pragma unroll
            for (int m = 0; m < 4; ++m) {
                const int row = row0 + ai * HALF + m * 16; const float rs = ss ? rs_of(ss[row]) : 1.0f;
#pragma unroll
                for (int bj = 0; bj < 2; ++bj) { const f32x4 v0 = acc[ai][bj][m][0] * rs, v1 = acc[ai][bj][m][1] * rs;
                    __builtin_nontemporal_store((u32x4){cvt_pk_bf16(v0[0], v0[1]), cvt_pk_bf16(v0[2], v0[3]), cvt_pk_bf16(v1[0], v1[1]), cvt_pk_bf16(v1[2], v1[3])}, (u32x4*)(O + (size_t)row * ldc + colb + bj * 32)); }
            }
    }
};
struct EpiProj {
    static constexpr bool PERM = true, AFTER_DRAIN = false; static constexpr int NST = 8;
    bf16_t* O; const PG8_LAS float* rst; const PG8_LAS float* gtab;
    __device__ __forceinline__ void operator()(const f32x4 (&acc)[2][2][4][2], const Unit& u, int wr, int wc, int fr, int fq) const {
        const int row0 = u.pm * BM + wr * 64 + fr, colb = u.pn * BM + wc * 64 + 8 * fq;
        if (u.pn >= 2 && u.pn < 6) {
            bf16_t* zp = O + (size_t)row0 * 3072 + 512 + 128 * (u.pn - 2) + 32 * wc + 8 * fq;
#pragma unroll
            for (int ai = 0; ai < 2; ++ai)
#pragma unroll
                for (int m = 0; m < 4; ++m) { const float rs = rst[u.idx * 256 + wr * 64 + fr + ai * HALF + m * 16], r2 = rs * rs;
                    const f32x4 z0 = acc[ai][0][m][0] * acc[ai][1][m][0] * r2, z1 = acc[ai][0][m][1] * acc[ai][1][m][1] * r2;
                    __builtin_nontemporal_store((u32x4){cvt_pk_bf16(z0[0], z0[1]), cvt_pk_bf16(z0[2], z0[3]), cvt_pk_bf16(z1[0], z1[1]), cvt_pk_bf16(z1[2], z1[3])}, (u32x4*)(zp + (size_t)(ai * HALF + m * 16) * 3072)); }
            return;
        }
        const int sec = u.pn >> 1; const bool qk = (sec == 3) || (sec == 4);
        f32x4 g[2][2];
        if (qk) { const PG8_LAS float* gp = gtab + (sec == 3 ? 0 : 64);
#pragma unroll
            for (int bj = 0; bj < 2; ++bj)
#pragma unroll
                for (int n = 0; n < 2; ++n) g[bj][n] = *(const PG8_LAS f32x4*)(gp + 32 * bj + 8 * fq + 4 * n); }
#pragma unroll
        for (int ai = 0; ai < 2; ++ai)
#pragma unroll
            for (int m = 0; m < 4; ++m) {
                const int row = row0 + ai * HALF + m * 16; const float rs = rst[u.idx * 256 + wr * 64 + fr + ai * HALF + m * 16];
                f32x4 v[2][2];
#pragma unroll
                for (int bj = 0; bj < 2; ++bj)
#pragma unroll
                    for (int n = 0; n < 2; ++n) v[bj][n] = acc[ai][bj][m][n] * rs;
                if (qk) { float s = 0.f;
#pragma unroll
                    for (int bj = 0; bj < 2; ++bj)
#pragma unroll
                        for (int n = 0; n < 2; ++n) s += (v[bj][n][0] * v[bj][n][0] + v[bj][n][1] * v[bj][n][1]) + (v[bj][n][2] * v[bj][n][2] + v[bj][n][3] * v[bj][n][3]);
                    s += __shfl_xor(s, 16); s += __shfl_xor(s, 32);
                    const float r = rsqrtf(s * (1.0f / 64.0f) + 1e-6f);
#pragma unroll
                    for (int bj = 0; bj < 2; ++bj)
#pragma unroll
                        for (int n = 0; n < 2; ++n) v[bj][n] = v[bj][n] * g[bj][n] * r; }
#pragma unroll
                for (int bj = 0; bj < 2; ++bj)
                    __builtin_nontemporal_store((u32x4){cvt_pk_bf16(v[bj][0][0], v[bj][0][1]), cvt_pk_bf16(v[bj][0][2], v[bj][0][3]), cvt_pk_bf16(v[bj][1][0], v[bj][1][1]), cvt_pk_bf16(v[bj][1][2], v[bj][1][3])},
                                                (u32x4*)(O + (size_t)row * 3072 + colb + bj * 32));
            }
    }
};
struct EpiPle {
    static constexpr bool PERM = true, AFTER_DRAIN = false; static constexpr int NST = 32;
    const bf16_t* xold; float* out; const bf16_t* PP; const PG8_LAS float* rst;
    __device__ __forceinline__ void operator()(const f32x4 (&acc)[2][2][4][2], const Unit& u, int wr, int wc, int fr, int fq) const {
        const int row0 = u.pm * BM + wr * 64 + fr, colb = u.pn * BM + wc * 64 + 8 * fq;
#pragma unroll
        for (int ai = 0; ai < 2; ++ai)
#pragma unroll
            for (int m = 0; m < 4; ++m) {
                const int row = row0 + ai * HALF + m * 16; const float rs = rst[u.idx * 256 + wr * 64 + fr + ai * HALF + m * 16] * -1.4426950408889634f;
#pragma unroll
                for (int bj = 0; bj < 2; ++bj) { const size_t off = (size_t)row * 1024 + colb + bj * 32;
                    const u32x4 xw = *(const u32x4*)(xold + off); const u32x4 pw = *(const u32x4*)(PP + off); f32x4 o0, o1;
                    o0[0] = __uint_as_float(xw[0] << 16); o0[1] = __uint_as_float(xw[0] & 0xffff0000u); o0[2] = __uint_as_float(xw[1] << 16); o0[3] = __uint_as_float(xw[1] & 0xffff0000u);
                    o1[0] = __uint_as_float(xw[2] << 16); o1[1] = __uint_as_float(xw[2] & 0xffff0000u); o1[2] = __uint_as_float(xw[3] << 16); o1[3] = __uint_as_float(xw[3] & 0xffff0000u);
                    f32x4 p0, p1; p0[0] = __uint_as_float(pw[0] << 16); p0[1] = __uint_as_float(pw[0] & 0xffff0000u); p0[2] = __uint_as_float(pw[1] << 16); p0[3] = __uint_as_float(pw[1] & 0xffff0000u);
                    p1[0] = __uint_as_float(pw[2] << 16); p1[1] = __uint_as_float(pw[2] & 0xffff0000u); p1[2] = __uint_as_float(pw[3] << 16); p1[3] = __uint_as_float(pw[3] & 0xffff0000u);
                    f32x4 v0, v1;
#pragma unroll
                    for (int e = 0; e < 4; ++e) { v0[e] = o0[e] + __builtin_amdgcn_rcpf(1.0f + __builtin_amdgcn_exp2f(acc[ai][bj][m][0][e] * rs)) * p0[e];
                                                  v1[e] = o1[e] + __builtin_amdgcn_rcpf(1.0f + __builtin_amdgcn_exp2f(acc[ai][bj][m][1][e] * rs)) * p1[e]; }
                    *(f32x4*)(out + off) = v0; *(f32x4*)(out + off + 4) = v1; }
            }
    }
};
template <class Epi, class Sched, bool ALIGN_EPI = false, bool SP2 = false>
__device__ __forceinline__ void gemm_phase(PG8_LAS unsigned char* lds, const Gemm g, const Sched& S, const Epi& E, int wid) {
    const int lane = lane_now(), tid = wid * 64 + lane, wr = wid >> 2, wc = wid & 3, fr = lane & 15, fq = lane >> 4;
    const int K = g.K, nt = K / BK;
    unsigned voffA[2], voffB[2];
#pragma unroll
    for (int i = 0; i < 2; ++i) { int R, C; stage_rc(tid * 16 + i * 8192, R, C); const int Rb = Epi::PERM ? ((R & ~31) + perm32(R & 31)) : R;
        voffA[i] = (unsigned)(R * K + C) * 2u; voffB[i] = (unsigned)(Rb * K + C) * 2u; }
    const size_t kstep = (size_t)(BK * 2);
    const size_t hstep = (size_t)HALF * K * 2;
    const size_t tstep = 2 * hstep;
    const unsigned ldsw = (unsigned)wid * 1024u;
    const int aoff = lds_byte(wr * 64 + fr, fq * 8), boff = lds_byte(wc * 32 + fr, fq * 8);
#define PG8_SA(b, h) (((b) * 2 + (h)) * HTB)
#define PG8_SB(b, h) ((4 + (b) * 2 + (h)) * HTB)
#define PG8_STAGE(bufoff, gbase, voff) do { _Pragma("unroll") for (int _i = 0; _i < 2; ++_i) \
        __builtin_amdgcn_global_load_lds((const unsigned*)((const char*)(gbase) + (voff)[_i]), (PG8_LAS unsigned*)(lds + (bufoff) + ldsw + _i * 8192), 16, 0, 0); } while (0)
#define PG8_LDA(dst, b, h) do { _Pragma("unroll") for (int m = 0; m < 4; ++m) _Pragma("unroll") for (int k = 0; k < 2; ++k) dst[m][k] = *(const PG8_LAS bf16x8*)(lds + PG8_SA(b, h) + aoff + m * 2048 + k * 1024); } while (0)
#define PG8_LDB(dst, b, h) do { _Pragma("unroll") for (int n = 0; n < 2; ++n) _Pragma("unroll") for (int k = 0; k < 2; ++k) dst[n][k] = *(const PG8_LAS bf16x8*)(lds + PG8_SB(b, h) + boff + n * 2048 + k * 1024); } while (0)
#define PG8_MMA(ai, bj, At, Bt) do { __builtin_amdgcn_s_setprio(1); _Pragma("unroll") for (int m = 0; m < 4; ++m) _Pragma("unroll") for (int n = 0; n < 2; ++n) _Pragma("unroll") for (int k = 0; k < 2; ++k) \
        acc[ai][bj][m][n] = __builtin_amdgcn_mfma_f32_16x16x32_bf16(Bt[n][k], At[m][k], acc[ai][bj][m][n], 0, 0, 0); __builtin_amdgcn_s_setprio(0); } while (0)
#define PG8_WAIT_V(n) asm volatile("s_waitcnt vmcnt(" #n ")" ::: "memory")
#define PG8_WAIT_L(n) asm volatile("s_waitcnt lgkmcnt(" #n ")" ::: "memory")
#define PG8_WAIT_VR(n, rlx) asm volatile("s_waitcnt vmcnt(%0)\n\ts_cmp_lg_u32 %1, 0\n\ts_cbranch_scc1 .Lpg8w%=\n\ts_waitcnt vmcnt(8)\n.Lpg8w%=:" :: "n"(n), "s"(rlx) : "memory", "scc")
#define PG8_BAR __builtin_amdgcn_s_barrier()
#define PG8_SCHED __builtin_amdgcn_sched_barrier(0)
    Unit cur, nxt; int ui = 0;
    if (!S.next(0, cur)) return;
    f32x4 acc[2][2][4][2];
#pragma unroll
    for (int a = 0; a < 2; ++a)
#pragma unroll
        for (int b = 0; b < 2; ++b)
#pragma unroll
            for (int m = 0; m < 4; ++m)
#pragma unroll
                for (int n = 0; n < 2; ++n) acc[a][b][m][n] = (f32x4){0.f, 0.f, 0.f, 0.f};
    bf16x8 At[4][2], B0[2][2], B1[2][2];
    const char* cA = (const char*)g.A + (size_t)cur.pm * tstep; const char* cB = (const char*)g.Bt + (size_t)cur.pn * tstep;
    S.a_ready(cur);
    if constexpr (SP2) {
        PG8_STAGE(PG8_SB(0, 0), cB, voffB); PG8_STAGE(PG8_SB(0, 1), cB + hstep, voffB); PG8_STAGE(PG8_SA(0, 0), cA, voffA); PG8_STAGE(PG8_SA(0, 1), cA + hstep, voffA);
        if (wr == 1) PG8_BAR;
        PG8_WAIT_V(2); PG8_BAR;
        PG8_STAGE(PG8_SB(1, 0), cB + kstep, voffB); PG8_STAGE(PG8_SA(1, 0), cA + kstep, voffA); PG8_STAGE(PG8_SB(1, 1), cB + hstep + kstep, voffB);
        PG8_WAIT_V(6); PG8_BAR;
    } else {
        PG8_STAGE(PG8_SB(0, 0), cB, voffB); PG8_STAGE(PG8_SA(0, 0), cA, voffA); PG8_STAGE(PG8_SB(0, 1), cB + hstep, voffB); PG8_STAGE(PG8_SA(0, 1), cA + hstep, voffA);
        if (wr == 1) PG8_BAR;
        PG8_WAIT_V(4); PG8_BAR;
        PG8_STAGE(PG8_SB(1, 0), cB + kstep, voffB); PG8_STAGE(PG8_SA(1, 0), cA + kstep, voffA); PG8_STAGE(PG8_SB(1, 1), cB + hstep + kstep, voffB);
        PG8_WAIT_V(6); PG8_BAR;
    }
    for (;;) {
        const bool has_next = S.next(ui + 1, nxt);
        const char* nA = has_next ? (const char*)g.A + (size_t)nxt.pm * tstep : cA; const char* nB = has_next ? (const char*)g.Bt + (size_t)nxt.pn * tstep : cB;
        for (int t = 0; t < nt; t += 2) {
            const bool last = (t == nt - 2);
            const int relax = __builtin_amdgcn_readfirstlane(((t == 0) && (ui > 0)) ? 1 : 0);
            const char* a1 = cA + (size_t)(t + 1) * kstep;
            const char* a2 = last ? nA : cA + (size_t)(t + 2) * kstep; const char* b2 = last ? nB : cB + (size_t)(t + 2) * kstep;
            const char* a3 = a2 + kstep; const char* b3 = b2 + kstep;
            if (last && has_next) S.a_ready(nxt);
            if constexpr (SP2) {
            PG8_LDB(B0, 0, 0); PG8_LDB(B1, 0, 1); PG8_SCHED; PG8_LDA(At, 0, 0); PG8_STAGE(PG8_SA(1, 1), a1 + hstep, voffA);
            PG8_WAIT_VR(8 + Epi::NST, relax); PG8_WAIT_L(0); PG8_BAR; PG8_MMA(0, 0, At, B0); PG8_MMA(0, 1, At, B1); PG8_BAR; PG8_SCHED;
            PG8_LDA(At, 0, 1); PG8_STAGE(PG8_SB(0, 0), b2, voffB); PG8_STAGE(PG8_SB(0, 1), b2 + hstep, voffB); PG8_STAGE(PG8_SA(0, 0), a2, voffA);
            PG8_WAIT_VR(8 + Epi::NST, relax); PG8_WAIT_L(0); PG8_BAR; PG8_MMA(1, 0, At, B0); PG8_MMA(1, 1, At, B1); PG8_BAR; PG8_SCHED;
            PG8_LDB(B0, 1, 0); PG8_LDB(B1, 1, 1); PG8_SCHED; PG8_LDA(At, 1, 0); PG8_STAGE(PG8_SA(0, 1), a2 + hstep, voffA);
            PG8_WAIT_V(8); PG8_WAIT_L(0); PG8_BAR; PG8_MMA(0, 0, At, B0); PG8_MMA(0, 1, At, B1); PG8_BAR; PG8_SCHED;
            PG8_LDA(At, 1, 1); PG8_STAGE(PG8_SB(1, 0), b3, voffB); PG8_STAGE(PG8_SB(1, 1), b3 + hstep, voffB); PG8_STAGE(PG8_SA(1, 0), a3, voffA);
            PG8_WAIT_V(8); PG8_WAIT_L(0); PG8_BAR; PG8_MMA(1, 0, At, B0); PG8_MMA(1, 1, At, B1); PG8_BAR; PG8_SCHED;
            } else {
            PG8_LDB(B0, 0, 0); PG8_SCHED; PG8_LDA(At, 0, 0); PG8_STAGE(PG8_SA(1, 1), a1 + hstep, voffA);
            PG8_WAIT_L(8); PG8_BAR; PG8_WAIT_L(0); PG8_MMA(0, 0, At, B0); PG8_BAR; PG8_SCHED;
            PG8_LDB(B1, 0, 1); PG8_STAGE(PG8_SB(0, 0), b2, voffB);
            PG8_BAR; PG8_WAIT_L(0); PG8_MMA(0, 1, At, B1); PG8_BAR;
            PG8_LDA(At, 0, 1); PG8_STAGE(PG8_SA(0, 0), a2, voffA);
            PG8_BAR; PG8_WAIT_L(0); PG8_MMA(1, 0, At, B0); PG8_BAR; PG8_SCHED;
            PG8_STAGE(PG8_SB(0, 1), b2 + hstep, voffB);
            PG8_WAIT_V(6); PG8_BAR; PG8_MMA(1, 1, At, B1); PG8_BAR;
            PG8_LDB(B0, 1, 0); PG8_SCHED; PG8_LDA(At, 1, 0); PG8_STAGE(PG8_SA(0, 1), a2 + hstep, voffA);
            PG8_WAIT_L(8); PG8_BAR; PG8_WAIT_L(0); PG8_MMA(0, 0, At, B0); PG8_BAR; PG8_SCHED;
            PG8_LDB(B1, 1, 1); PG8_STAGE(PG8_SB(1, 0), b3, voffB);
            PG8_BAR; PG8_WAIT_L(0); PG8_MMA(0, 1, At, B1); PG8_BAR;
            PG8_LDA(At, 1, 1); PG8_STAGE(PG8_SA(1, 0), a3, voffA);
            PG8_BAR; PG8_WAIT_L(0); PG8_MMA(1, 0, At, B0); PG8_BAR; PG8_SCHED;
            PG8_STAGE(PG8_SB(1, 1), b3 + hstep, voffB);
            PG8_WAIT_V(6); PG8_BAR; PG8_MMA(1, 1, At, B1); PG8_BAR;
            }
        }
        if constexpr (ALIGN_EPI) { if (wr == 0) PG8_BAR; }
        if constexpr (!Epi::AFTER_DRAIN) { const int ln_ = (int)__builtin_amdgcn_mbcnt_hi(~0u, __builtin_amdgcn_mbcnt_lo(~0u, 0u)); E(acc, cur, wr, wc, ln_ & 15, ln_ >> 4); S.done(cur); }
        if (!has_next) break;
#pragma unroll
        for (int a = 0; a < 2; ++a)
#pragma unroll
            for (int b = 0; b < 2; ++b)
#pragma unroll
                for (int m = 0; m < 4; ++m)
#pragma unroll
                    for (int n = 0; n < 2; ++n) acc[a][b][m][n] = (f32x4){0.f, 0.f, 0.f, 0.f};
        cur = nxt; cA = nA; cB = nB; ++ui;
        if constexpr (ALIGN_EPI) { if (wr == 1) PG8_BAR; }
    }
    PG8_WAIT_V(0);
    if constexpr (!ALIGN_EPI) { if (wr == 0) PG8_BAR; }
    PG8_BAR;
    if constexpr (Epi::AFTER_DRAIN) { E.fused(acc, cur, wr, wc, fr, fq, lds, wid, lane); S.done(cur); }
#undef PG8_SA
#undef PG8_SB
#undef PG8_STAGE
#undef PG8_LDA
#undef PG8_LDB
#undef PG8_MMA
#undef PG8_WAIT_V
#undef PG8_WAIT_L
#undef PG8_WAIT_VR
#undef PG8_BAR
#undef PG8_SCHED
}
}

constexpr int NWAVES = 8;
constexpr int BATCH = 4, SEQ = 8192, D = 1024, FF = 2816, NPROJ = 3072, PLE = 256, NH = 8, HD = 64, CONVD = 512;
constexpr int M = BATCH * SEQ;
#ifndef PROBE_DUP
#define PROBE_DUP 0
#endif
#ifndef MK_ONE_LAUNCH
#define MK_ONE_LAUNCH 1
#endif
constexpr int N_PHASES = 10;
constexpr size_t MiB = 1u << 20;
constexpr size_t WS_CTL = 0, CTL_ZERO_BYTES = 1 * MiB;
constexpr size_t WS_W1GU = 2 * MiB, WS_W1D = 13 * MiB, WS_WIN = 19 * MiB, WS_WOUT = 25 * MiB, WS_W2GU = 27 * MiB, WS_W2D = 38 * MiB, WS_WPG = 44 * MiB, WS_WPP = 46 * MiB;
constexpr size_t WS_XB = 48 * MiB;
constexpr size_t WS_PB = 112 * MiB;
constexpr size_t WS_HID = 128 * MiB;
constexpr size_t WS_YMIX = 320 * MiB;
constexpr size_t WS_PP = 384 * MiB;
constexpr size_t WS_END = 448 * MiB;
#ifndef ATTN_NAIVE
#define ATTN_NAIVE 0
#endif
constexpr float QSC = ATTN_NAIVE ? 0.125f : 0.125f * 1.4426950408889634f;
constexpr int LDS_BYTES = 147456;

#define GAS __attribute__((address_space(1)))
#define LAS __attribute__((address_space(3)))
typedef unsigned short bf16;
typedef unsigned v4u __attribute__((ext_vector_type(4)));
typedef float f32x4 __attribute__((ext_vector_type(4)));
#define LDS_WAIT() asm volatile("s_waitcnt lgkmcnt(0)" ::: "memory")
__device__ __forceinline__ unsigned pk2(float lo, float hi) { return pg8::cvt_pk_bf16(lo, hi); }
__device__ __forceinline__ float bflo(unsigned w) { return __uint_as_float(w << 16); }
__device__ __forceinline__ float bfhi(unsigned w) { return __uint_as_float(w & 0xffff0000u); }
__device__ __forceinline__ float wave_sum(float v) {
#pragma unroll
    for (int o = 1; o < 64; o <<= 1) v += __shfl_xor(v, o);
    return v;
}

#define XB_TMO      128
#define XB_XCNT(j)  (256  + 64 * (j))
#define XB_XSUB(j)  (1280 + 64 * (j))
#define XB_XGEN(j)  (2304 + 64 * (j))
#define XB_TOP      3328
#define XB_TOPGEN   3392
#define XCD_BAR_WORDS 3456
#define XB_SPIN_CAP (1u << 18)

__device__ __forceinline__ unsigned xb_ld(unsigned* p)              { return __hip_atomic_load(p, __ATOMIC_RELAXED, __HIP_MEMORY_SCOPE_AGENT); }
__device__ __forceinline__ unsigned xb_add(unsigned* p, unsigned v) { return __hip_atomic_fetch_add(p, v, __ATOMIC_RELAXED, __HIP_MEMORY_SCOPE_AGENT); }
__device__ __forceinline__ unsigned xb_xcc_id() { return (unsigned)__builtin_amdgcn_s_getreg((3 << 11) | 20) & 0xFu; }
#define XB_SPIN(cond, bar) do { unsigned _sp = 0; while (cond) { __builtin_amdgcn_s_sleep(1); \
    if ((++_sp & 255u) == 0u) { if (xb_ld(&(bar)[XB_TMO])) break; if (_sp > XB_SPIN_CAP) { atomicAdd(&(bar)[XB_TMO], 1u); break; } } } } while (0)

struct XcdBarrier {
    unsigned* bar; unsigned x;
    volatile LAS unsigned* st;
};

__device__ __forceinline__ XcdBarrier xcd_barrier_post(unsigned* bar, volatile LAS unsigned* st) {
    XcdBarrier b; b.bar = bar; b.x = xb_xcc_id(); b.st = st;
    if (threadIdx.x == 0) (void)xb_add(&bar[XB_XCNT(b.x)], 1u);
    return b;
}
__device__ __forceinline__ void xcd_barrier_complete(unsigned* bar, unsigned x, unsigned& nloc, unsigned& nx) {
    const unsigned G = gridDim.x * gridDim.y * gridDim.z;
    unsigned sum, cnt, mine, sp = 0u;
    for (;;) {
        sum = 0u; cnt = 0u; mine = 0u;
#pragma unroll
        for (unsigned j = 0; j < 16; ++j) { const unsigned c = xb_ld(&bar[XB_XCNT(j)]); sum += c; cnt += (c > 0u) ? 1u : 0u; mine = (j == x) ? c : mine; }
        if (sum == G) break;
        __builtin_amdgcn_s_sleep(1);
        if ((++sp & 255u) == 0u) { if (xb_ld(&bar[XB_TMO])) break; if (sp > XB_SPIN_CAP) { atomicAdd(&bar[XB_TMO], 1u); break; } }
    }
    nloc = mine > 0u ? mine : 1u; nx = cnt > 0u ? cnt : 1u;
}

__device__ __forceinline__ void xcd_barrier(const XcdBarrier& b, int wave) {
    asm volatile("s_waitcnt vmcnt(0)" ::: "memory");
    __syncthreads();
    if (wave == 0 && lane_now() == 0) {
        unsigned* bar = b.bar;
        __builtin_amdgcn_s_waitcnt(0);
        unsigned nloc = b.st[0], nx = b.st[1];
        if (nloc == 0u) { xcd_barrier_complete(bar, b.x, nloc, nx); b.st[0] = nloc; b.st[1] = nx; }
        const unsigned old = xb_add(&bar[XB_XSUB(b.x)], 1u);
        const unsigned gen = old / nloc;
        if (old + 1u == (gen + 1u) * nloc) {
            __builtin_amdgcn_fence(__ATOMIC_RELEASE, "agent");
            asm volatile("s_waitcnt vmcnt(0)" ::: "memory");
            const unsigned og = xb_add(&bar[XB_TOP], 1u);
            const unsigned tg = og / nx;
            if (og + 1u == (tg + 1u) * nx) xb_add(&bar[XB_TOPGEN], 1u);
            else XB_SPIN(xb_ld(&bar[XB_TOPGEN]) == tg, bar);
            __builtin_amdgcn_fence(__ATOMIC_ACQUIRE, "agent");
            xb_add(&bar[XB_XGEN(b.x)], 1u);
            asm volatile("s_waitcnt vmcnt(0)" ::: "memory");
        } else {
            XB_SPIN(xb_ld(&bar[XB_XGEN(b.x)]) == gen, bar);
            __builtin_amdgcn_fence(__ATOMIC_ACQUIRE, "agent");
            asm volatile("s_waitcnt vmcnt(0)" ::: "memory");
        }
    }
    __syncthreads();
}

constexpr size_t WS_BAR = 768 * 1024;
__device__ unsigned g_bar[XCD_BAR_WORDS + 64];
struct Args { const float* in[20]; float* out; unsigned char* ws; int ph_lo, ph_hi; };

__device__ __forceinline__ void tr_item(const float* __restrict__ W, int K, int N, const float* __restrict__ gain, bf16* __restrict__ WT, int dst_row0, LAS float* scr, int k0, int n0, int lane) {
    float w[32]; const float* wp = W + (size_t)(k0 + (lane >> 5)) * N + n0 + (lane & 31);
#pragma unroll
    for (int i = 0; i < 32; ++i) w[i] = __builtin_nontemporal_load(wp + (size_t)(2 * i) * N);
    if (gain) {
#pragma unroll
        for (int i = 0; i < 32; ++i) w[i] *= gain[k0 + 2 * i + (lane >> 5)];
    }
#pragma unroll
    for (int i = 0; i < 32; ++i) scr[(2 * i + (lane >> 5)) * 33 + (lane & 31)] = w[i];
    LDS_WAIT(); asm volatile("" ::: "memory");
    const int c = lane & 7;
#pragma unroll
    for (int j = 0; j < 4; ++j) { const int n = (lane >> 3) + 8 * j; const LAS float* s = scr + (8 * c) * 33 + n;
        v4u o; o.x = pk2(s[0 * 33], s[1 * 33]); o.y = pk2(s[2 * 33], s[3 * 33]); o.z = pk2(s[4 * 33], s[5 * 33]); o.w = pk2(s[6 * 33], s[7 * 33]);
        *(v4u*)(WT + (size_t)(dst_row0 + n) * K + k0 + 8 * c) = o; }
    LDS_WAIT(); asm volatile("" ::: "memory");
}
__device__ __forceinline__ bool tr_matrix(int& r, const float* W, int K, int N, const float* gain, bf16* WT, int mode, LAS float* scr, int lane) {
    const int nblk = N / 32, items = (K / 64) * nblk;
    if (r >= items) { r -= items; return false; }
    const int kb = r / nblk, nb = r % nblk, n0 = 32 * nb;
    int dst;
    if (mode == 4 && n0 >= 512 && n0 < 1536) { const int ch = (n0 - 512) & 511; dst = 256 * (2 + (ch >> 7)) + (n0 >= 1024 ? 128 : 0) + (ch & 127); }
    else if (mode >= 3) dst = 256 * (n0 >> 8) + 128 * ((n0 >> 5) & 1) + 32 * ((n0 >> 6) & 3);
    else dst = 256 * (n0 >> 7) + (n0 & 127) + (mode == 2 ? 128 : 0);
    tr_item(W, K, N, gain, WT, dst, scr, 64 * kb, n0, lane);
    return true;
}
__device__ __forceinline__ void p0_prep(const Args& a, LAS unsigned char* lds, int gw, int NGW, int lane, int wave) {
    unsigned char* ws = a.ws;
    LAS float* scr = (LAS float*)(lds + wave * 16384);
    constexpr int I_GU = (D / 64) * (FF / 32), I_DN = (FF / 64) * (D / 32), I_IN = (D / 64) * (NPROJ / 32), I_SQ = (D / 64) * (D / 32), I_PP = (PLE / 64) * (D / 32);
    constexpr int NITEMS = 4 * I_GU + 2 * I_DN + I_IN + 2 * I_SQ + I_PP;
    for (int it = gw; it < NITEMS; it += NGW) {
        int r = it;
        if (tr_matrix(r, a.in[3], D, FF, a.in[2], (bf16*)(ws + WS_W1GU), 1, scr, lane)) continue;
        if (tr_matrix(r, a.in[4], D, FF, a.in[2], (bf16*)(ws + WS_W1GU), 2, scr, lane)) continue;
        if (tr_matrix(r, a.in[14], D, FF, a.in[13], (bf16*)(ws + WS_W2GU), 1, scr, lane)) continue;
        if (tr_matrix(r, a.in[15], D, FF, a.in[13], (bf16*)(ws + WS_W2GU), 2, scr, lane)) continue;
        if (tr_matrix(r, a.in[5], FF, D, nullptr, (bf16*)(ws + WS_W1D), 3, scr, lane)) continue;
        if (tr_matrix(r, a.in[16], FF, D, nullptr, (bf16*)(ws + WS_W2D), 3, scr, lane)) continue;
        if (tr_matrix(r, a.in[7], D, NPROJ, a.in[6], (bf16*)(ws + WS_WIN), 4, scr, lane)) continue;
        if (tr_matrix(r, a.in[12], D, D, nullptr, (bf16*)(ws + WS_WOUT), 3, scr, lane)) continue;
        if (tr_matrix(r, a.in[18], D, D, a.in[17], (bf16*)(ws + WS_WPG), 3, scr, lane)) continue;
        tr_matrix(r, a.in[19], PLE, D, nullptr, (bf16*)(ws + WS_WPP), 3, scr, lane);
    }
    const float* __restrict__ x = a.in[0]; bf16* __restrict__ XB = (bf16*)(ws + WS_XB); float* __restrict__ ss1 = (float*)(ws + WS_CTL);
    for (int m0 = gw * 8; m0 < M; m0 += NGW * 8) {
        f32x4 v[8][4];
#pragma unroll
        for (int r = 0; r < 8; ++r)
#pragma unroll
            for (int j = 0; j < 4; ++j) v[r][j] = __builtin_nontemporal_load((const f32x4*)(x + (size_t)(m0 + r) * D) + lane + 64 * j);
#pragma unroll
        for (int r = 0; r < 8; ++r) { float s = 0.f;
#pragma unroll
            for (int j = 0; j < 4; ++j) s += (v[r][j].x * v[r][j].x + v[r][j].y * v[r][j].y) + (v[r][j].z * v[r][j].z + v[r][j].w * v[r][j].w);
            s = wave_sum(s);
            unsigned long long* o8 = (unsigned long long*)(XB + (size_t)(m0 + r) * D) + lane;
#pragma unroll
            for (int j = 0; j < 4; ++j) o8[64 * j] = (unsigned long long)pk2(v[r][j].x, v[r][j].y) | ((unsigned long long)pk2(v[r][j].z, v[r][j].w) << 32);
            if (lane == 0) ss1[m0 + r] = s; }
    }
    for (int i = gw * 64 + lane; i < 3 * M; i += NGW * 64) ss1[M + i] = 0.f;
    const float* __restrict__ p = a.in[1]; bf16* __restrict__ PB = (bf16*)(ws + WS_PB);
    for (int i0 = gw * 64 + lane; i0 < M * PLE / 8; i0 += NGW * 64 * 4) {
        f32x4 v0[4], v1[4];
#pragma unroll
        for (int r = 0; r < 4; ++r) { const size_t i = (size_t)i0 + (size_t)r * NGW * 64; v0[r] = __builtin_nontemporal_load((const f32x4*)(p + i * 8)); v1[r] = __builtin_nontemporal_load((const f32x4*)(p + i * 8 + 4)); }
#pragma unroll
        for (int r = 0; r < 4; ++r) { const size_t i = (size_t)i0 + (size_t)r * NGW * 64; *(v4u*)(PB + i * 8) = (v4u){pk2(v0[r].x, v0[r].y), pk2(v0[r].z, v0[r].w), pk2(v1[r].x, v1[r].y), pk2(v1[r].z, v1[r].w)}; }
    }
}

__device__ __forceinline__ void unpack8(const v4u w, float (&f)[8]) { f[0] = bflo(w.x); f[1] = bfhi(w.x); f[2] = bflo(w.y); f[3] = bfhi(w.y); f[4] = bflo(w.z); f[5] = bfhi(w.z); f[6] = bflo(w.w); f[7] = bfhi(w.w); }
__device__ __forceinline__ v4u pack8(const float (&f)[8]) { return (v4u){pk2(f[0], f[1]), pk2(f[2], f[3]), pk2(f[4], f[5]), pk2(f[6], f[7])}; }
__device__ __forceinline__ void conv_phase(const Args& a, int gw, int NGW, int lane) {
    const bf16* __restrict__ PROJ = (const bf16*)(a.ws + WS_HID); bf16* __restrict__ YMIX = (bf16*)(a.ws + WS_YMIX);
    const float* cw = a.in[8]; const float* cbp = a.in[9];
    float w0[8], w1[8], w2[8], cb[8];
#pragma unroll
    for (int i = 0; i < 8; ++i) { w0[i] = cw[8 * lane + i]; w1[i] = cw[CONVD + 8 * lane + i]; w2[i] = cw[2 * CONVD + 8 * lane + i]; cb[i] = cbp[8 * lane + i]; }
    for (int ch = gw; ch < M / 16; ch += NGW) {
        const int r0 = ch * 16; const bool first = (r0 & (SEQ - 1)) == 0;
        const bf16* pr = PROJ + (size_t)r0 * NPROJ + 8 * lane;
        float z1[8], z2[8];
        { const bf16* q2 = pr - (first ? 0 : 2 * NPROJ); const bf16* q1 = pr - (first ? 0 : NPROJ);
          float c[8]; unpack8(*(const v4u*)(q2 + 512), c);
#pragma unroll
          for (int i = 0; i < 8; ++i) z2[i] = first ? 0.f : c[i];
          unpack8(*(const v4u*)(q1 + 512), c);
#pragma unroll
          for (int i = 0; i < 8; ++i) z1[i] = first ? 0.f : c[i]; }
#pragma unroll 1
        for (int s4 = 0; s4 < 4; ++s4) {
            const bf16* ps = pr + (size_t)(4 * s4) * NPROJ;
            v4u bw[4], cwv[4];
#pragma unroll
            for (int r = 0; r < 4; ++r) { bw[r] = *(const v4u*)(ps + (size_t)r * NPROJ); cwv[r] = *(const v4u*)(ps + (size_t)r * NPROJ + 512); }
#pragma unroll
            for (int r = 0; r < 4; ++r) { float b[8], c[8], y[8]; unpack8(bw[r], b); unpack8(cwv[r], c);
#pragma unroll
                for (int i = 0; i < 8; ++i) { const float z0 = c[i]; y[i] = b[i] * (w0[i] * z2[i] + w1[i] * z1[i] + w2[i] * z0 + cb[i]); z2[i] = z1[i]; z1[i] = z0; }
                *(v4u*)(YMIX + (size_t)(r0 + 4 * s4 + r) * D + 8 * lane) = pack8(y); }
        }
    }
}

__device__ __forceinline__ void p5_attn_naive(const Args& a, int tid) {
    const bf16* PROJ = (const bf16*)(a.ws + WS_HID); bf16* YMIX = (bf16*)(a.ws + WS_YMIX);
    for (int un = blockIdx.x; un < 512; un += gridDim.x) {
        const int bh = un & 31, r = un >> 5, qq = r < 8 ? r : 23 - r, b = bh >> 3, h = bh & 7;
        const int t = qq * 512 + tid;
        const bf16* base = PROJ + (size_t)b * SEQ * NPROJ + h * HD;
        float q[64], o[64];
#pragma unroll
        for (int c = 0; c < 8; ++c) { float f[8]; unpack8(*(const v4u*)(base + (size_t)t * NPROJ + 1536 + 8 * c), f);
#pragma unroll
            for (int e = 0; e < 8; ++e) { q[8 * c + e] = f[e]; o[8 * c + e] = 0.f; } }
        float carry = 0.f;
        for (int j = qq * 512 + 511; j >= 0; --j) {
            const bf16* kr = base + (size_t)j * NPROJ + 2048; float z = 0.f;
#pragma unroll
            for (int c = 0; c < 8; ++c) { float f[8]; unpack8(*(const v4u*)(kr + 8 * c), f);
#pragma unroll
                for (int e = 0; e < 8; ++e) z += q[8 * c + e] * f[e]; }
            const bool act = j < t;
            const float sp = fmaxf(z, 0.f) + __logf(1.0f + __expf(-fabsf(z)));
            const float av = act ? __expf(z - sp + carry) : 0.f;
            carry -= act ? sp : 0.f;
            const bf16* vr = kr + 512;
#pragma unroll
            for (int c = 0; c < 8; ++c) { float f[8]; unpack8(*(const v4u*)(vr + 8 * c), f);
#pragma unroll
                for (int e = 0; e < 8; ++e) o[8 * c + e] += av * f[e]; }
        }
        bf16* orow = YMIX + (size_t)(b * SEQ + t) * D + 512 + h * HD;
#pragma unroll
        for (int c = 0; c < 8; ++c) { float f[8];
#pragma unroll
            for (int e = 0; e < 8; ++e) f[e] = o[8 * c + e];
            *(v4u*)(orow + 8 * c) = pack8(f); }
    }
}

namespace sba {
using bf16x8 = __attribute__((ext_vector_type(8))) short;
using s16x4 = __attribute__((ext_vector_type(4))) short;
using f32x16 = __attribute__((ext_vector_type(16))) float;
typedef short v4i16_t __attribute__((ext_vector_type(4)));
typedef float f32x2_t __attribute__((ext_vector_type(2))); typedef __bf16 bf16x2_t __attribute__((ext_vector_type(2)));
typedef __attribute__((address_space(3))) const char* lds_cptr;
constexpr int SLOTB = 8192, LDS_K = 0, LDS_V = 3 * SLOTB, LDS_FLG = 6 * SLOTB, LDS_OST = 65536;
constexpr float CARRY_DEAD = 1e-30f;
__device__ __forceinline__ void glds16(const void* gbase, unsigned voff, unsigned lds_dst) { unsigned keep;
    asm volatile("s_mov_b32 %0, m0\n\ts_mov_b32 m0, %3\n\ts_nop 0\n\tglobal_load_lds_dwordx4 %1, %2\n\ts_mov_b32 m0, %0" : "=&s"(keep) : "v"(voff), "s"(gbase), "s"(lds_dst) : "memory"); }
__device__ __forceinline__ unsigned cvtpk_s(float lo, float hi) { f32x2_t v = {lo, hi}; bf16x2_t b = __builtin_convertvector(v, bf16x2_t); return __builtin_bit_cast(unsigned, b); }
__device__ __forceinline__ s16x4 vtr(lds_cptr p) { return __builtin_bit_cast(s16x4, __builtin_amdgcn_ds_read_tr16_b64_v4i16((__attribute__((address_space(3))) v4i16_t*)p)); }
#define SBA_MFMA(a, b, c) __builtin_amdgcn_mfma_f32_32x32x16_bf16((a), (b), (c), 0, 0, 0)

#define SBA_WAIT_BAR() asm volatile("s_waitcnt vmcnt(0) lgkmcnt(0)\n\ts_barrier" ::: "memory")
#define SBA_SBAR() do {} while (0)
struct Ctx { const unsigned short* Kh; unsigned koff, voff; unsigned kdst, vdst;     lds_cptr kp0, vp0; __attribute__((address_space(3))) unsigned* flg; int NT, qrel, hi, wid, lane; int s_cur, s_nxt, s_nn; int walive; };
__device__ __forceinline__ void band_mask(f32x16& p0, f32x16& p1, int jb, int qrel, int hi) {
    const int kb = 64 * jb + 4 * hi;
#pragma unroll
    for (int r = 0; r < 16; ++r) { const int kv = kb + (r & 3) + 8 * (r >> 2); if (kv >= qrel) p0[r] = -INFINITY; if (kv + 32 >= qrel) p1[r] = -INFINITY; }
}
__device__ __forceinline__ bool step(Ctx& c, int t, const f32x16& PC0, const f32x16& PC1, f32x16& PN0, f32x16& PN1, f32x16 (&o)[2], const bf16x8 (&qr)[4], float& carry) {
    SBA_WAIT_BAR();
    if (t < c.NT - 1) {
        const __attribute__((address_space(3))) v4u* f = (const __attribute__((address_space(3))) v4u*)(c.flg + ((t + 1) & 1) * 8); const v4u f0 = f[0], f1 = f[1];
        if (((f0.x | f0.y) | (f0.z | f0.w) | (f1.x | f1.y) | (f1.z | f1.w)) == 0u) return false;
    }
    if (t >= 2) { const unsigned short* tb = c.Kh + (size_t)(t - 2) * 64 * NPROJ; glds16(tb, c.koff, (unsigned)__builtin_amdgcn_readfirstlane(c.kdst + c.s_nn)); glds16(tb, c.voff, (unsigned)__builtin_amdgcn_readfirstlane(c.vdst + c.s_nn)); }
    const bool qk = c.walive != 0;
    const bool act = qk && !(t >= c.NT - 4 && (t - (c.NT - 4)) > (c.wid >> 1));
    bf16x8 kf[8]; s16x4 vlo[8], vhi[8];
    const lds_cptr kp = c.kp0 + c.s_nxt; const lds_cptr vp = c.vp0 + c.s_cur;
#define SBA_LDK(d0) do { kf[2 * (d0)] = *(const __attribute__((address_space(3))) bf16x8*)(kp + (d0) * 2048); kf[2 * (d0) + 1] = *(const __attribute__((address_space(3))) bf16x8*)(kp + (d0) * 2048 + 512); } while (0)
#define SBA_LDV(i) do { vlo[i] = vtr(vp + ((i) >> 2) * 4096 + ((i) & 3) * 1024); vhi[i] = vtr(vp + ((i) >> 2) * 4096 + ((i) & 3) * 1024 + 512); } while (0)
    if (qk) SBA_LDK(0);
    const f32x16 zero16 = f32x16{};
    float st = carry; unsigned pw[4][4];
#define VFR(i) ((bf16x8){vlo[i][0], vlo[i][1], vlo[i][2], vlo[i][3], vhi[i][0], vhi[i][1], vhi[i][2], vhi[i][3]})
#define PAF(ks) __builtin_bit_cast(bf16x8, (v4u){pw[ks][0], pw[ks][1], pw[ks][2], pw[ks][3]})
#pragma unroll
    for (int jj = 0; jj < 4; ++jj) {
        const int ks = 3 - jj, p = ks >> 1;
        SBA_SBAR();
        if (qk) { if (jj < 3) SBA_LDK(jj + 1);
            PN0 = SBA_MFMA(kf[2 * jj], qr[jj], jj ? PN0 : zero16); PN1 = SBA_MFMA(kf[2 * jj + 1], qr[jj], jj ? PN1 : zero16); }
        if (act) {
            SBA_LDV(ks); SBA_LDV(4 + ks);
            if (jj >= 1) { o[0] = SBA_MFMA(PAF(ks + 1), VFR(ks + 1), o[0]); o[1] = SBA_MFMA(PAF(ks + 1), VFR(4 + ks + 1), o[1]); }
            float a8[8];
#pragma unroll
            for (int gi = 0; gi < 2; ++gi) {
                const int g = 2 * (ks & 1) + 1 - gi; float k4[4];
#pragma unroll
                for (int e = 0; e < 4; ++e) { const float z = p ? PC1[4 * g + e] : PC0[4 * g + e]; k4[e] = __builtin_amdgcn_rcpf(1.0f + __builtin_amdgcn_exp2f(z)); }
                const float r3 = k4[3], r2 = r3 * k4[2], r1 = r2 * k4[1], G = r1 * k4[0];
                const auto rr = __builtin_amdgcn_permlane32_swap(__float_as_uint(G), __float_as_uint(G), false, false);
                const float Glo = __uint_as_float(rr[0]), Ghi = __uint_as_float(rr[1]);
                const float base = st * (c.hi ? 1.0f : Ghi);
                a8[4 * (1 - gi) + 3] = base * (1.0f - r3); a8[4 * (1 - gi) + 2] = base * (r3 - r2); a8[4 * (1 - gi) + 1] = base * (r2 - r1); a8[4 * (1 - gi)] = base * (r1 - G);
                st = st * (Glo * Ghi);
            }
#pragma unroll
            for (int i = 0; i < 4; ++i) pw[ks][i] = cvtpk_s(a8[2 * i], a8[2 * i + 1]);
        }
    }
    SBA_SBAR();
    if (act) {
        o[0] = SBA_MFMA(PAF(0), VFR(0), o[0]); o[1] = SBA_MFMA(PAF(0), VFR(4), o[1]);
        carry = st;
        const unsigned long long alive = __ballot(st > CARRY_DEAD); c.walive = alive ? 1 : 0;
    }
#undef VFR
#undef PAF
#undef SBA_LDK
#undef SBA_LDV
    if (c.lane == 0) c.flg[(t & 1) * 8 + c.wid] = (unsigned)c.walive;
    if (qk && t - 1 >= c.NT - 4) band_mask(PN0, PN1, t - 1 - (c.NT - 4), c.qrel, c.hi);
    { const int s = c.s_cur; c.s_cur = c.s_nxt; c.s_nxt = c.s_nn; c.s_nn = s; }
    return true;
}
__device__ __forceinline__ void unit(int b, int hd, int qb, const unsigned short* PROJ, unsigned short* YMIX, char* shm, int wid) {
    const int lane = lane_now(), r32 = lane & 31, hi = lane >> 5;
    const size_t rowbase = (size_t)b * SEQ; const int q0 = qb * 256;
    const unsigned short* Qw = PROJ + (rowbase + q0 + wid * 32) * NPROJ + 1536 + hd * 64;
    const unsigned short* Kh = PROJ + rowbase * NPROJ + 2048 + hd * 64; const unsigned short* Vh = Kh + 512;
    const unsigned lds0 = (unsigned)(uintptr_t)shm;
    const lds_cptr shm3 = (lds_cptr)shm;
    Ctx c;
    c.Kh = Kh;
    c.koff = (unsigned)(lane * NPROJ + wid * 8) * 2u;
    c.voff = (unsigned)((16 * (wid & 3) + (lane >> 2)) * NPROJ + 512 + (wid >> 2) * 32 + (lane & 3) * 8) * 2u;
    c.kdst = lds0 + LDS_K + wid * 1024; c.vdst = lds0 + LDS_V + wid * 1024;
    c.kp0 = shm3 + LDS_K + hi * 1024 + r32 * 16;
    c.vp0 = shm3 + LDS_V + ((lane >> 4) & 1) * 32 + (lane & 3) * 8 + (4 * hi + ((lane & 15) >> 2)) * 64;
    c.flg = (__attribute__((address_space(3))) unsigned*)(shm3 + LDS_FLG); c.wid = wid; c.lane = lane;
    c.NT = 4 * (qb + 1); c.qrel = wid * 32 + r32; c.hi = hi; c.s_cur = 0; c.s_nxt = SLOTB; c.s_nn = 2 * SLOTB; c.walive = 1;
    const int NT = c.NT;
    asm volatile("s_waitcnt lgkmcnt(0)\n\ts_barrier" ::: "memory");
    { const unsigned short* t1 = Kh + (size_t)(NT - 1) * 64 * NPROJ; const unsigned short* t2 = Kh + (size_t)(NT - 2) * 64 * NPROJ;
      glds16(t1, c.koff, (unsigned)__builtin_amdgcn_readfirstlane(c.kdst)); glds16(t1, c.voff, (unsigned)__builtin_amdgcn_readfirstlane(c.vdst));
      glds16(t2, c.koff, (unsigned)__builtin_amdgcn_readfirstlane(c.kdst + SLOTB)); glds16(t2, c.voff, (unsigned)__builtin_amdgcn_readfirstlane(c.vdst + SLOTB)); }
    bf16x8 qr[4];
#pragma unroll
    for (int d0 = 0; d0 < 4; ++d0) qr[d0] = *reinterpret_cast<const bf16x8*>(&Qw[(size_t)r32 * NPROJ + d0 * 16 + hi * 8]);
    f32x16 o[2]; o[0] = f32x16{}; o[1] = f32x16{};
    float carry = 1.0f;
    SBA_WAIT_BAR();
    f32x16 pA0, pA1, pB0, pB1;
    { const f32x16 zero16 = f32x16{};
#pragma unroll
      for (int d0 = 0; d0 < 4; ++d0) {
          const bf16x8 b0 = *(const __attribute__((address_space(3))) bf16x8*)(c.kp0 + d0 * 2048);
          const bf16x8 b1 = *(const __attribute__((address_space(3))) bf16x8*)(c.kp0 + d0 * 2048 + 512);
          pA0 = SBA_MFMA(b0, qr[d0], d0 ? pA0 : zero16); pA1 = SBA_MFMA(b1, qr[d0], d0 ? pA1 : zero16);
      }
      band_mask(pA0, pA1, 3, c.qrel, hi); }
    for (int t = NT - 1; t > 0; t -= 2) {
        if (!step(c, t, pA0, pA1, pB0, pB1, o, qr, carry)) break;
        if (!step(c, t - 1, pB0, pB1, pA0, pA1, o, qr, carry)) break;
    }
    unsigned short* Ow = YMIX + (rowbase + q0 + wid * 32) * D + 512 + hd * 64;
    { __attribute__((address_space(3))) unsigned short* stg = (__attribute__((address_space(3))) unsigned short*)(shm3 + LDS_OST + wid * 4096);
#pragma unroll
      for (int r = 0; r < 16; ++r) { const int orow = (r & 3) + 8 * (r >> 2) + 4 * hi;
#pragma unroll
          for (int d0 = 0; d0 < 2; ++d0) stg[orow * 64 + d0 * 32 + r32] = (unsigned short)(cvtpk_s(o[d0][r], 0.f) & 0xffffu); }
      asm volatile("s_waitcnt lgkmcnt(0)" ::: "memory");
#pragma unroll
      for (int i = 0; i < 4; ++i) { const int row = i * 8 + (lane >> 3), ch = lane & 7; const v4u v = *(const __attribute__((address_space(3))) v4u*)(stg + row * 64 + ch * 8); *(v4u*)(Ow + (size_t)row * D + ch * 8) = v; } }
}
__device__ __forceinline__ void phase(const unsigned short* PROJ, unsigned short* YMIX, char* shm, int bx, int wid) {
    const int G = gridDim.x; const int vcu = (G % 8 == 0) ? (bx % 8) * (G / 8) + bx / 8 : bx;
    for (int v = vcu; v < 256; v += G) { const int bh = v >> 3, s = v & 7;
#pragma unroll 1
        for (int i = 0; i < 4; ++i) { const int qb = (i == 0) ? 31 - s : (i == 1) ? 16 + s : (i == 2) ? 15 - s : s; unit(bh >> 3, bh & 7, qb, PROJ, YMIX, shm, wid); } }
}
}

__global__ void __launch_bounds__(NWAVES * 64, 2) mk_fwd(Args args) {
    extern __shared__ __attribute__((aligned(16))) unsigned char lds_raw[];
    LAS unsigned char* lds = (LAS unsigned char*)lds_raw;
    const int wave = __builtin_amdgcn_readfirstlane((int)threadIdx.x >> 6);
#define LANE_NOW() lane_now()
#define TID_NOW() (wave * 64 + lane_now())
    const int G = gridDim.x, gw = blockIdx.x * NWAVES + wave, NGW = G * NWAVES;
    unsigned char* const ws0 = args.ws;
#define PHASE_PTRS() unsigned char* ws = ws0; const Args* ap = (const Args*)__builtin_amdgcn_kernarg_segment_ptr(); asm volatile("" : "+s"(ws), "+s"(ap)); \
    float* ss1 = (float*)(ws + WS_CTL); float* ss2 = ss1 + M; float* ss3 = ss2 + M; float* ss4 = ss3 + M; (void)ss1; (void)ss2; (void)ss3; (void)ss4; \
    bf16* XB = (bf16*)(ws + WS_XB); bf16* PB = (bf16*)(ws + WS_PB); bf16* HID = (bf16*)(ws + WS_HID); bf16* PROJ = HID; bf16* YMIX = (bf16*)(ws + WS_YMIX); bf16* PP = (bf16*)(ws + WS_PP); (void)XB; (void)PB; (void)HID; (void)PROJ; (void)YMIX; (void)PP
    const int lo = args.ph_lo, hi = args.ph_hi;
    volatile LAS unsigned* MISC = (volatile LAS unsigned*)(lds + 131072);
    { const int tid = TID_NOW(); if (tid < 32) MISC[tid] = 0u; }
    __syncthreads();
    XcdBarrier bar; bar.bar = g_bar; bar.x = 0; bar.st = nullptr;
    if (hi - lo > 1) { bar.x = xb_xcc_id(); bar.st = MISC + 8;
        if (TID_NOW() == 0) MISC[10] = xb_add(&bar.bar[XB_XCNT(bar.x)], 1u); }
    __syncthreads();
#define IN(k) (lo <= (k) && (k) < hi)
#define SEAM(k) do { if (IN(k) && IN((k) + 1)) { if ((k) == 0 && hi == 0x7fffffff) cg::this_grid().sync(); else xcd_barrier(bar, wave); } } while (0)
    typedef pg8::StaticOrder SO;
    LAS float* rst = (LAS float*)(lds + 131072 + 256);
#define FILL_RS(S_, ss_) do { pg8::Unit u_; const int tid_ = TID_NOW(); for (int i_ = 0; (S_).next(i_, u_); ++i_) if (tid_ < 256) rst[i_ * 256 + tid_] = pg8::rs_of((ss_)[u_.pm * 256 + tid_]); __syncthreads(); } while (0)
    if (IN(0)) { PHASE_PTRS(); p0_prep(*ap, lds, gw, NGW, LANE_NOW(), wave); } SEAM(0);
    int vc = (int)blockIdx.x;
    if (hi - lo > 1) {
        if (TID_NOW() == 0) { unsigned ok = (G % 8 == 0) ? 1u : 0u, nz = 0u, slot = 0u;
            for (unsigned j = 0; j < 16; ++j) { const unsigned cj = xb_ld(&bar.bar[XB_XCNT(j)]); if (cj) { ++nz; if (cj != (unsigned)G / 8u) ok = 0u; if (j < bar.x) ++slot; } }
            if (nz != 8u) ok = 0u;
            MISC[11] = ok ? (MISC[10] * 8u + slot) : (unsigned)blockIdx.x; }
        __syncthreads();
        vc = (int)MISC[11];
    }
    if (IN(1)) { PHASE_PTRS();
        { pg8::Gemm g{XB, (const bf16*)(ws + WS_W1GU), M, 2 * FF, D}; SO S; S.init(M, 2 * FF, G, vc); FILL_RS(S, ss1); pg8::EpiSwiGLU E{HID, FF, rst};
          pg8::gemm_phase<pg8::EpiSwiGLU, SO, true, true>(lds, g, S, E, wave); }
        { pg8::Gemm g{PB, (const bf16*)(ws + WS_WPP), M, D, PLE}; SO S; S.init(M, D, G, vc); pg8::EpiScaleBf16 E{PP, D, nullptr};
          pg8::gemm_phase<pg8::EpiScaleBf16, SO, true, true>(lds, g, S, E, wave); }
    } SEAM(1);
    if (IN(2)) { PHASE_PTRS(); pg8::Gemm g{HID, (const bf16*)(ws + WS_W1D), M, D, FF}; SO S; S.init(M, D, G, vc); pg8::EpiResid<false> E{nullptr, XB, ss2, 0.5f};
        pg8::gemm_phase<pg8::EpiResid<false>, SO, true, true>(lds, g, S, E, wave); } SEAM(2);
    if (IN(3)) { PHASE_PTRS(); pg8::Gemm g{XB, (const bf16*)(ws + WS_WIN), M, NPROJ, D}; SO S; S.init(M, NPROJ, G, vc); { const int t_ = TID_NOW(); if (t_ < 64) rst[2816 + t_] = ap->in[10][t_] * QSC; else if (t_ < 128) rst[2816 + t_] = ap->in[11][t_ - 64]; } FILL_RS(S, ss2); pg8::EpiProj E{PROJ, rst, rst + 2816};
        pg8::gemm_phase<pg8::EpiProj, SO, true, true>(lds, g, S, E, wave); } SEAM(3);
    if (IN(5)) { PHASE_PTRS(); if (ATTN_NAIVE) p5_attn_naive(*ap, TID_NOW()); else sba::phase(PROJ, YMIX, (char*)lds_raw, vc, wave); conv_phase(*ap, gw, NGW, LANE_NOW()); } SEAM(5);
    if (IN(6)) { PHASE_PTRS(); pg8::Gemm g{YMIX, (const bf16*)(ws + WS_WOUT), M, D, D}; SO S; S.init(M, D, G, vc); pg8::EpiResid<false> E{nullptr, XB, ss3, 1.0f};
        pg8::gemm_phase<pg8::EpiResid<false>, SO, true, true>(lds, g, S, E, wave); } SEAM(6);
    if (IN(7)) { PHASE_PTRS(); pg8::Gemm g{XB, (const bf16*)(ws + WS_W2GU), M, 2 * FF, D}; SO S; S.init(M, 2 * FF, G, vc); FILL_RS(S, ss3); pg8::EpiSwiGLU E{HID, FF, rst};
        pg8::gemm_phase<pg8::EpiSwiGLU, SO, true, true>(lds, g, S, E, wave); } SEAM(7);
    if (IN(8)) { PHASE_PTRS(); pg8::Gemm g{HID, (const bf16*)(ws + WS_W2D), M, D, FF}; SO S; S.init(M, D, G, vc); pg8::EpiResid<false> E{nullptr, XB, ss4, 0.5f};
        pg8::gemm_phase<pg8::EpiResid<false>, SO, true, true>(lds, g, S, E, wave); } SEAM(8);
    if (IN(9)) { PHASE_PTRS(); pg8::Gemm g{XB, (const bf16*)(ws + WS_WPG), M, D, D}; SO S; S.init(M, D, G, vc); FILL_RS(S, ss4); pg8::EpiPle E{XB, ap->out, PP, rst};
        pg8::gemm_phase<pg8::EpiPle, SO, true, true>(lds, g, S, E, wave); }
    if (hi - lo > 1) {
        __syncthreads();
        const int t_ = TID_NOW();
        if (t_ == 0) MISC[12] = (xb_add(&g_bar[XCD_BAR_WORDS], 1u) == (unsigned)G - 1u) ? 1u : 0u;
        __syncthreads();
        if (MISC[12]) { for (int i_ = t_; i_ < XCD_BAR_WORDS + 1; i_ += NWAVES * 64) __hip_atomic_store(&g_bar[i_], 0u, __ATOMIC_RELAXED, __HIP_MEMORY_SCOPE_AGENT); }
    }
#undef IN
#undef SEAM
}

extern "C" void kernel_launch(void* const* d_in, const int* in_sizes, int n_in, void* d_out, int out_size, void* d_ws, size_t ws_size, hipStream_t stream) {
    static int grid = 0;
    if (grid == 0) {
        if (n_in != 20 || out_size != M * D || ws_size < WS_END) { fprintf(stderr, "kernel_launch: unexpected shapes (n_in %d out %d ws %zu)\n", n_in, out_size, ws_size); grid = -1; return; }
        int dev = 0, cus = 0, per_cu = 0;
        if (hipGetDevice(&dev) != hipSuccess || hipDeviceGetAttribute(&cus, hipDeviceAttributeMultiprocessorCount, dev) != hipSuccess) { grid = -1; return; }
        if (hipFuncSetAttribute((const void*)mk_fwd, hipFuncAttributeMaxDynamicSharedMemorySize, LDS_BYTES) != hipSuccess) { fprintf(stderr, "kernel_launch: hipFuncSetAttribute failed\n"); grid = -1; return; }
        if (hipOccupancyMaxActiveBlocksPerMultiprocessor(&per_cu, (const void*)mk_fwd, NWAVES * 64, LDS_BYTES) != hipSuccess || per_cu < 1) { fprintf(stderr, "kernel_launch: occupancy query says %d\n", per_cu); per_cu = 1; }
        (void)hipGetLastError();
        grid = cus;
    }
    if (grid < 0) return;
    Args a{};
    for (int i = 0; i < 20; ++i) a.in[i] = (const float*)d_in[i];
    a.out = (float*)d_out; a.ws = (unsigned char*)d_ws;
#if MK_ONE_LAUNCH
    a.ph_lo = 0; a.ph_hi = N_PHASES;
    void* kargs[] = {&a};
    hipError_t e = hipLaunchCooperativeKernel((const void*)mk_fwd, dim3(grid), dim3(NWAVES * 64), kargs, LDS_BYTES, stream);
    if (e != hipSuccess) fprintf(stderr, "kernel_launch: cooperative launch failed: %s\n", hipGetErrorString(e));
#else
    for (int ph = 0; ph < N_PHASES; ++ph) for (int rep = 0; rep < 1 + ((PROBE_DUP >> ph) & 1); ++rep) { a.ph_lo = ph; a.ph_hi = ph + 1; hipLaunchKernelGGL(mk_fwd, dim3(grid), dim3(NWAVES * 64), LDS_BYTES, stream, a); }
#endif
}
```

```cpp
#include <hip/hip_runtime.h>
#include <hip/hip_cooperative_groups.h>
#include <cstdio>
#include <cstdint>
namespace cg = cooperative_groups;
__device__ __forceinline__ int lane_now() { int l_; asm volatile("v_mbcnt_lo_u32_b32 %0, -1, 0\n\tv_mbcnt_hi_u32_b32 %0, -1, %0" : "=v"(l_)); return l_; }
namespace pg8 {
#define PG8_LAS __attribute__((address_space(3)))
typedef unsigned short bf16_t;
typedef short bf16x8 __attribute__((ext_vector_type(8)));
typedef float f32x4 __attribute__((ext_vector_type(4)));
typedef unsigned u32x4 __attribute__((ext_vector_type(4)));
constexpr int BM = 256, BK = 64, HALF = 128, HTB = HALF * BK * 2  , STAGE_BYTES = 8 * HTB, NXCD = 8, WGM = 4;

__host__ __device__ __forceinline__ int lds_byte(int r, int c) { const int st = (r >> 4) * 2 + (c >> 5), rr = r & 15, cc = c & 31, ob = rr * 64 + cc * 2; return st * 1024 + (ob ^ (((ob >> 9) & 1) << 5)); }
__host__ __device__ __forceinline__ void stage_rc(int b, int& R, int& C) { const int st = b / 1024, sb = b % 1024, swz = sb ^ (((sb >> 9) & 1) << 5); R = (st >> 1) * 16 + swz / 64; C = (st & 1) * 32 + (swz % 64) / 2; }
__host__ __device__ __forceinline__ int perm32(int rho) { const int n = rho >> 4, i = rho & 15; return 8 * (i >> 2) + 4 * n + (i & 3); }

struct Unit { int pm, pn, idx; };
struct Gemm { const bf16_t* A; const bf16_t* Bt; int M, N, K; };

struct StaticOrder {
    int nM, nN, nwg, G, c;
    __host__ __device__ void init(int M, int N, int G_, int c_) { nM = M / BM; nN = N / BM; nwg = nM * nN; G = G_; c = c_; }
    __host__ __device__ bool next(int i, Unit& u) const {
        const long L = (long)i * G + c; if (L >= nwg) return false;
        int wgid = (int)L; { const int q = nwg / NXCD, r = nwg % NXCD, xcd = wgid % NXCD, off = wgid / NXCD; wgid = (xcd < r ? xcd * (q + 1) : r * (q + 1) + (xcd - r) * q) + off; }
        const int nig = WGM * nN, gid = wgid / nig, fm = gid * WGM, gsz = (nM - fm) < WGM ? (nM - fm) : WGM;
        u.pm = fm + ((wgid % nig) % gsz); u.pn = (wgid % nig) / gsz; u.idx = i; return true;
    }
    __device__ __forceinline__ void a_ready(const Unit&) const {}
    __device__ __forceinline__ void done(const Unit&) const {}
};

__device__ __forceinline__ unsigned cvt_pk_bf16(float lo, float hi) { unsigned r; asm volatile("v_cvt_pk_bf16_f32 %0, %1, %2" : "=v"(r) : "v"(lo), "v"(hi)); return r; }
typedef float f32x2 __attribute__((ext_vector_type(2)));
__device__ __forceinline__ float rs_of(float ss) { return rsqrtf(ss * (1.0f / 1024.0f) + 1e-6f); }
struct EpiSwiGLU {
    static constexpr bool PERM = true, AFTER_DRAIN = false; static constexpr int NST = 8;
    bf16_t* H; int ldh; const PG8_LAS float* rst;
    __device__ __forceinline__ void operator()(const f32x4 (&acc)[2][2][4][2], const Unit& u, int wr, int wc, int fr, int fq) const {
        const int row0 = u.pm * BM + wr * 64 + fr, col0 = u.pn * HALF + wc * 32 + 8 * fq;
#pragma unroll
        for (int ai = 0; ai < 2; ++ai)
#pragma unroll
            for (int m = 0; m < 4; ++m) {
                const int row = row0 + ai * HALF + m * 16; const float rs = rst[u.idx * 256 + wr * 64 + fr + ai * HALF + m * 16];
                unsigned ww[4];
#pragma unroll
                for (int n = 0; n < 2; ++n) { const f32x4 g = acc[ai][0][m][n] * rs, up = acc[ai][1][m][n] * rs; f32x4 hh;
#pragma unroll
                    for (int e = 0; e < 4; ++e) hh[e] = g[e] * __builtin_amdgcn_rcpf(1.0f + __builtin_amdgcn_exp2f(-1.4426950408889634f * g[e])) * up[e];
                    ww[2 * n] = cvt_pk_bf16(hh[0], hh[1]); ww[2 * n + 1] = cvt_pk_bf16(hh[2], hh[3]); }
                __builtin_nontemporal_store((u32x4){ww[0], ww[1], ww[2], ww[3]}, (u32x4*)(H + (size_t)row * ldh + col0));
            }
    }
};
template <bool XF32> struct EpiResid {
    static constexpr bool PERM = true, AFTER_DRAIN = false; static constexpr int NST = 16;
    const float* xold; bf16_t* xb; float* ssq; float alpha;
    __device__ __forceinline__ void operator()(const f32x4 (&acc)[2][2][4][2], const Unit& u, int wr, int wc, int fr, int fq) const {
        const int row0 = u.pm * BM + wr * 64 + fr, colb = u.pn * BM + wc * 64 + 8 * fq;
#pragma unroll
        for (int ai = 0; ai < 2; ++ai)
#pragma unroll
            for (int m = 0; m < 4; ++m) {
                const int row = row0 + ai * HALF + m * 16; float s = 0.f;
#pragma unroll
                for (int bj = 0; bj < 2; ++bj) { const size_t off = (size_t)row * 1024 + colb + bj * 32;
                    f32x4 o0, o1;
                    if (XF32) { o0 = *(const f32x4*)(xold + off); o1 = *(const f32x4*)(xold + off + 4); }
                    else { const u32x4 pw = *(const u32x4*)(xb + off);
                        o0[0] = __uint_as_float(pw[0] << 16); o0[1] = __uint_as_float(pw[0] & 0xffff0000u); o0[2] = __uint_as_float(pw[1] << 16); o0[3] = __uint_as_float(pw[1] & 0xffff0000u);
                        o1[0] = __uint_as_float(pw[2] << 16); o1[1] = __uint_as_float(pw[2] & 0xffff0000u); o1[2] = __uint_as_float(pw[3] << 16); o1[3] = __uint_as_float(pw[3] & 0xffff0000u); }
                    const f32x4 v0 = o0 + acc[ai][bj][m][0] * alpha, v1 = o1 + acc[ai][bj][m][1] * alpha;
                    *(u32x4*)(xb + off) = (u32x4){cvt_pk_bf16(v0[0], v0[1]), cvt_pk_bf16(v0[2], v0[3]), cvt_pk_bf16(v1[0], v1[1]), cvt_pk_bf16(v1[2], v1[3])};
                    s += (v0[0] * v0[0] + v0[1] * v0[1]) + (v0[2] * v0[2] + v0[3] * v0[3]) + (v1[0] * v1[0] + v1[1] * v1[1]) + (v1[2] * v1[2] + v1[3] * v1[3]); }
                s += __shfl_xor(s, 16); s += __shfl_xor(s, 32);
                if (fq == 0) __hip_atomic_fetch_add(ssq + row, s, __ATOMIC_RELAXED, __HIP_MEMORY_SCOPE_AGENT);
            }
    }
};
struct EpiScaleBf16 {
    static constexpr bool PERM = true, AFTER_DRAIN = false; static constexpr int NST = 16;
    bf16_t* O; int ldc; const float* ss;
    __device__ __forceinline__ void operator()(const f32x4 (&acc)[2][2][4][2], const Unit& u, int wr, int wc, int fr, int fq) const {
        const int row0 = u.pm * BM + wr * 64 + fr, colb = u.pn * BM + wc * 64 + 8 * fq;
#pragma unroll
        for (int ai = 0; ai < 2; ++ai)
#pragma unroll
            for (int m = 0; m < 4; ++m) {
                const int row = row0 + ai * HALF + m * 16; const float rs = ss ? rs_of(ss[row]) : 1.0f;
#pragma unroll
                for (int bj = 0; bj < 2; ++bj) { const f32x4 v0 = acc[ai][bj][m][0] * rs, v1 = acc[ai][bj][m][1] * rs;
                    __builtin_nontemporal_store((u32x4){cvt_pk_bf16(v0[0], v0[1]), cvt_pk_bf16(v0[2], v0[3]), cvt_pk_bf16(v1[0], v1[1]), cvt_pk_bf16(v1[2], v1[3])}, (u32x4*)(O + (size_t)row * ldc + colb + bj * 32)); }
            }
    }
};
struct EpiProj {
    static constexpr bool PERM = true, AFTER_DRAIN = false; static constexpr int NST = 8;
    bf16_t* O; const PG8_LAS float* rst; const PG8_LAS float* gtab;
    __device__ __forceinline__ void operator()(const f32x4 (&acc)[2][2][4][2], const Unit& u, int wr, int wc, int fr, int fq) const {
        const int row0 = u.pm * BM + wr * 64 + fr, colb = u.pn * BM + wc * 64 + 8 * fq;
        if (u.pn >= 2 && u.pn < 6) {
            bf16_t* zp = O + (size_t)row0 * 3072 + 512 + 128 * (u.pn - 2) + 32 * wc + 8 * fq;
#pragma unroll
            for (int ai = 0; ai < 2; ++ai)
#pragma unroll
                for (int m = 0; m < 4; ++m) { const float rs = rst[u.idx * 256 + wr * 64 + fr + ai * HALF + m * 16], r2 = rs * rs;
                    const f32x4 z0 = acc[ai][0][m][0] * acc[ai][1][m][0] * r2, z1 = acc[ai][0][m][1] * acc[ai][1][m][1] * r2;
                    __builtin_nontemporal_store((u32x4){cvt_pk_bf16(z0[0], z0[1]), cvt_pk_bf16(z0[2], z0[3]), cvt_pk_bf16(z1[0], z1[1]), cvt_pk_bf16(z1[2], z1[3])}, (u32x4*)(zp + (size_t)(ai * HALF + m * 16) * 3072)); }
            return;
        }
        const int sec = u.pn >> 1; const bool qk = (sec == 3) || (sec == 4);
        f32x4 g[2][2];
        if (qk) { const PG8_LAS float* gp = gtab + (sec == 3 ? 0 : 64);
#pragma unroll
            for (int bj = 0; bj < 2; ++bj)
#pragma unroll
                for (int n = 0; n < 2; ++n) g[bj][n] = *(const PG8_LAS f32x4*)(gp + 32 * bj + 8 * fq + 4 * n); }
#pragma unroll
        for (int ai = 0; ai < 2; ++ai)
#pragma unroll
            for (int m = 0; m < 4; ++m) {
                const int row = row0 + ai * HALF + m * 16; const float rs = rst[u.idx * 256 + wr * 64 + fr + ai * HALF + m * 16];
                f32x4 v[2][2];
#pragma unroll
                for (int bj = 0; bj < 2; ++bj)
#pragma unroll
                    for (int n = 0; n < 2; ++n) v[bj][n] = acc[ai][bj][m][n] * rs;
                if (qk) { float s = 0.f;
#pragma unroll
                    for (int bj = 0; bj < 2; ++bj)
#pragma unroll
                        for (int n = 0; n < 2; ++n) s += (v[bj][n][0] * v[bj][n][0] + v[bj][n][1] * v[bj][n][1]) + (v[bj][n][2] * v[bj][n][2] + v[bj][n][3] * v[bj][n][3]);
                    s += __shfl_xor(s, 16); s += __shfl_xor(s, 32);
                    const float r = rsqrtf(s * (1.0f / 64.0f) + 1e-6f);
#pragma unroll
                    for (int bj = 0; bj < 2; ++bj)
#pragma unroll
                        for (int n = 0; n < 2; ++n) v[bj][n] = v[bj][n] * g[bj][n] * r; }
#pragma unroll
                for (int bj = 0; bj < 2; ++bj)
                    __builtin_nontemporal_store((u32x4){cvt_pk_bf16(v[bj][0][0], v[bj][0][1]), cvt_pk_bf16(v[bj][0][2], v[bj][0][3]), cvt_pk_bf16(v[bj][1][0], v[bj][1][1]), cvt_pk_bf16(v[bj][1][2], v[bj][1][3])},
                                                (u32x4*)(O + (size_t)row * 3072 + colb + bj * 32));
            }
    }
};
struct EpiPle {
    static constexpr bool PERM = true, AFTER_DRAIN = false; static constexpr int NST = 32;
    const bf16_t* xold; float* out; const bf16_t* PP; const PG8_LAS float* rst;
    __device__ __forceinline__ void operator()(const f32x4 (&acc)[2][2][4][2], const Unit& u, int wr, int wc, int fr, int fq) const {
        const int row0 = u.pm * BM + wr * 64 + fr, colb = u.pn * BM + wc * 64 + 8 * fq;
#pragma unroll
        for (int ai = 0; ai < 2; ++ai)
#pragma unroll
            for (int m = 0; m < 4; ++m) {
                const int row = row0 + ai * HALF + m * 16; const float rs = rst[u.idx * 256 + wr * 64 + fr + ai * HALF + m * 16] * -1.4426950408889634f;
#pragma unroll
                for (int bj = 0; bj < 2; ++bj) { const size_t off = (size_t)row * 1024 + colb + bj * 32;
                    const u32x4 xw = *(const u32x4*)(xold + off); const u32x4 pw = *(const u32x4*)(PP + off); f32x4 o0, o1;
                    o0[0] = __uint_as_float(xw[0] << 16); o0[1] = __uint_as_float(xw[0] & 0xffff0000u); o0[2] = __uint_as_float(xw[1] << 16); o0[3] = __uint_as_float(xw[1] & 0xffff0000u);
                    o1[0] = __uint_as_float(xw[2] << 16); o1[1] = __uint_as_float(xw[2] & 0xffff0000u); o1[2] = __uint_as_float(xw[3] << 16); o1[3] = __uint_as_float(xw[3] & 0xffff0000u);
                    f32x4 p0, p1; p0[0] = __uint_as_float(pw[0] << 16); p0[1] = __uint_as_float(pw[0] & 0xffff0000u); p0[2] = __uint_as_float(pw[1] << 16); p0[3] = __uint_as_float(pw[1] & 0xffff0000u);
                    p1[0] = __uint_as_float(pw[2] << 16); p1[1] = __uint_as_float(pw[2] & 0xffff0000u); p1[2] = __uint_as_float(pw[3] << 16); p1[3] = __uint_as_float(pw[3] & 0xffff0000u);
                    f32x4 v0, v1;
#pragma unroll
                    for (int e = 0; e < 4; ++e) { v0[e] = o0[e] + __builtin_amdgcn_rcpf(1.0f + __builtin_amdgcn_exp2f(acc[ai][bj][m][0][e] * rs)) * p0[e];
                                                  v1[e] = o1[e] + __builtin_amdgcn_rcpf(1.0f + __builtin_amdgcn_exp2f(acc[ai][bj][m][1][e] * rs)) * p1[e]; }
                    __builtin_nontemporal_store(v0, (f32x4*)(out + off)); __builtin_nontemporal_store(v1, (f32x4*)(out + off + 4)); }
            }
    }
};
template <class Epi, class Sched, bool ALIGN_EPI = false, bool SP2 = false>
__device__ __forceinline__ void gemm_phase(PG8_LAS unsigned char* lds, const Gemm g, const Sched& S, const Epi& E, int wid) {
    const int lane = lane_now(), tid = wid * 64 + lane, wr = wid >> 2, wc = wid & 3, fr = lane & 15, fq = lane >> 4;
    const int K = g.K, nt = K / BK;
    unsigned voffA[2], voffB[2];
#pragma unroll
    for (int i = 0; i < 2; ++i) { int R, C; stage_rc(tid * 16 + i * 8192, R, C); const int Rb = Epi::PERM ? ((R & ~31) + perm32(R & 31)) : R;
        voffA[i] = (unsigned)(R * K + C) * 2u; voffB[i] = (unsigned)(Rb * K + C) * 2u; }
    const size_t kstep = (size_t)(BK * 2);
    const size_t hstep = (size_t)HALF * K * 2;
    const size_t tstep = 2 * hstep;
    const unsigned ldsw = (unsigned)wid * 1024u;
    const int aoff = lds_byte(wr * 64 + fr, fq * 8), boff = lds_byte(wc * 32 + fr, fq * 8);
#define PG8_SA(b, h) (((b) * 2 + (h)) * HTB)
#define PG8_SB(b, h) ((4 + (b) * 2 + (h)) * HTB)
#define PG8_STAGE(bufoff, gbase, voff) do { _Pragma("unroll") for (int _i = 0; _i < 2; ++_i) \
        __builtin_amdgcn_global_load_lds((const unsigned*)((const char*)(gbase) + (voff)[_i]), (PG8_LAS unsigned*)(lds + (bufoff) + ldsw + _i * 8192), 16, 0, 0); } while (0)
#define PG8_LDA(dst, b, h) do { _Pragma("unroll") for (int m = 0; m < 4; ++m) _Pragma("unroll") for (int k = 0; k < 2; ++k) dst[m][k] = *(const PG8_LAS bf16x8*)(lds + PG8_SA(b, h) + aoff + m * 2048 + k * 1024); } while (0)
#define PG8_LDB(dst, b, h) do { _Pragma("unroll") for (int n = 0; n < 2; ++n) _Pragma("unroll") for (int k = 0; k < 2; ++k) dst[n][k] = *(const PG8_LAS bf16x8*)(lds + PG8_SB(b, h) + boff + n * 2048 + k * 1024); } while (0)
#define PG8_MMA(ai, bj, At, Bt) do { __builtin_amdgcn_s_setprio(1); _Pragma("unroll") for (int m = 0; m < 4; ++m) _Pragma("unroll") for (int n = 0; n < 2; ++n) _Pragma("unroll") for (int k = 0; k < 2; ++k) \
        acc[ai][bj][m][n] = __builtin_amdgcn_mfma_f32_16x16x32_bf16(Bt[n][k], At[m][k], acc[ai][bj][m][n], 0, 0, 0); __builtin_amdgcn_s_setprio(0); } while (0)
#define PG8_WAIT_V(n) asm volatile("s_waitcnt vmcnt(" #n ")" ::: "memory")
#define PG8_WAIT_L(n) asm volatile("s_waitcnt lgkmcnt(" #n ")" ::: "memory")
#define PG8_WAIT_VR(n, rlx) asm volatile("s_waitcnt vmcnt(%0)\n\ts_cmp_lg_u32 %1, 0\n\ts_cbranch_scc1 .Lpg8w%=\n\ts_waitcnt vmcnt(8)\n.Lpg8w%=:" :: "n"(n), "s"(rlx) : "memory", "scc")
#define PG8_BAR __builtin_amdgcn_s_barrier()
#define PG8_SCHED __builtin_amdgcn_sched_barrier(0)
    Unit cur, nxt; int ui = 0;
    if (!S.next(0, cur)) return;
    f32x4 acc[2][2][4][2];
#pragma unroll
    for (int a = 0; a < 2; ++a)
#pragma unroll
        for (int b = 0; b < 2; ++b)
#pragma unroll
            for (int m = 0; m < 4; ++m)
#pragma unroll
                for (int n = 0; n < 2; ++n) acc[a][b][m][n] = (f32x4){0.f, 0.f, 0.f, 0.f};
    bf16x8 At[4][2], B0[2][2], B1[2][2];
    const char* cA = (const char*)g.A + (size_t)cur.pm * tstep; const char* cB = (const char*)g.Bt + (size_t)cur.pn * tstep;
    S.a_ready(cur);
    if constexpr (SP2) {
        PG8_STAGE(PG8_SB(0, 0), cB, voffB); PG8_STAGE(PG8_SB(0, 1), cB + hstep, voffB); PG8_STAGE(PG8_SA(0, 0), cA, voffA); PG8_STAGE(PG8_SA(0, 1), cA + hstep, voffA);
        if (wr == 1) PG8_BAR;
        PG8_WAIT_V(2); PG8_BAR;
        PG8_STAGE(PG8_SB(1, 0), cB + kstep, voffB); PG8_STAGE(PG8_SA(1, 0), cA + kstep, voffA); PG8_STAGE(PG8_SB(1, 1), cB + hstep + kstep, voffB);
        PG8_WAIT_V(6); PG8_BAR;
    } else {
        PG8_STAGE(PG8_SB(0, 0), cB, voffB); PG8_STAGE(PG8_SA(0, 0), cA, voffA); PG8_STAGE(PG8_SB(0, 1), cB + hstep, voffB); PG8_STAGE(PG8_SA(0, 1), cA + hstep, voffA);
        if (wr == 1) PG8_BAR;
        PG8_WAIT_V(4); PG8_BAR;
        PG8_STAGE(PG8_SB(1, 0), cB + kstep, voffB); PG8_STAGE(PG8_SA(1, 0), cA + kstep, voffA); PG8_STAGE(PG8_SB(1, 1), cB + hstep + kstep, voffB);
        PG8_WAIT_V(6); PG8_BAR;
    }
    for (;;) {
        const bool has_next = S.next(ui + 1, nxt);
        const char* nA = has_next ? (const char*)g.A + (size_t)nxt.pm * tstep : cA; const char* nB = has_next ? (const char*)g.Bt + (size_t)nxt.pn * tstep : cB;
        for (int t = 0; t < nt; t += 2) {
            const bool last = (t == nt - 2);
            const int relax = __builtin_amdgcn_readfirstlane(((t == 0) && (ui > 0)) ? 1 : 0);
            const char* a1 = cA + (size_t)(t + 1) * kstep;
            const char* a2 = last ? nA : cA + (size_t)(t + 2) * kstep; const char* b2 = last ? nB : cB + (size_t)(t + 2) * kstep;
            const char* a3 = a2 + kstep; const char* b3 = b2 + kstep;
            if (last && has_next) S.a_ready(nxt);
            if constexpr (SP2) {
            PG8_LDB(B0, 0, 0); PG8_LDB(B1, 0, 1); PG8_SCHED; PG8_LDA(At, 0, 0); PG8_STAGE(PG8_SA(1, 1), a1 + hstep, voffA);
            PG8_WAIT_VR(8 + Epi::NST, relax); PG8_WAIT_L(0); PG8_BAR; PG8_MMA(0, 0, At, B0); PG8_MMA(0, 1, At, B1); PG8_BAR; PG8_SCHED;
            PG8_LDA(At, 0, 1); PG8_STAGE(PG8_SB(0, 0), b2, voffB); PG8_STAGE(PG8_SB(0, 1), b2 + hstep, voffB); PG8_STAGE(PG8_SA(0, 0), a2, voffA);
            PG8_WAIT_VR(8 + Epi::NST, relax); PG8_WAIT_L(0); PG8_BAR; PG8_MMA(1, 0, At, B0); PG8_MMA(1, 1, At, B1); PG8_BAR; PG8_SCHED;
            PG8_LDB(B0, 1, 0); PG8_LDB(B1, 1, 1); PG8_SCHED; PG8_LDA(At, 1, 0); PG8_STAGE(PG8_SA(0, 1), a2 + hstep, voffA);
            PG8_WAIT_V(8); PG8_WAIT_L(0); PG8_BAR; PG8_MMA(0, 0, At, B0); PG8_MMA(0, 1, At, B1); PG8_BAR; PG8_SCHED;
            PG8_LDA(At, 1, 1); PG8_STAGE(PG8_SB(1, 0), b3, voffB); PG8_STAGE(PG8_SB(1, 1), b3 + hstep, voffB); PG8_STAGE(PG8_SA(1, 0), a3, voffA);
            PG8_WAIT_V(8); PG8_WAIT_L(0); PG8_BAR; PG8_MMA(1, 0, At, B0); PG8_MMA(1, 1, At, B1); PG8_BAR; PG8_SCHED;
            } else {
            PG8_LDB(B0, 0, 0); PG8_SCHED; PG8_LDA(At, 0, 0); PG8_STAGE(PG8_SA(1, 1), a1 + hstep, voffA);
            PG8_WAIT_L(8); PG8_BAR; PG8_WAIT_L(0); PG8_MMA(0, 0, At, B0); PG8_BAR; PG8_SCHED;
            PG8_LDB(B1, 0, 1); PG8_STAGE(PG8_SB(0, 0), b2, voffB);
            PG8_BAR; PG8_WAIT_L(0); PG8_MMA(0, 1, At, B1); PG8_BAR;
            PG8_LDA(At, 0, 1); PG8_STAGE(PG8_SA(0, 0), a2, voffA);
            PG8_BAR; PG8_WAIT_L(0); PG8_MMA(1, 0, At, B0); PG8_BAR; PG8_SCHED;
            PG8_STAGE(PG8_SB(0, 1), b2 + hstep, voffB);
            PG8_WAIT_V(6); PG8_BAR; PG8_MMA(1, 1, At, B1); PG8_BAR;
            PG8_LDB(B0, 1, 0); PG8_SCHED; PG8_LDA(At, 1, 0); PG8_STAGE(PG8_SA(0, 1), a2 + hstep, voffA);
            PG8_WAIT_L(8); PG8_BAR; PG8_WAIT_L(0); PG8_MMA(0, 0, At, B0); PG8_BAR; PG8_SCHED;
            PG8_LDB(B1, 1, 1); PG8_STAGE(PG8_SB(1, 0), b3, voffB);
            PG8_BAR; PG8_WAIT_L(0); PG8_MMA(0, 1, At, B1); PG8_BAR;
            PG8_LDA(At, 1, 1); PG8_STAGE(PG8_SA(1, 0), a3, voffA);
            PG8_BAR; PG8_WAIT_L(0); PG8_MMA(1, 0, At, B0); PG8_BAR; PG8_SCHED;
            PG8_STAGE(PG8_SB(1, 1), b3 + hstep, voffB);
            PG8_WAIT_V(6); PG8_BAR; PG8_MMA(1, 1, At, B1); PG8_BAR;
            }
        }
        if constexpr (ALIGN_EPI) { if (wr == 0) PG8_BAR; }
        if constexpr (!Epi::AFTER_DRAIN) { const int ln_ = (int)__builtin_amdgcn_mbcnt_hi(~0u, __builtin_amdgcn_mbcnt_lo(~0u, 0u)); E(acc, cur, wr, wc, ln_ & 15, ln_ >> 4); S.done(cur); }
        if (!has_next) break;
#pragma unroll
        for (int a = 0; a < 2; ++a)
#pragma unroll
            for (int b = 0; b < 2; ++b)
#pragma unroll
                for (int m = 0; m < 4; ++m)
#pragma unroll
                    for (int n = 0; n < 2; ++n) acc[a][b][m][n] = (f32x4){0.f, 0.f, 0.f, 0.f};
        cur = nxt; cA = nA; cB = nB; ++ui;
        if constexpr (ALIGN_EPI) { if (wr == 1) PG8_BAR; }
    }
    PG8_WAIT_V(0);
    if constexpr (!ALIGN_EPI) { if (wr == 0) PG8_BAR; }
    PG8_BAR;
    if constexpr (Epi::AFTER_DRAIN) { E.fused(acc, cur, wr, wc, fr, fq, lds, wid, lane); S.done(cur); }
#undef PG8_SA
#undef PG8_SB
#undef PG8_STAGE
#undef PG8_LDA
#undef PG8_LDB
#undef PG8_MMA
#undef PG8_WAIT_V
#undef PG8_WAIT_L
#undef PG8_WAIT_VR
#undef PG8_BAR
#undef PG8_SCHED
}
}

constexpr int NWAVES = 8;
constexpr int BATCH = 4, SEQ = 8192, D = 1024, FF = 2816, NPROJ = 3072, PLE = 256, NH = 8, HD = 64, CONVD = 512;
constexpr int M = BATCH * SEQ;
#ifndef PROBE_DUP
#define PROBE_DUP 0
#endif
#ifndef MK_ONE_LAUNCH
#define MK_ONE_LAUNCH 1
#endif
constexpr int N_PHASES = 10;
constexpr size_t MiB = 1u << 20;
constexpr size_t WS_CTL = 0, CTL_ZERO_BYTES = 1 * MiB;
constexpr size_t WS_W1GU = 2 * MiB, WS_W1D = 13 * MiB, WS_WIN = 19 * MiB, WS_WOUT = 25 * MiB, WS_W2GU = 27 * MiB, WS_W2D = 38 * MiB, WS_WPG = 44 * MiB, WS_WPP = 46 * MiB;
constexpr size_t WS_XB = 48 * MiB;
constexpr size_t WS_PB = 112 * MiB;
constexpr size_t WS_HID = 128 * MiB;
constexpr size_t WS_YMIX = 320 * MiB;
constexpr size_t WS_PP = 384 * MiB;
constexpr size_t WS_END = 448 * MiB;
#ifndef ATTN_NAIVE
#define ATTN_NAIVE 0
#endif
constexpr float QSC = ATTN_NAIVE ? 0.125f : 0.125f * 1.4426950408889634f;
constexpr int LDS_BYTES = 147456;

#define GAS __attribute__((address_space(1)))
#define LAS __attribute__((address_space(3)))
typedef unsigned short bf16;
typedef unsigned v4u __attribute__((ext_vector_type(4)));
typedef float f32x4 __attribute__((ext_vector_type(4)));
#define LDS_WAIT() asm volatile("s_waitcnt lgkmcnt(0)" ::: "memory")
__device__ __forceinline__ unsigned pk2(float lo, float hi) { return pg8::cvt_pk_bf16(lo, hi); }
__device__ __forceinline__ float bflo(unsigned w) { return __uint_as_float(w << 16); }
__device__ __forceinline__ float bfhi(unsigned w) { return __uint_as_float(w & 0xffff0000u); }
__device__ __forceinline__ float wave_sum(float v) {
#pragma unroll
    for (int o = 1; o < 64; o <<= 1) v += __shfl_xor(v, o);
    return v;
}

#define XB_TMO      128
#define XB_XCNT(j)  (256  + 64 * (j))
#define XB_XSUB(j)  (1280 + 64 * (j))
#define XB_XGEN(j)  (2304 + 64 * (j))
#define XB_TOP      3328
#define XB_TOPGEN   3392
#define XCD_BAR_WORDS 3456
#define XB_SPIN_CAP (1u << 18)

__device__ __forceinline__ unsigned xb_ld(unsigned* p)              { return __hip_atomic_load(p, __ATOMIC_RELAXED, __HIP_MEMORY_SCOPE_AGENT); }
__device__ __forceinline__ unsigned xb_add(unsigned* p, unsigned v) { return __hip_atomic_fetch_add(p, v, __ATOMIC_RELAXED, __HIP_MEMORY_SCOPE_AGENT); }
__device__ __forceinline__ unsigned xb_xcc_id() { return (unsigned)__builtin_amdgcn_s_getreg((3 << 11) | 20) & 0xFu; }
#define XB_SPIN(cond, bar) do { unsigned _sp = 0; while (cond) { __builtin_amdgcn_s_sleep(1); \
    if ((++_sp & 255u) == 0u) { if (xb_ld(&(bar)[XB_TMO])) break; if (_sp > XB_SPIN_CAP) { atomicAdd(&(bar)[XB_TMO], 1u); break; } } } } while (0)

struct XcdBarrier {
    unsigned* bar; unsigned x;
    volatile LAS unsigned* st;
};

__device__ __forceinline__ XcdBarrier xcd_barrier_post(unsigned* bar, volatile LAS unsigned* st) {
    XcdBarrier b; b.bar = bar; b.x = xb_xcc_id(); b.st = st;
    if (threadIdx.x == 0) (void)xb_add(&bar[XB_XCNT(b.x)], 1u);
    return b;
}
__device__ __forceinline__ void xcd_barrier_complete(unsigned* bar, unsigned x, unsigned& nloc, unsigned& nx) {
    const unsigned G = gridDim.x * gridDim.y * gridDim.z;
    unsigned sum, cnt, mine, sp = 0u;
    for (;;) {
        sum = 0u; cnt = 0u; mine = 0u;
#pragma unroll
        for (unsigned j = 0; j < 16; ++j) { const unsigned c = xb_ld(&bar[XB_XCNT(j)]); sum += c; cnt += (c > 0u) ? 1u : 0u; mine = (j == x) ? c : mine; }
        if (sum == G) break;
        __builtin_amdgcn_s_sleep(1);
        if ((++sp & 255u) == 0u) { if (xb_ld(&bar[XB_TMO])) break; if (sp > XB_SPIN_CAP) { atomicAdd(&bar[XB_TMO], 1u); break; } }
    }
    nloc = mine > 0u ? mine : 1u; nx = cnt > 0u ? cnt : 1u;
}

__device__ __forceinline__ void xcd_barrier(const XcdBarrier& b, int wave) {
    asm volatile("s_waitcnt vmcnt(0)" ::: "memory");
    __syncthreads();
    if (wave == 0 && lane_now() == 0) {
        unsigned* bar = b.bar;
        __builtin_amdgcn_s_waitcnt(0);
        unsigned nloc = b.st[0], nx = b.st[1];
        if (nloc == 0u) { xcd_barrier_complete(bar, b.x, nloc, nx); b.st[0] = nloc; b.st[1] = nx; }
        const unsigned old = xb_add(&bar[XB_XSUB(b.x)], 1u);
        const unsigned gen = old / nloc;
        if (old + 1u == (gen + 1u) * nloc) {
            __builtin_amdgcn_fence(__ATOMIC_RELEASE, "agent");
            asm volatile("s_waitcnt vmcnt(0)" ::: "memory");
            const unsigned og = xb_add(&bar[XB_TOP], 1u);
            const unsigned tg = og / nx;
            if (og + 1u == (tg + 1u) * nx) xb_add(&bar[XB_TOPGEN], 1u);
            else XB_SPIN(xb_ld(&bar[XB_TOPGEN]) == tg, bar);
            __builtin_amdgcn_fence(__ATOMIC_ACQUIRE, "agent");
            xb_add(&bar[XB_XGEN(b.x)], 1u);
            asm volatile("s_waitcnt vmcnt(0)" ::: "memory");
        } else {
            XB_SPIN(xb_ld(&bar[XB_XGEN(b.x)]) == gen, bar);
            __builtin_amdgcn_fence(__ATOMIC_ACQUIRE, "agent");
            asm volatile("s_waitcnt vmcnt(0)" ::: "memory");
        }
    }
    __syncthreads();
}

constexpr size_t WS_BAR = 768 * 1024;
__device__ unsigned g_bar[XCD_BAR_WORDS + 64];
struct Args { const float* in[20]; float* out; unsigned char* ws; int ph_lo, ph_hi; };

__device__ __forceinline__ void tr_item(const float* __restrict__ W, int K, int N, const float* __restrict__ gain, bf16* __restrict__ WT, int dst_row0, LAS float* scr, int k0, int n0, int lane) {
    float w[32]; const float* wp = W + (size_t)(k0 + (lane >> 5)) * N + n0 + (lane & 31);
#pragma unroll
    for (int i = 0; i < 32; ++i) w[i] = __builtin_nontemporal_load(wp + (size_t)(2 * i) * N);
    if (gain) {
#pragma unroll
        for (int i = 0; i < 32; ++i) w[i] *= gain[k0 + 2 * i + (lane >> 5)];
    }
#pragma unroll
    for (int i = 0; i < 32; ++i) scr[(2 * i + (lane >> 5)) * 33 + (lane & 31)] = w[i];
    LDS_WAIT(); asm volatile("" ::: "memory");
    const int c = lane & 7;
#pragma unroll
    for (int j = 0; j < 4; ++j) { const int n = (lane >> 3) + 8 * j; const LAS float* s = scr + (8 * c) * 33 + n;
        v4u o; o.x = pk2(s[0 * 33], s[1 * 33]); o.y = pk2(s[2 * 33], s[3 * 33]); o.z = pk2(s[4 * 33], s[5 * 33]); o.w = pk2(s[6 * 33], s[7 * 33]);
        *(v4u*)(WT + (size_t)(dst_row0 + n) * K + k0 + 8 * c) = o; }
    LDS_WAIT(); asm volatile("" ::: "memory");
}
__device__ __forceinline__ bool tr_matrix(int& r, const float* W, int K, int N, const float* gain, bf16* WT, int mode, LAS float* scr, int lane) {
    const int nblk = N / 32, items = (K / 64) * nblk;
    if (r >= items) { r -= items; return false; }
    const int kb = r / nblk, nb = r % nblk, n0 = 32 * nb;
    int dst;
    if (mode == 4 && n0 >= 512 && n0 < 1536) { const int ch = (n0 - 512) & 511; dst = 256 * (2 + (ch >> 7)) + (n0 >= 1024 ? 128 : 0) + (ch & 127); }
    else if (mode >= 3) dst = 256 * (n0 >> 8) + 128 * ((n0 >> 5) & 1) + 32 * ((n0 >> 6) & 3);
    else dst = 256 * (n0 >> 7) + (n0 & 127) + (mode == 2 ? 128 : 0);
    tr_item(W, K, N, gain, WT, dst, scr, 64 * kb, n0, lane);
    return true;
}
__device__ __forceinline__ void p0_prep(const Args& a, LAS unsigned char* lds, int gw, int NGW, int lane, int wave) {
    unsigned char* ws = a.ws;
    LAS float* scr = (LAS float*)(lds + wave * 16384);
    constexpr int I_GU = (D / 64) * (FF / 32), I_DN = (FF / 64) * (D / 32), I_IN = (D / 64) * (NPROJ / 32), I_SQ = (D / 64) * (D / 32), I_PP = (PLE / 64) * (D / 32);
    constexpr int NITEMS = 4 * I_GU + 2 * I_DN + I_IN + 2 * I_SQ + I_PP;
    for (int it = gw; it < NITEMS; it += NGW) {
        int r = it;
        if (tr_matrix(r, a.in[3], D, FF, a.in[2], (bf16*)(ws + WS_W1GU), 1, scr, lane)) continue;
        if (tr_matrix(r, a.in[4], D, FF, a.in[2], (bf16*)(ws + WS_W1GU), 2, scr, lane)) continue;
        if (tr_matrix(r, a.in[14], D, FF, a.in[13], (bf16*)(ws + WS_W2GU), 1, scr, lane)) continue;
        if (tr_matrix(r, a.in[15], D, FF, a.in[13], (bf16*)(ws + WS_W2GU), 2, scr, lane)) continue;
        if (tr_matrix(r, a.in[5], FF, D, nullptr, (bf16*)(ws + WS_W1D), 3, scr, lane)) continue;
        if (tr_matrix(r, a.in[16], FF, D, nullptr, (bf16*)(ws + WS_W2D), 3, scr, lane)) continue;
        if (tr_matrix(r, a.in[7], D, NPROJ, a.in[6], (bf16*)(ws + WS_WIN), 4, scr, lane)) continue;
        if (tr_matrix(r, a.in[12], D, D, nullptr, (bf16*)(ws + WS_WOUT), 3, scr, lane)) continue;
        if (tr_matrix(r, a.in[18], D, D, a.in[17], (bf16*)(ws + WS_WPG), 3, scr, lane)) continue;
        tr_matrix(r, a.in[19], PLE, D, nullptr, (bf16*)(ws + WS_WPP), 3, scr, lane);
    }
    const float* __restrict__ x = a.in[0]; bf16* __restrict__ XB = (bf16*)(ws + WS_XB); float* __restrict__ ss1 = (float*)(ws + WS_CTL);
    for (int m0 = gw * 8; m0 < M; m0 += NGW * 8) {
        f32x4 v[8][4];
#pragma unroll
        for (int r = 0; r < 8; ++r)
#pragma unroll
            for (int j = 0; j < 4; ++j) v[r][j] = __builtin_nontemporal_load((const f32x4*)(x + (size_t)(m0 + r) * D) + lane + 64 * j);
#pragma unroll
        for (int r = 0; r < 8; ++r) { float s = 0.f;
#pragma unroll
            for (int j = 0; j < 4; ++j) s += (v[r][j].x * v[r][j].x + v[r][j].y * v[r][j].y) + (v[r][j].z * v[r][j].z + v[r][j].w * v[r][j].w);
            s = wave_sum(s);
            unsigned long long* o8 = (unsigned long long*)(XB + (size_t)(m0 + r) * D) + lane;
#pragma unroll
            for (int j = 0; j < 4; ++j) o8[64 * j] = (unsigned long long)pk2(v[r][j].x, v[r][j].y) | ((unsigned long long)pk2(v[r][j].z, v[r][j].w) << 32);
            if (lane == 0) ss1[m0 + r] = s; }
    }
    for (int i = gw * 64 + lane; i < 3 * M; i += NGW * 64) ss1[M + i] = 0.f;
    const float* __restrict__ p = a.in[1]; bf16* __restrict__ PB = (bf16*)(ws + WS_PB);
    for (int i0 = gw * 64 + lane; i0 < M * PLE / 8; i0 += NGW * 64 * 4) {
        f32x4 v0[4], v1[4];
#pragma unroll
        for (int r = 0; r < 4; ++r) { const size_t i = (size_t)i0 + (size_t)r * NGW * 64; v0[r] = __builtin_nontemporal_load((const f32x4*)(p + i * 8)); v1[r] = __builtin_nontemporal_load((const f32x4*)(p + i * 8 + 4)); }
#pragma unroll
        for (int r = 0; r < 4; ++r) { const size_t i = (size_t)i0 + (size_t)r * NGW * 64; *(v4u*)(PB + i * 8) = (v4u){pk2(v0[r].x, v0[r].y), pk2(v0[r].z, v0[r].w), pk2(v1[r].x, v1[r].y), pk2(v1[r].z, v1[r].w)}; }
    }
}

__device__ __forceinline__ void unpack8(const v4u w, float (&f)[8]) { f[0] = bflo(w.x); f[1] = bfhi(w.x); f[2] = bflo(w.y); f[3] = bfhi(w.y); f[4] = bflo(w.z); f[5] = bfhi(w.z); f[6] = bflo(w.w); f[7] = bfhi(w.w); }
__device__ __forceinline__ v4u pack8(const float (&f)[8]) { return (v4u){pk2(f[0], f[1]), pk2(f[2], f[3]), pk2(f[4], f[5]), pk2(f[6], f[7])}; }
__device__ __forceinline__ void conv_phase(const Args& a, int gw, int NGW, int lane) {
    const bf16* __restrict__ PROJ = (const bf16*)(a.ws + WS_HID); bf16* __restrict__ YMIX = (bf16*)(a.ws + WS_YMIX);
    const float* cw = a.in[8]; const float* cbp = a.in[9];
    float w0[8], w1[8], w2[8], cb[8];
#pragma unroll
    for (int i = 0; i < 8; ++i) { w0[i] = cw[8 * lane + i]; w1[i] = cw[CONVD + 8 * lane + i]; w2[i] = cw[2 * CONVD + 8 * lane + i]; cb[i] = cbp[8 * lane + i]; }
    for (int ch = gw; ch < M / 16; ch += NGW) {
        const int r0 = ch * 16; const bool first = (r0 & (SEQ - 1)) == 0;
        const bf16* pr = PROJ + (size_t)r0 * NPROJ + 8 * lane;
        float z1[8], z2[8];
        { const bf16* q2 = pr - (first ? 0 : 2 * NPROJ); const bf16* q1 = pr - (first ? 0 : NPROJ);
          float c[8]; unpack8(*(const v4u*)(q2 + 512), c);
#pragma unroll
          for (int i = 0; i < 8; ++i) z2[i] = first ? 0.f : c[i];
          unpack8(*(const v4u*)(q1 + 512), c);
#pragma unroll
          for (int i = 0; i < 8; ++i) z1[i] = first ? 0.f : c[i]; }
#pragma unroll 1
        for (int s4 = 0; s4 < 4; ++s4) {
            const bf16* ps = pr + (size_t)(4 * s4) * NPROJ;
            v4u bw[4], cwv[4];
#pragma unroll
            for (int r = 0; r < 4; ++r) { bw[r] = *(const v4u*)(ps + (size_t)r * NPROJ); cwv[r] = *(const v4u*)(ps + (size_t)r * NPROJ + 512); }
#pragma unroll
            for (int r = 0; r < 4; ++r) { float b[8], c[8], y[8]; unpack8(bw[r], b); unpack8(cwv[r], c);
#pragma unroll
                for (int i = 0; i < 8; ++i) { const float z0 = c[i]; y[i] = b[i] * (w0[i] * z2[i] + w1[i] * z1[i] + w2[i] * z0 + cb[i]); z2[i] = z1[i]; z1[i] = z0; }
                *(v4u*)(YMIX + (size_t)(r0 + 4 * s4 + r) * D + 8 * lane) = pack8(y); }
        }
    }
}

__device__ __forceinline__ void p5_attn_naive(const Args& a, int tid) {
    const bf16* PROJ = (const bf16*)(a.ws + WS_HID); bf16* YMIX = (bf16*)(a.ws + WS_YMIX);
    for (int un = blockIdx.x; un < 512; un += gridDim.x) {
        const int bh = un & 31, r = un >> 5, qq = r < 8 ? r : 23 - r, b = bh >> 3, h = bh & 7;
        const int t = qq * 512 + tid;
        const bf16* base = PROJ + (size_t)b * SEQ * NPROJ + h * HD;
        float q[64], o[64];
#pragma unroll
        for (int c = 0; c < 8; ++c) { float f[8]; unpack8(*(const v4u*)(base + (size_t)t * NPROJ + 1536 + 8 * c), f);
#pragma unroll
            for (int e = 0; e < 8; ++e) { q[8 * c + e] = f[e]; o[8 * c + e] = 0.f; } }
        float carry = 0.f;
        for (int j = qq * 512 + 511; j >= 0; --j) {
            const bf16* kr = base + (size_t)j * NPROJ + 2048; float z = 0.f;
#pragma unroll
            for (int c = 0; c < 8; ++c) { float f[8]; unpack8(*(const v4u*)(kr + 8 * c), f);
#pragma unroll
                for (int e = 0; e < 8; ++e) z += q[8 * c + e] * f[e]; }
            const bool act = j < t;
            const float sp = fmaxf(z, 0.f) + __logf(1.0f + __expf(-fabsf(z)));
            const float av = act ? __expf(z - sp + carry) : 0.f;
            carry -= act ? sp : 0.f;
            const bf16* vr = kr + 512;
#pragma unroll
            for (int c = 0; c < 8; ++c) { float f[8]; unpack8(*(const v4u*)(vr + 8 * c), f);
#pragma unroll
                for (int e = 0; e < 8; ++e) o[8 * c + e] += av * f[e]; }
        }
        bf16* orow = YMIX + (size_t)(b * SEQ + t) * D + 512 + h * HD;
#pragma unroll
        for (int c = 0; c < 8; ++c) { float f[8];
#pragma unroll
            for (int e = 0; e < 8; ++e) f[e] = o[8 * c + e];
            *(v4u*)(orow + 8 * c) = pack8(f); }
    }
}

namespace sba {
using bf16x8 = __attribute__((ext_vector_type(8))) short;
using s16x4 = __attribute__((ext_vector_type(4))) short;
using f32x16 = __attribute__((ext_vector_type(16))) float;
typedef short v4i16_t __attribute__((ext_vector_type(4)));
typedef float f32x2_t __attribute__((ext_vector_type(2))); typedef __bf16 bf16x2_t __attribute__((ext_vector_type(2)));
typedef __attribute__((address_space(3))) const char* lds_cptr;
constexpr int SLOTB = 8192, LDS_K = 0, LDS_V = 3 * SLOTB, LDS_FLG = 6 * SLOTB, LDS_OST = 65536;
constexpr float CARRY_DEAD = 1e-30f;
__device__ __forceinline__ void glds16(const void* gbase, unsigned voff, unsigned lds_dst) { unsigned keep;
    asm volatile("s_mov_b32 %0, m0\n\ts_mov_b32 m0, %3\n\ts_nop 0\n\tglobal_load_lds_dwordx4 %1, %2\n\ts_mov_b32 m0, %0" : "=&s"(keep) : "v"(voff), "s"(gbase), "s"(lds_dst) : "memory"); }
__device__ __forceinline__ unsigned cvtpk_s(float lo, float hi) { f32x2_t v = {lo, hi}; bf16x2_t b = __builtin_convertvector(v, bf16x2_t); return __builtin_bit_cast(unsigned, b); }
__device__ __forceinline__ s16x4 vtr(lds_cptr p) { return __builtin_bit_cast(s16x4, __builtin_amdgcn_ds_read_tr16_b64_v4i16((__attribute__((address_space(3))) v4i16_t*)p)); }
#define SBA_MFMA(a, b, c) __builtin_amdgcn_mfma_f32_32x32x16_bf16((a), (b), (c), 0, 0, 0)

#define SBA_WAIT_BAR() asm volatile("s_waitcnt vmcnt(0) lgkmcnt(0)\n\ts_barrier" ::: "memory")
#define SBA_SBAR() do {} while (0)
struct Ctx { const unsigned short* Kh; unsigned koff, voff; unsigned kdst, vdst;     lds_cptr kp0, vp0; __attribute__((address_space(3))) unsigned* flg; int NT, qrel, hi, wid, lane; int s_cur, s_nxt, s_nn; int walive; };
__device__ __forceinline__ void band_mask(f32x16& p0, f32x16& p1, int jb, int qrel, int hi) {
    const int kb = 64 * jb + 4 * hi;
#pragma unroll
    for (int r = 0; r < 16; ++r) { const int kv = kb + (r & 3) + 8 * (r >> 2); if (kv >= qrel) p0[r] = -INFINITY; if (kv + 32 >= qrel) p1[r] = -INFINITY; }
}
__device__ __forceinline__ bool step(Ctx& c, int t, const f32x16& PC0, const f32x16& PC1, f32x16& PN0, f32x16& PN1, f32x16 (&o)[2], const bf16x8 (&qr)[4], float& carry) {
    SBA_WAIT_BAR();
    if (t < c.NT - 1) {
        const __attribute__((address_space(3))) v4u* f = (const __attribute__((address_space(3))) v4u*)(c.flg + ((t + 1) & 1) * 8); const v4u f0 = f[0], f1 = f[1];
        if (((f0.x | f0.y) | (f0.z | f0.w) | (f1.x | f1.y) | (f1.z | f1.w)) == 0u) return false;
    }
    if (t >= 2) { const unsigned short* tb = c.Kh + (size_t)(t - 2) * 64 * NPROJ; glds16(tb, c.koff, (unsigned)__builtin_amdgcn_readfirstlane(c.kdst + c.s_nn)); glds16(tb, c.voff, (unsigned)__builtin_amdgcn_readfirstlane(c.vdst + c.s_nn)); }
    const bool qk = c.walive != 0;
    const bool act = qk && !(t >= c.NT - 4 && (t - (c.NT - 4)) > (c.wid >> 1));
    bf16x8 kf[8]; s16x4 vlo[8], vhi[8];
    const lds_cptr kp = c.kp0 + c.s_nxt; const lds_cptr vp = c.vp0 + c.s_cur;
#define SBA_LDK(d0) do { kf[2 * (d0)] = *(const __attribute__((address_space(3))) bf16x8*)(kp + (d0) * 2048); kf[2 * (d0) + 1] = *(const __attribute__((address_space(3))) bf16x8*)(kp + (d0) * 2048 + 512); } while (0)
#define SBA_LDV(i) do { vlo[i] = vtr(vp + ((i) >> 2) * 4096 + ((i) & 3) * 1024); vhi[i] = vtr(vp + ((i) >> 2) * 4096 + ((i) & 3) * 1024 + 512); } while (0)
    if (qk) SBA_LDK(0);
    const f32x16 zero16 = f32x16{};
    float st = carry; unsigned pw[4][4];
#define VFR(i) ((bf16x8){vlo[i][0], vlo[i][1], vlo[i][2], vlo[i][3], vhi[i][0], vhi[i][1], vhi[i][2], vhi[i][3]})
#define PAF(ks) __builtin_bit_cast(bf16x8, (v4u){pw[ks][0], pw[ks][1], pw[ks][2], pw[ks][3]})
#pragma unroll
    for (int jj = 0; jj < 4; ++jj) {
        const int ks = 3 - jj, p = ks >> 1;
        SBA_SBAR();
        if (qk) { if (jj < 3) SBA_LDK(jj + 1);
            PN0 = SBA_MFMA(kf[2 * jj], qr[jj], jj ? PN0 : zero16); PN1 = SBA_MFMA(kf[2 * jj + 1], qr[jj], jj ? PN1 : zero16); }
        if (act) {
            SBA_LDV(ks); SBA_LDV(4 + ks);
            if (jj >= 1) { o[0] = SBA_MFMA(PAF(ks + 1), VFR(ks + 1), o[0]); o[1] = SBA_MFMA(PAF(ks + 1), VFR(4 + ks + 1), o[1]); }
            float a8[8];
#pragma unroll
            for (int gi = 0; gi < 2; ++gi) {
                const int g = 2 * (ks & 1) + 1 - gi; float k4[4];
#pragma unroll
                for (int e = 0; e < 4; ++e) { const float z = p ? PC1[4 * g + e] : PC0[4 * g + e]; k4[e] = __builtin_amdgcn_rcpf(1.0f + __builtin_amdgcn_exp2f(z)); }
                const float r3 = k4[3], r2 = r3 * k4[2], r1 = r2 * k4[1], G = r1 * k4[0];
                const auto rr = __builtin_amdgcn_permlane32_swap(__float_as_uint(G), __float_as_uint(G), false, false);
                const float Glo = __uint_as_float(rr[0]), Ghi = __uint_as_float(rr[1]);
                const float base = st * (c.hi ? 1.0f : Ghi);
                a8[4 * (1 - gi) + 3] = base * (1.0f - r3); a8[4 * (1 - gi) + 2] = base * (r3 - r2); a8[4 * (1 - gi) + 1] = base * (r2 - r1); a8[4 * (1 - gi)] = base * (r1 - G);
                st = st * (Glo * Ghi);
            }
#pragma unroll
            for (int i = 0; i < 4; ++i) pw[ks][i] = cvtpk_s(a8[2 * i], a8[2 * i + 1]);
        }
    }
    SBA_SBAR();
    if (act) {
        o[0] = SBA_MFMA(PAF(0), VFR(0), o[0]); o[1] = SBA_MFMA(PAF(0), VFR(4), o[1]);
        carry = st;
        const unsigned long long alive = __ballot(st > CARRY_DEAD); c.walive = alive ? 1 : 0;
    }
#undef VFR
#undef PAF
#undef SBA_LDK
#undef SBA_LDV
    if (c.lane == 0) c.flg[(t & 1) * 8 + c.wid] = (unsigned)c.walive;
    if (qk && t - 1 >= c.NT - 4) band_mask(PN0, PN1, t - 1 - (c.NT - 4), c.qrel, c.hi);
    { const int s = c.s_cur; c.s_cur = c.s_nxt; c.s_nxt = c.s_nn; c.s_nn = s; }
    return true;
}
__device__ __forceinline__ void unit(int b, int hd, int qb, const unsigned short* PROJ, unsigned short* YMIX, char* shm, int wid) {
    const int lane = lane_now(), r32 = lane & 31, hi = lane >> 5;
    const size_t rowbase = (size_t)b * SEQ; const int q0 = qb * 256;
    const unsigned short* Qw = PROJ + (rowbase + q0 + wid * 32) * NPROJ + 1536 + hd * 64;
    const unsigned short* Kh = PROJ + rowbase * NPROJ + 2048 + hd * 64; const unsigned short* Vh = Kh + 512;
    const unsigned lds0 = (unsigned)(uintptr_t)shm;
    const lds_cptr shm3 = (lds_cptr)shm;
    Ctx c;
    c.Kh = Kh;
    c.koff = (unsigned)(lane * NPROJ + wid * 8) * 2u;
    c.voff = (unsigned)((16 * (wid & 3) + (lane >> 2)) * NPROJ + 512 + (wid >> 2) * 32 + (lane & 3) * 8) * 2u;
    c.kdst = lds0 + LDS_K + wid * 1024; c.vdst = lds0 + LDS_V + wid * 1024;
    c.kp0 = shm3 + LDS_K + hi * 1024 + r32 * 16;
    c.vp0 = shm3 + LDS_V + ((lane >> 4) & 1) * 32 + (lane & 3) * 8 + (4 * hi + ((lane & 15) >> 2)) * 64;
    c.flg = (__attribute__((address_space(3))) unsigned*)(shm3 + LDS_FLG); c.wid = wid; c.lane = lane;
    c.NT = 4 * (qb + 1); c.qrel = wid * 32 + r32; c.hi = hi; c.s_cur = 0; c.s_nxt = SLOTB; c.s_nn = 2 * SLOTB; c.walive = 1;
    const int NT = c.NT;
    asm volatile("s_waitcnt lgkmcnt(0)\n\ts_barrier" ::: "memory");
    { const unsigned short* t1 = Kh + (size_t)(NT - 1) * 64 * NPROJ; const unsigned short* t2 = Kh + (size_t)(NT - 2) * 64 * NPROJ;
      glds16(t1, c.koff, (unsigned)__builtin_amdgcn_readfirstlane(c.kdst)); glds16(t1, c.voff, (unsigned)__builtin_amdgcn_readfirstlane(c.vdst));
      glds16(t2, c.koff, (unsigned)__builtin_amdgcn_readfirstlane(c.kdst + SLOTB)); glds16(t2, c.voff, (unsigned)__builtin_amdgcn_readfirstlane(c.vdst + SLOTB)); }
    bf16x8 qr[4];
#pragma unroll
    for (int d0 = 0; d0 < 4; ++d0) qr[d0] = *reinterpret_cast<const bf16x8*>(&Qw[(size_t)r32 * NPROJ + d0 * 16 + hi * 8]);
    f32x16 o[2]; o[0] = f32x16{}; o[1] = f32x16{};
    float carry = 1.0f;
    SBA_WAIT_BAR();
    f32x16 pA0, pA1, pB0, pB1;
    { const f32x16 zero16 = f32x16{};
#pragma unroll
      for (int d0 = 0; d0 < 4; ++d0) {
          const bf16x8 b0 = *(const __attribute__((address_space(3))) bf16x8*)(c.kp0 + d0 * 2048);
          const bf16x8 b1 = *(const __attribute__((address_space(3))) bf16x8*)(c.kp0 + d0 * 2048 + 512);
          pA0 = SBA_MFMA(b0, qr[d0], d0 ? pA0 : zero16); pA1 = SBA_MFMA(b1, qr[d0], d0 ? pA1 : zero16);
      }
      band_mask(pA0, pA1, 3, c.qrel, hi); }
    for (int t = NT - 1; t > 0; t -= 2) {
        if (!step(c, t, pA0, pA1, pB0, pB1, o, qr, carry)) break;
        if (!step(c, t - 1, pB0, pB1, pA0, pA1, o, qr, carry)) break;
    }
    unsigned short* Ow = YMIX + (rowbase + q0 + wid * 32) * D + 512 + hd * 64;
    { __attribute__((address_space(3))) unsigned short* stg = (__attribute__((address_space(3))) unsigned short*)(shm3 + LDS_OST + wid * 4096);
#pragma unroll
      for (int r = 0; r < 16; ++r) { const int orow = (r & 3) + 8 * (r >> 2) + 4 * hi;
#pragma unroll
          for (int d0 = 0; d0 < 2; ++d0) stg[orow * 64 + d0 * 32 + r32] = (unsigned short)(cvtpk_s(o[d0][r], 0.f) & 0xffffu); }
      asm volatile("s_waitcnt lgkmcnt(0)" ::: "memory");
#pragma unroll
      for (int i = 0; i < 4; ++i) { const int row = i * 8 + (lane >> 3), ch = lane & 7; const v4u v = *(const __attribute__((address_space(3))) v4u*)(stg + row * 64 + ch * 8); *(v4u*)(Ow + (size_t)row * D + ch * 8) = v; } }
}
__device__ __forceinline__ void phase(const unsigned short* PROJ, unsigned short* YMIX, char* shm, int bx, int wid) {
    const int G = gridDim.x; const int vcu = (G % 8 == 0) ? (bx % 8) * (G / 8) + bx / 8 : bx;
    for (int v = vcu; v < 256; v += G) { const int bh = v >> 3, s = v & 7;
#pragma unroll 1
        for (int i = 0; i < 4; ++i) { const int qb = (i == 0) ? 31 - s : (i == 1) ? 16 + s : (i == 2) ? 15 - s : s; unit(bh >> 3, bh & 7, qb, PROJ, YMIX, shm, wid); } }
}
}

__global__ void __launch_bounds__(NWAVES * 64, 2) mk_fwd(Args args) {
    extern __shared__ __attribute__((aligned(16))) unsigned char lds_raw[];
    LAS unsigned char* lds = (LAS unsigned char*)lds_raw;
    const int wave = __builtin_amdgcn_readfirstlane((int)threadIdx.x >> 6);
#define LANE_NOW() lane_now()
#define TID_NOW() (wave * 64 + lane_now())
    const int G = gridDim.x, gw = blockIdx.x * NWAVES + wave, NGW = G * NWAVES;
    unsigned char* const ws0 = args.ws;
#define PHASE_PTRS() unsigned char* ws = ws0; const Args* ap = (const Args*)__builtin_amdgcn_kernarg_segment_ptr(); asm volatile("" : "+s"(ws), "+s"(ap)); \
    float* ss1 = (float*)(ws + WS_CTL); float* ss2 = ss1 + M; float* ss3 = ss2 + M; float* ss4 = ss3 + M; (void)ss1; (void)ss2; (void)ss3; (void)ss4; \
    bf16* XB = (bf16*)(ws + WS_XB); bf16* PB = (bf16*)(ws + WS_PB); bf16* HID = (bf16*)(ws + WS_HID); bf16* PROJ = HID; bf16* YMIX = (bf16*)(ws + WS_YMIX); bf16* PP = (bf16*)(ws + WS_PP); (void)XB; (void)PB; (void)HID; (void)PROJ; (void)YMIX; (void)PP
    const int lo = args.ph_lo, hi = args.ph_hi;
    volatile LAS unsigned* MISC = (volatile LAS unsigned*)(lds + 131072);
    { const int tid = TID_NOW(); if (tid < 32) MISC[tid] = 0u; }
    __syncthreads();
    XcdBarrier bar; bar.bar = g_bar; bar.x = 0; bar.st = nullptr;
    if (hi - lo > 1) { bar.x = xb_xcc_id(); bar.st = MISC + 8;
        if (TID_NOW() == 0) MISC[10] = xb_add(&bar.bar[XB_XCNT(bar.x)], 1u); }
    __syncthreads();
#define IN(k) (lo <= (k) && (k) < hi)
#define SEAM(k) do { if (IN(k) && IN((k) + 1)) { if ((k) == 0 && hi == 0x7fffffff) cg::this_grid().sync(); else xcd_barrier(bar, wave); } } while (0)
    typedef pg8::StaticOrder SO;
    LAS float* rst = (LAS float*)(lds + 131072 + 256);
#define FILL_RS(S_, ss_) do { pg8::Unit u_; const int tid_ = TID_NOW(); for (int i_ = 0; (S_).next(i_, u_); ++i_) if (tid_ < 256) rst[i_ * 256 + tid_] = pg8::rs_of((ss_)[u_.pm * 256 + tid_]); __syncthreads(); } while (0)
    if (IN(0)) { PHASE_PTRS(); p0_prep(*ap, lds, gw, NGW, LANE_NOW(), wave); } SEAM(0);
    int vc = (int)blockIdx.x;
    if (hi - lo > 1) {
        if (TID_NOW() == 0) { unsigned ok = (G % 8 == 0) ? 1u : 0u, nz = 0u, slot = 0u;
            for (unsigned j = 0; j < 16; ++j) { const unsigned cj = xb_ld(&bar.bar[XB_XCNT(j)]); if (cj) { ++nz; if (cj != (unsigned)G / 8u) ok = 0u; if (j < bar.x) ++slot; } }
            if (nz != 8u) ok = 0u;
            MISC[11] = ok ? (MISC[10] * 8u + slot) : (unsigned)blockIdx.x; }
        __syncthreads();
        vc = (int)MISC[11];
    }
    if (IN(1)) { PHASE_PTRS();
        { pg8::Gemm g{XB, (const bf16*)(ws + WS_W1GU), M, 2 * FF, D}; SO S; S.init(M, 2 * FF, G, vc); FILL_RS(S, ss1); pg8::EpiSwiGLU E{HID, FF, rst};
          pg8::gemm_phase<pg8::EpiSwiGLU, SO, true, true>(lds, g, S, E, wave); }
        { pg8::Gemm g{PB, (const bf16*)(ws + WS_WPP), M, D, PLE}; SO S; S.init(M, D, G, vc); pg8::EpiScaleBf16 E{PP, D, nullptr};
          pg8::gemm_phase<pg8::EpiScaleBf16, SO, true, true>(lds, g, S, E, wave); }
    } SEAM(1);
    if (IN(2)) { PHASE_PTRS(); pg8::Gemm g{HID, (const bf16*)(ws + WS_W1D), M, D, FF}; SO S; S.init(M, D, G, vc); pg8::EpiResid<false> E{nullptr, XB, ss2, 0.5f};
        pg8::gemm_phase<pg8::EpiResid<false>, SO, true, true>(lds, g, S, E, wave); } SEAM(2);
    if (IN(3)) { PHASE_PTRS(); pg8::Gemm g{XB, (const bf16*)(ws + WS_WIN), M, NPROJ, D}; SO S; S.init(M, NPROJ, G, vc); { const int t_ = TID_NOW(); if (t_ < 64) rst[2816 + t_] = ap->in[10][t_] * QSC; else if (t_ < 128) rst[2816 + t_] = ap->in[11][t_ - 64]; } FILL_RS(S, ss2); pg8::EpiProj E{PROJ, rst, rst + 2816};
        pg8::gemm_phase<pg8::EpiProj, SO, true, true>(lds, g, S, E, wave); } SEAM(3);
    if (IN(5)) { PHASE_PTRS(); if (ATTN_NAIVE) p5_attn_naive(*ap, TID_NOW()); else sba::phase(PROJ, YMIX, (char*)lds_raw, vc, wave); conv_phase(*ap, gw, NGW, LANE_NOW()); } SEAM(5);
    if (IN(6)) { PHASE_PTRS(); pg8::Gemm g{YMIX, (const bf16*)(ws + WS_WOUT), M, D, D}; SO S; S.init(M, D, G, vc); pg8::EpiResid<false> E{nullptr, XB, ss3, 1.0f};
        pg8::gemm_phase<pg8::EpiResid<false>, SO, true, true>(lds, g, S, E, wave); } SEAM(6);
    if (IN(7)) { PHASE_PTRS(); pg8::Gemm g{XB, (const bf16*)(ws + WS_W2GU), M, 2 * FF, D}; SO S; S.init(M, 2 * FF, G, vc); FILL_RS(S, ss3); pg8::EpiSwiGLU E{HID, FF, rst};
        pg8::gemm_phase<pg8::EpiSwiGLU, SO, true, true>(lds, g, S, E, wave); } SEAM(7);
    if (IN(8)) { PHASE_PTRS(); pg8::Gemm g{HID, (const bf16*)(ws + WS_W2D), M, D, FF}; SO S; S.init(M, D, G, vc); pg8::EpiResid<false> E{nullptr, XB, ss4, 0.5f};
        pg8::gemm_phase<pg8::EpiResid<false>, SO, true, true>(lds, g, S, E, wave); } SEAM(8);
    if (IN(9)) { PHASE_PTRS(); pg8::Gemm g{XB, (const bf16*)(ws + WS_WPG), M, D, D}; SO S; S.init(M, D, G, vc); FILL_RS(S, ss4); pg8::EpiPle E{XB, ap->out, PP, rst};
        pg8::gemm_phase<pg8::EpiPle, SO, true, true>(lds, g, S, E, wave); }
    if (hi - lo > 1) {
        __syncthreads();
        const int t_ = TID_NOW();
        if (t_ == 0) MISC[12] = (xb_add(&g_bar[XCD_BAR_WORDS], 1u) == (unsigned)G - 1u) ? 1u : 0u;
        __syncthreads();
        if (MISC[12]) { for (int i_ = t_; i_ < XCD_BAR_WORDS + 1; i_ += NWAVES * 64) __hip_atomic_store(&g_bar[i_], 0u, __ATOMIC_RELAXED, __HIP_MEMORY_SCOPE_AGENT); }
    }
#undef IN
#undef SEAM
}

extern "C" void kernel_launch(void* const* d_in, const int* in_sizes, int n_in, void* d_out, int out_size, void* d_ws, size_t ws_size, hipStream_t stream) {
    static int grid = 0;
    if (grid == 0) {
        if (n_in != 20 || out_size != M * D || ws_size < WS_END) { fprintf(stderr, "kernel_launch: unexpected shapes (n_in %d out %d ws %zu)\n", n_in, out_size, ws_size); grid = -1; return; }
        int dev = 0, cus = 0, per_cu = 0;
        if (hipGetDevice(&dev) != hipSuccess || hipDeviceGetAttribute(&cus, hipDeviceAttributeMultiprocessorCount, dev) != hipSuccess) { grid = -1; return; }
        if (hipFuncSetAttribute((const void*)mk_fwd, hipFuncAttributeMaxDynamicSharedMemorySize, LDS_BYTES) != hipSuccess) { fprintf(stderr, "kernel_launch: hipFuncSetAttribute failed\n"); grid = -1; return; }
        if (hipOccupancyMaxActiveBlocksPerMultiprocessor(&per_cu, (const void*)mk_fwd, NWAVES * 64, LDS_BYTES) != hipSuccess || per_cu < 1) { fprintf(stderr, "kernel_launch: occupancy query says %d\n", per_cu); per_cu = 1; }
        (void)hipGetLastError();
        grid = cus;
    }
    if (grid < 0) return;
    Args a{};
    for (int i = 0; i < 20; ++i) a.in[i] = (const float*)d_in[i];
    a.out = (float*)d_out; a.ws = (unsigned char*)d_ws;
#if MK_ONE_LAUNCH
    a.ph_lo = 0; a.ph_hi = N_PHASES;
    void* kargs[] = {&a};
    hipError_t e = hipLaunchCooperativeKernel((const void*)mk_fwd, dim3(grid), dim3(NWAVES * 64), kargs, LDS_BYTES, stream);
    if (e != hipSuccess) fprintf(stderr, "kernel_launch: cooperative launch failed: %s\n", hipGetErrorString(e));
#else
    for (int ph = 0; ph < N_PHASES; ++ph) for (int rep = 0; rep < 1 + ((PROBE_DUP >> ph) & 1); ++rep) { a.ph_lo = ph; a.ph_hi = ph + 1; hipLaunchKernelGGL(mk_fwd, dim3(grid), dim3(NWAVES * 64), LDS_BYTES, stream, a); }
#endif
}
```

```cpp
#include <hip/hip_runtime.h>
#include <hip/hip_cooperative_groups.h>
#include <cstdio>
#include <cstdint>
namespace cg = cooperative_groups;
__device__ __forceinline__ int lane_now() { int l_; asm volatile("v_mbcnt_lo_u32_b32 %0, -1, 0\n\tv_mbcnt_hi_u32_b32 %0, -1, %0" : "=v"(l_)); return l_; }
namespace pg8 {
#define PG8_LAS __attribute__((address_space(3)))
typedef unsigned short bf16_t;
typedef short bf16x8 __attribute__((ext_vector_type(8)));
typedef float f32x4 __attribute__((ext_vector_type(4)));
typedef unsigned u32x4 __attribute__((ext_vector_type(4)));
constexpr int BM = 256, BK = 64, HALF = 128, HTB = HALF * BK * 2  , STAGE_BYTES = 8 * HTB, NXCD = 8, WGM = 4;

__host__ __device__ __forceinline__ int lds_byte(int r, int c) { const int st = (r >> 4) * 2 + (c >> 5), rr = r & 15, cc = c & 31, ob = rr * 64 + cc * 2; return st * 1024 + (ob ^ (((ob >> 9) & 1) << 5)); }
__host__ __device__ __forceinline__ void stage_rc(int b, int& R, int& C) { const int st = b / 1024, sb = b % 1024, swz = sb ^ (((sb >> 9) & 1) << 5); R = (st >> 1) * 16 + swz / 64; C = (st & 1) * 32 + (swz % 64) / 2; }
__host__ __device__ __forceinline__ int perm32(int rho) { const int n = rho >> 4, i = rho & 15; return 8 * (i >> 2) + 4 * n + (i & 3); }

struct Unit { int pm, pn, idx; };
struct Gemm { const bf16_t* A; const bf16_t* Bt; int M, N, K; };

struct StaticOrder {
    int nM, nN, nwg, G, c;
    __host__ __device__ void init(int M, int N, int G_, int c_) { nM = M / BM; nN = N / BM; nwg = nM * nN; G = G_; c = c_; }
    __host__ __device__ bool next(int i, Unit& u) const {
        const long L = (long)i * G + c; if (L >= nwg) return false;
        int wgid = (int)L; { const int q = nwg / NXCD, r = nwg % NXCD, xcd = wgid % NXCD, off = wgid / NXCD; wgid = (xcd < r ? xcd * (q + 1) : r * (q + 1) + (xcd - r) * q) + off; }
        const int nig = WGM * nN, gid = wgid / nig, fm = gid * WGM, gsz = (nM - fm) < WGM ? (nM - fm) : WGM;
        u.pm = fm + ((wgid % nig) % gsz); u.pn = (wgid % nig) / gsz; u.idx = i; return true;
    }
    __device__ __forceinline__ void a_ready(const Unit&) const {}
    __device__ __forceinline__ void done(const Unit&) const {}
};

__device__ __forceinline__ unsigned cvt_pk_bf16(float lo, float hi) { unsigned r; asm volatile("v_cvt_pk_bf16_f32 %0, %1, %2" : "=v"(r) : "v"(lo), "v"(hi)); return r; }
typedef float f32x2 __attribute__((ext_vector_type(2)));
__device__ __forceinline__ float rs_of(float ss) { return rsqrtf(ss * (1.0f / 1024.0f) + 1e-6f); }
struct EpiSwiGLU {
    static constexpr bool PERM = true, AFTER_DRAIN = false; static constexpr int NST = 8;
    bf16_t* H; int ldh; const PG8_LAS float* rst;
    __device__ __forceinline__ void operator()(const f32x4 (&acc)[2][2][4][2], const Unit& u, int wr, int wc, int fr, int fq) const {
        const int row0 = u.pm * BM + wr * 64 + fr, col0 = u.pn * HALF + wc * 32 + 8 * fq;
#pragma unroll
        for (int ai = 0; ai < 2; ++ai)
#pragma unroll
            for (int m = 0; m < 4; ++m) {
                const int row = row0 + ai * HALF + m * 16; const float rs = rst[u.idx * 256 + wr * 64 + fr + ai * HALF + m * 16];
                unsigned ww[4];
                const float rsl = rs * -1.4426950408889634f, rs2 = rs * rs;
#pragma unroll
                for (int n = 0; n < 2; ++n) { const f32x4 g = acc[ai][0][m][n], up = acc[ai][1][m][n]; f32x4 hh;
#pragma unroll
                    for (int e = 0; e < 4; ++e) hh[e] = (g[e] * up[e]) * (rs2 * __builtin_amdgcn_rcpf(1.0f + __builtin_amdgcn_exp2f(g[e] * rsl)));
                    ww[2 * n] = cvt_pk_bf16(hh[0], hh[1]); ww[2 * n + 1] = cvt_pk_bf16(hh[2], hh[3]); }
                __builtin_nontemporal_store((u32x4){ww[0], ww[1], ww[2], ww[3]}, (u32x4*)(H + (size_t)row * ldh + col0));
            }
    }
};
template <bool XF32> struct EpiResid {
    static constexpr bool PERM = true, AFTER_DRAIN = false; static constexpr int NST = 16;
    const float* xold; bf16_t* xb; float* ssq; float alpha;
    __device__ __forceinline__ void operator()(const f32x4 (&acc)[2][2][4][2], const Unit& u, int wr, int wc, int fr, int fq) const {
        const int row0 = u.pm * BM + wr * 64 + fr, colb = u.pn * BM + wc * 64 + 8 * fq;
#pragma unroll
        for (int ai = 0; ai < 2; ++ai)
#pragma unroll
            for (int m = 0; m < 4; ++m) {
                const int row = row0 + ai * HALF + m * 16; float s = 0.f;
#pragma unroll
                for (int bj = 0; bj < 2; ++bj) { const size_t off = (size_t)row * 1024 + colb + bj * 32;
                    f32x4 o0, o1;
                    if (XF32) { o0 = *(const f32x4*)(xold + off); o1 = *(const f32x4*)(xold + off + 4); }
                    else { const u32x4 pw = *(const u32x4*)(xb + off);
                        o0[0] = __uint_as_float(pw[0] << 16); o0[1] = __uint_as_float(pw[0] & 0xffff0000u); o0[2] = __uint_as_float(pw[1] << 16); o0[3] = __uint_as_float(pw[1] & 0xffff0000u);
                        o1[0] = __uint_as_float(pw[2] << 16); o1[1] = __uint_as_float(pw[2] & 0xffff0000u); o1[2] = __uint_as_float(pw[3] << 16); o1[3] = __uint_as_float(pw[3] & 0xffff0000u); }
                    const f32x4 v0 = o0 + acc[ai][bj][m][0] * alpha, v1 = o1 + acc[ai][bj][m][1] * alpha;
                    *(u32x4*)(xb + off) = (u32x4){cvt_pk_bf16(v0[0], v0[1]), cvt_pk_bf16(v0[2], v0[3]), cvt_pk_bf16(v1[0], v1[1]), cvt_pk_bf16(v1[2], v1[3])};
                    s += (v0[0] * v0[0] + v0[1] * v0[1]) + (v0[2] * v0[2] + v0[3] * v0[3]) + (v1[0] * v1[0] + v1[1] * v1[1]) + (v1[2] * v1[2] + v1[3] * v1[3]); }
                s += __shfl_xor(s, 16); s += __shfl_xor(s, 32);
                if (fq == 0) __hip_atomic_fetch_add(ssq + row, s, __ATOMIC_RELAXED, __HIP_MEMORY_SCOPE_AGENT);
            }
    }
};
struct EpiScaleBf16 {
    static constexpr bool PERM = true, AFTER_DRAIN = false; static constexpr int NST = 16;
    bf16_t* O; int ldc; const float* ss;
    __device__ __forceinline__ void operator()(const f32x4 (&acc)[2][2][4][2], const Unit& u, int wr, int wc, int fr, int fq) const {
        const int row0 = u.pm * BM + wr * 64 + fr, colb = u.pn * BM + wc * 64 + 8 * fq;
#pragma unroll
        for (int ai = 0; ai < 2; ++ai)
#pragma unroll
            for (int m = 0; m < 4; ++m) {
                const int row = row0 + ai * HALF + m * 16; const float rs = ss ? rs_of(ss[row]) : 1.0f;
#pragma unroll
                for (int bj = 0; bj < 2; ++bj) { const f32x4 v0 = acc[ai][bj][m][0] * rs, v1 = acc[ai][bj][m][1] * rs;
                    __builtin_nontemporal_store((u32x4){cvt_pk_bf16(v0[0], v0[1]), cvt_pk_bf16(v0[2], v0[3]), cvt_pk_bf16(v1[0], v1[1]), cvt_pk_bf16(v1[2], v1[3])}, (u32x4*)(O + (size_t)row * ldc + colb + bj * 32)); }
            }
    }
};
struct EpiProj {
    static constexpr bool PERM = true, AFTER_DRAIN = false; static constexpr int NST = 8;
    bf16_t* O; const PG8_LAS float* rst; const PG8_LAS float* gtab;
    __device__ __forceinline__ void operator()(const f32x4 (&acc)[2][2][4][2], const Unit& u, int wr, int wc, int fr, int fq) const {
        const int row0 = u.pm * BM + wr * 64 + fr, colb = u.pn * BM + wc * 64 + 8 * fq;
        if (u.pn >= 2 && u.pn < 6) {
            bf16_t* zp = O + (size_t)row0 * 3072 + 512 + 128 * (u.pn - 2) + 32 * wc + 8 * fq;
#pragma unroll
            for (int ai = 0; ai < 2; ++ai)
#pragma unroll
                for (int m = 0; m < 4; ++m) { const float rs = rst[u.idx * 256 + wr * 64 + fr + ai * HALF + m * 16], r2 = rs * rs;
                    const f32x4 z0 = acc[ai][0][m][0] * acc[ai][1][m][0] * r2, z1 = acc[ai][0][m][1] * acc[ai][1][m][1] * r2;
                    __builtin_nontemporal_store((u32x4){cvt_pk_bf16(z0[0], z0[1]), cvt_pk_bf16(z0[2], z0[3]), cvt_pk_bf16(z1[0], z1[1]), cvt_pk_bf16(z1[2], z1[3])}, (u32x4*)(zp + (size_t)(ai * HALF + m * 16) * 3072)); }
            return;
        }
        const int sec = u.pn >> 1; const bool qk = (sec == 3) || (sec == 4);
        f32x4 g[2][2];
        if (qk) { const PG8_LAS float* gp = gtab + (sec == 3 ? 0 : 64);
#pragma unroll
            for (int bj = 0; bj < 2; ++bj)
#pragma unroll
                for (int n = 0; n < 2; ++n) g[bj][n] = *(const PG8_LAS f32x4*)(gp + 32 * bj + 8 * fq + 4 * n); }
#pragma unroll
        for (int ai = 0; ai < 2; ++ai)
#pragma unroll
            for (int m = 0; m < 4; ++m) {
                const int row = row0 + ai * HALF + m * 16; const float rs = rst[u.idx * 256 + wr * 64 + fr + ai * HALF + m * 16];
                f32x4 v[2][2];
#pragma unroll
                for (int bj = 0; bj < 2; ++bj)
#pragma unroll
                    for (int n = 0; n < 2; ++n) v[bj][n] = acc[ai][bj][m][n] * rs;
                if (qk) { float s = 0.f;
#pragma unroll
                    for (int bj = 0; bj < 2; ++bj)
#pragma unroll
                        for (int n = 0; n < 2; ++n) s += (v[bj][n][0] * v[bj][n][0] + v[bj][n][1] * v[bj][n][1]) + (v[bj][n][2] * v[bj][n][2] + v[bj][n][3] * v[bj][n][3]);
                    s += __shfl_xor(s, 16); s += __shfl_xor(s, 32);
                    const float r = rsqrtf(s * (1.0f / 64.0f) + 1e-6f);
#pragma unroll
                    for (int bj = 0; bj < 2; ++bj)
#pragma unroll
                        for (int n = 0; n < 2; ++n) v[bj][n] = v[bj][n] * g[bj][n] * r; }
#pragma unroll
                for (int bj = 0; bj < 2; ++bj)
                    __builtin_nontemporal_store((u32x4){cvt_pk_bf16(v[bj][0][0], v[bj][0][1]), cvt_pk_bf16(v[bj][0][2], v[bj][0][3]), cvt_pk_bf16(v[bj][1][0], v[bj][1][1]), cvt_pk_bf16(v[bj][1][2], v[bj][1][3])},
                                                (u32x4*)(O + (size_t)row * 3072 + colb + bj * 32));
            }
    }
};
struct EpiPle {
    static constexpr bool PERM = true, AFTER_DRAIN = false; static constexpr int NST = 32;
    const bf16_t* xold; float* out; const bf16_t* PP; const PG8_LAS float* rst;
    __device__ __forceinline__ void operator()(const f32x4 (&acc)[2][2][4][2], const Unit& u, int wr, int wc, int fr, int fq) const {
        const int row0 = u.pm * BM + wr * 64 + fr, colb = u.pn * BM + wc * 64 + 8 * fq;
#pragma unroll
        for (int ai = 0; ai < 2; ++ai)
#pragma unroll
            for (int m = 0; m < 4; ++m) {
                const int row = row0 + ai * HALF + m * 16; const float rs = rst[u.idx * 256 + wr * 64 + fr + ai * HALF + m * 16] * -1.4426950408889634f;
#pragma unroll
                for (int bj = 0; bj < 2; ++bj) { const size_t off = (size_t)row * 1024 + colb + bj * 32;
                    const u32x4 xw = *(const u32x4*)(xold + off); const u32x4 pw = *(const u32x4*)(PP + off); f32x4 o0, o1;
                    o0[0] = __uint_as_float(xw[0] << 16); o0[1] = __uint_as_float(xw[0] & 0xffff0000u); o0[2] = __uint_as_float(xw[1] << 16); o0[3] = __uint_as_float(xw[1] & 0xffff0000u);
                    o1[0] = __uint_as_float(xw[2] << 16); o1[1] = __uint_as_float(xw[2] & 0xffff0000u); o1[2] = __uint_as_float(xw[3] << 16); o1[3] = __uint_as_float(xw[3] & 0xffff0000u);
                    f32x4 p0, p1; p0[0] = __uint_as_float(pw[0] << 16); p0[1] = __uint_as_float(pw[0] & 0xffff0000u); p0[2] = __uint_as_float(pw[1] << 16); p0[3] = __uint_as_float(pw[1] & 0xffff0000u);
                    p1[0] = __uint_as_float(pw[2] << 16); p1[1] = __uint_as_float(pw[2] & 0xffff0000u); p1[2] = __uint_as_float(pw[3] << 16); p1[3] = __uint_as_float(pw[3] & 0xffff0000u);
                    f32x4 v0, v1;
#pragma unroll
                    for (int e = 0; e < 4; ++e) { v0[e] = o0[e] + __builtin_amdgcn_rcpf(1.0f + __builtin_amdgcn_exp2f(acc[ai][bj][m][0][e] * rs)) * p0[e];
                                                  v1[e] = o1[e] + __builtin_amdgcn_rcpf(1.0f + __builtin_amdgcn_exp2f(acc[ai][bj][m][1][e] * rs)) * p1[e]; }
                    __builtin_nontemporal_store(v0, (f32x4*)(out + off)); __builtin_nontemporal_store(v1, (f32x4*)(out + off + 4)); }
            }
    }
};
template <class Epi, class Sched, bool ALIGN_EPI = false, bool SP2 = false>
__device__ __forceinline__ void gemm_phase(PG8_LAS unsigned char* lds, const Gemm g, const Sched& S, const Epi& E, int wid) {
    const int lane = lane_now(), tid = wid * 64 + lane, wr = wid >> 2, wc = wid & 3, fr = lane & 15, fq = lane >> 4;
    const int K = g.K, nt = K / BK;
    unsigned voffA[2], voffB[2];
#pragma unroll
    for (int i = 0; i < 2; ++i) { int R, C; stage_rc(tid * 16 + i * 8192, R, C); const int Rb = Epi::PERM ? ((R & ~31) + perm32(R & 31)) : R;
        voffA[i] = (unsigned)(R * K + C) * 2u; voffB[i] = (unsigned)(Rb * K + C) * 2u; }
    const size_t kstep = (size_t)(BK * 2);
    const size_t hstep = (size_t)HALF * K * 2;
    const size_t tstep = 2 * hstep;
    const unsigned ldsw = (unsigned)wid * 1024u;
    const int aoff = lds_byte(wr * 64 + fr, fq * 8), boff = lds_byte(wc * 32 + fr, fq * 8);
#define PG8_SA(b, h) (((b) * 2 + (h)) * HTB)
#define PG8_SB(b, h) ((4 + (b) * 2 + (h)) * HTB)
#define PG8_STAGE(bufoff, gbase, voff) do { _Pragma("unroll") for (int _i = 0; _i < 2; ++_i) \
        __builtin_amdgcn_global_load_lds((const unsigned*)((const char*)(gbase) + (voff)[_i]), (PG8_LAS unsigned*)(lds + (bufoff) + ldsw + _i * 8192), 16, 0, 0); } while (0)
#define PG8_LDA(dst, b, h) do { _Pragma("unroll") for (int m = 0; m < 4; ++m) _Pragma("unroll") for (int k = 0; k < 2; ++k) dst[m][k] = *(const PG8_LAS bf16x8*)(lds + PG8_SA(b, h) + aoff + m * 2048 + k * 1024); } while (0)
#define PG8_LDB(dst, b, h) do { _Pragma("unroll") for (int n = 0; n < 2; ++n) _Pragma("unroll") for (int k = 0; k < 2; ++k) dst[n][k] = *(const PG8_LAS bf16x8*)(lds + PG8_SB(b, h) + boff + n * 2048 + k * 1024); } while (0)
#define PG8_MMA(ai, bj, At, Bt) do { __builtin_amdgcn_s_setprio(1); _Pragma("unroll") for (int m = 0; m < 4; ++m) _Pragma("unroll") for (int n = 0; n < 2; ++n) _Pragma("unroll") for (int k = 0; k < 2; ++k) \
        acc[ai][bj][m][n] = __builtin_amdgcn_mfma_f32_16x16x32_bf16(Bt[n][k], At[m][k], acc[ai][bj][m][n], 0, 0, 0); __builtin_amdgcn_s_setprio(0); } while (0)
#define PG8_WAIT_V(n) asm volatile("s_waitcnt vmcnt(" #n ")" ::: "memory")
#define PG8_WAIT_L(n) asm volatile("s_waitcnt lgkmcnt(" #n ")" ::: "memory")
#define PG8_WAIT_VR(n, rlx) asm volatile("s_waitcnt vmcnt(%0)\n\ts_cmp_lg_u32 %1, 0\n\ts_cbranch_scc1 .Lpg8w%=\n\ts_waitcnt vmcnt(8)\n.Lpg8w%=:" :: "n"(n), "s"(rlx) : "memory", "scc")
#define PG8_BAR __builtin_amdgcn_s_barrier()
#define PG8_SCHED __builtin_amdgcn_sched_barrier(0)
    Unit cur, nxt; int ui = 0;
    if (!S.next(0, cur)) return;
    f32x4 acc[2][2][4][2];
#pragma unroll
    for (int a = 0; a < 2; ++a)
#pragma unroll
        for (int b = 0; b < 2; ++b)
#pragma unroll
            for (int m = 0; m < 4; ++m)
#pragma unroll
                for (int n = 0; n < 2; ++n) acc[a][b][m][n] = (f32x4){0.f, 0.f, 0.f, 0.f};
    bf16x8 At[4][2], B0[2][2], B1[2][2];
    const char* cA = (const char*)g.A + (size_t)cur.pm * tstep; const char* cB = (const char*)g.Bt + (size_t)cur.pn * tstep;
    S.a_ready(cur);
    if constexpr (SP2) {
        PG8_STAGE(PG8_SB(0, 0), cB, voffB); PG8_STAGE(PG8_SB(0, 1), cB + hstep, voffB); PG8_STAGE(PG8_SA(0, 0), cA, voffA); PG8_STAGE(PG8_SA(0, 1), cA + hstep, voffA);
        if (wr == 1) PG8_BAR;
        PG8_WAIT_V(2); PG8_BAR;
        PG8_STAGE(PG8_SB(1, 0), cB + kstep, voffB); PG8_STAGE(PG8_SA(1, 0), cA + kstep, voffA); PG8_STAGE(PG8_SB(1, 1), cB + hstep + kstep, voffB);
        PG8_WAIT_V(6); PG8_BAR;
    } else {
        PG8_STAGE(PG8_SB(0, 0), cB, voffB); PG8_STAGE(PG8_SA(0, 0), cA, voffA); PG8_STAGE(PG8_SB(0, 1), cB + hstep, voffB); PG8_STAGE(PG8_SA(0, 1), cA + hstep, voffA);
        if (wr == 1) PG8_BAR;
        PG8_WAIT_V(4); PG8_BAR;
        PG8_STAGE(PG8_SB(1, 0), cB + kstep, voffB); PG8_STAGE(PG8_SA(1, 0), cA + kstep, voffA); PG8_STAGE(PG8_SB(1, 1), cB + hstep + kstep, voffB);
        PG8_WAIT_V(6); PG8_BAR;
    }
    for (;;) {
        const bool has_next = S.next(ui + 1, nxt);
        const char* nA = has_next ? (const char*)g.A + (size_t)nxt.pm * tstep : cA; const char* nB = has_next ? (const char*)g.Bt + (size_t)nxt.pn * tstep : cB;
        for (int t = 0; t < nt; t += 2) {
            const bool last = (t == nt - 2);
            const int relax = __builtin_amdgcn_readfirstlane(((t == 0) && (ui > 0)) ? 1 : 0);
            const char* a1 = cA + (size_t)(t + 1) * kstep;
            const char* a2 = last ? nA : cA + (size_t)(t + 2) * kstep; const char* b2 = last ? nB : cB + (size_t)(t + 2) * kstep;
            const char* a3 = a2 + kstep; const char* b3 = b2 + kstep;
            if (last && has_next) S.a_ready(nxt);
            if constexpr (SP2) {
            PG8_LDB(B0, 0, 0); PG8_LDB(B1, 0, 1); PG8_SCHED; PG8_LDA(At, 0, 0); PG8_STAGE(PG8_SA(1, 1), a1 + hstep, voffA);
            PG8_WAIT_VR(8 + Epi::NST, relax); PG8_WAIT_L(0); PG8_BAR; PG8_MMA(0, 0, At, B0); PG8_MMA(0, 1, At, B1); PG8_BAR; PG8_SCHED;
            PG8_LDA(At, 0, 1); PG8_STAGE(PG8_SB(0, 0), b2, voffB); PG8_STAGE(PG8_SB(0, 1), b2 + hstep, voffB); PG8_STAGE(PG8_SA(0, 0), a2, voffA);
            PG8_WAIT_VR(8 + Epi::NST, relax); PG8_WAIT_L(0); PG8_BAR; PG8_MMA(1, 0, At, B0); PG8_MMA(1, 1, At, B1); PG8_BAR; PG8_SCHED;
            PG8_LDB(B0, 1, 0); PG8_LDB(B1, 1, 1); PG8_SCHED; PG8_LDA(At, 1, 0); PG8_STAGE(PG8_SA(0, 1), a2 + hstep, voffA);
            PG8_WAIT_V(8); PG8_WAIT_L(0); PG8_BAR; PG8_MMA(0, 0, At, B0); PG8_MMA(0, 1, At, B1); PG8_BAR; PG8_SCHED;
            PG8_LDA(At, 1, 1); PG8_STAGE(PG8_SB(1, 0), b3, voffB); PG8_STAGE(PG8_SB(1, 1), b3 + hstep, voffB); PG8_STAGE(PG8_SA(1, 0), a3, voffA);
            PG8_WAIT_V(8); PG8_WAIT_L(0); PG8_BAR; PG8_MMA(1, 0, At, B0); PG8_MMA(1, 1, At, B1); PG8_BAR; PG8_SCHED;
            } else {
            PG8_LDB(B0, 0, 0); PG8_SCHED; PG8_LDA(At, 0, 0); PG8_STAGE(PG8_SA(1, 1), a1 + hstep, voffA);
            PG8_WAIT_L(8); PG8_BAR; PG8_WAIT_L(0); PG8_MMA(0, 0, At, B0); PG8_BAR; PG8_SCHED;
            PG8_LDB(B1, 0, 1); PG8_STAGE(PG8_SB(0, 0), b2, voffB);
            PG8_BAR; PG8_WAIT_L(0); PG8_MMA(0, 1, At, B1); PG8_BAR;
            PG8_LDA(At, 0, 1); PG8_STAGE(PG8_SA(0, 0), a2, voffA);
            PG8_BAR; PG8_WAIT_L(0); PG8_MMA(1, 0, At, B0); PG8_BAR; PG8_SCHED;
            PG8_STAGE(PG8_SB(0, 1), b2 + hstep, voffB);
            PG8_WAIT_V(6); PG8_BAR; PG8_MMA(1, 1, At, B1); PG8_BAR;
            PG8_LDB(B0, 1, 0); PG8_SCHED; PG8_LDA(At, 1, 0); PG8_STAGE(PG8_SA(0, 1), a2 + hstep, voffA);
            PG8_WAIT_L(8); PG8_BAR; PG8_WAIT_L(0); PG8_MMA(0, 0, At, B0); PG8_BAR; PG8_SCHED;
            PG8_LDB(B1, 1, 1); PG8_STAGE(PG8_SB(1, 0), b3, voffB);
            PG8_BAR; PG8_WAIT_L(0); PG8_MMA(0, 1, At, B1); PG8_BAR;
            PG8_LDA(At, 1, 1); PG8_STAGE(PG8_SA(1, 0), a3, voffA);
            PG8_BAR; PG8_WAIT_L(0); PG8_MMA(1, 0, At, B0); PG8_BAR; PG8_SCHED;
            PG8_STAGE(PG8_SB(1, 1), b3 + hstep, voffB);
            PG8_WAIT_V(6); PG8_BAR; PG8_MMA(1, 1, At, B1); PG8_BAR;
            }
        }
        if constexpr (ALIGN_EPI) { if (wr == 0) PG8_BAR; }
        if constexpr (!Epi::AFTER_DRAIN) { const int ln_ = (int)__builtin_amdgcn_mbcnt_hi(~0u, __builtin_amdgcn_mbcnt_lo(~0u, 0u)); E(acc, cur, wr, wc, ln_ & 15, ln_ >> 4); S.done(cur); }
        if (!has_next) break;
#pragma unroll
        for (int a = 0; a < 2; ++a)
#pragma unroll
            for (int b = 0; b < 2; ++b)
#pragma unroll
                for (int m = 0; m < 4; ++m)
#pragma unroll
                    for (int n = 0; n < 2; ++n) acc[a][b][m][n] = (f32x4){0.f, 0.f, 0.f, 0.f};
        cur = nxt; cA = nA; cB = nB; ++ui;
        if constexpr (ALIGN_EPI) { if (wr == 1) PG8_BAR; }
    }
    PG8_WAIT_V(0);
    if constexpr (!ALIGN_EPI) { if (wr == 0) PG8_BAR; }
    PG8_BAR;
    if constexpr (Epi::AFTER_DRAIN) { E.fused(acc, cur, wr, wc, fr, fq, lds, wid, lane); S.done(cur); }
#undef PG8_SA
#undef PG8_SB
#undef PG8_STAGE
#undef PG8_LDA
#undef PG8_LDB
#undef PG8_MMA
#undef PG8_WAIT_V
#undef PG8_WAIT_L
#undef PG8_WAIT_VR
#undef PG8_BAR
#undef PG8_SCHED
}
}

constexpr int NWAVES = 8;
constexpr int BATCH = 4, SEQ = 8192, D = 1024, FF = 2816, NPROJ = 3072, PLE = 256, NH = 8, HD = 64, CONVD = 512;
constexpr int M = BATCH * SEQ;
#ifndef PROBE_DUP
#define PROBE_DUP 0
#endif
#ifndef MK_ONE_LAUNCH
#define MK_ONE_LAUNCH 1
#endif
constexpr int N_PHASES = 10;
constexpr size_t MiB = 1u << 20;
constexpr size_t WS_CTL = 0, CTL_ZERO_BYTES = 1 * MiB;
constexpr size_t WS_W1GU = 2 * MiB, WS_W1D = 13 * MiB, WS_WIN = 19 * MiB, WS_WOUT = 25 * MiB, WS_W2GU = 27 * MiB, WS_W2D = 38 * MiB, WS_WPG = 44 * MiB, WS_WPP = 46 * MiB;
constexpr size_t WS_XB = 48 * MiB;
constexpr size_t WS_PB = 112 * MiB;
constexpr size_t WS_HID = 128 * MiB;
constexpr size_t WS_YMIX = 320 * MiB;
constexpr size_t WS_PP = 384 * MiB;
constexpr size_t WS_END = 448 * MiB;
#ifndef ATTN_NAIVE
#define ATTN_NAIVE 0
#endif
constexpr float QSC = ATTN_NAIVE ? 0.125f : 0.125f * 1.4426950408889634f;
constexpr int LDS_BYTES = 147456;

#define GAS __attribute__((address_space(1)))
#define LAS __attribute__((address_space(3)))
typedef unsigned short bf16;
typedef unsigned v4u __attribute__((ext_vector_type(4)));
typedef float f32x4 __attribute__((ext_vector_type(4)));
#define LDS_WAIT() asm volatile("s_waitcnt lgkmcnt(0)" ::: "memory")
__device__ __forceinline__ unsigned pk2(float lo, float hi) { return pg8::cvt_pk_bf16(lo, hi); }
__device__ __forceinline__ float bflo(unsigned w) { return __uint_as_float(w << 16); }
__device__ __forceinline__ float bfhi(unsigned w) { return __uint_as_float(w & 0xffff0000u); }
__device__ __forceinline__ float wave_sum(float v) {
#pragma unroll
    for (int o = 1; o < 64; o <<= 1) v += __shfl_xor(v, o);
    return v;
}

#define XB_TMO      128
#define XB_XCNT(j)  (256  + 64 * (j))
#define XB_XSUB(j)  (1280 + 64 * (j))
#define XB_XGEN(j)  (2304 + 64 * (j))
#define XB_TOP      3328
#define XB_TOPGEN   3392
#define XCD_BAR_WORDS 3456
#define XB_SPIN_CAP (1u << 18)

__device__ __forceinline__ unsigned xb_ld(unsigned* p)              { return __hip_atomic_load(p, __ATOMIC_RELAXED, __HIP_MEMORY_SCOPE_AGENT); }
__device__ __forceinline__ unsigned xb_add(unsigned* p, unsigned v) { return __hip_atomic_fetch_add(p, v, __ATOMIC_RELAXED, __HIP_MEMORY_SCOPE_AGENT); }
__device__ __forceinline__ unsigned xb_xcc_id() { return (unsigned)__builtin_amdgcn_s_getreg((3 << 11) | 20) & 0xFu; }
#define XB_SPIN(cond, bar) do { unsigned _sp = 0; while (cond) { __builtin_amdgcn_s_sleep(1); \
    if ((++_sp & 255u) == 0u) { if (xb_ld(&(bar)[XB_TMO])) break; if (_sp > XB_SPIN_CAP) { atomicAdd(&(bar)[XB_TMO], 1u); break; } } } } while (0)

struct XcdBarrier {
    unsigned* bar; unsigned x;
    volatile LAS unsigned* st;
};

__device__ __forceinline__ XcdBarrier xcd_barrier_post(unsigned* bar, volatile LAS unsigned* st) {
    XcdBarrier b; b.bar = bar; b.x = xb_xcc_id(); b.st = st;
    if (threadIdx.x == 0) (void)xb_add(&bar[XB_XCNT(b.x)], 1u);
    return b;
}
__device__ __forceinline__ void xcd_barrier_complete(unsigned* bar, unsigned x, unsigned& nloc, unsigned& nx) {
    const unsigned G = gridDim.x * gridDim.y * gridDim.z;
    unsigned sum, cnt, mine, sp = 0u;
    for (;;) {
        sum = 0u; cnt = 0u; mine = 0u;
#pragma unroll
        for (unsigned j = 0; j < 16; ++j) { const unsigned c = xb_ld(&bar[XB_XCNT(j)]); sum += c; cnt += (c > 0u) ? 1u : 0u; mine = (j == x) ? c : mine; }
        if (sum == G) break;
        __builtin_amdgcn_s_sleep(1);
        if ((++sp & 255u) == 0u) { if (xb_ld(&bar[XB_TMO])) break; if (sp > XB_SPIN_CAP) { atomicAdd(&bar[XB_TMO], 1u); break; } }
    }
    nloc = mine > 0u ? mine : 1u; nx = cnt > 0u ? cnt : 1u;
}

__device__ __forceinline__ void xcd_barrier(const XcdBarrier& b, int wave) {
    asm volatile("s_waitcnt vmcnt(0)" ::: "memory");
    __syncthreads();
    if (wave == 0 && lane_now() == 0) {
        unsigned* bar = b.bar;
        __builtin_amdgcn_s_waitcnt(0);
        unsigned nloc = b.st[0], nx = b.st[1];
        if (nloc == 0u) { xcd_barrier_complete(bar, b.x, nloc, nx); b.st[0] = nloc; b.st[1] = nx; }
        const unsigned old = xb_add(&bar[XB_XSUB(b.x)], 1u);
        const unsigned gen = old / nloc;
        if (old + 1u == (gen + 1u) * nloc) {
            __builtin_amdgcn_fence(__ATOMIC_RELEASE, "agent");
            asm volatile("s_waitcnt vmcnt(0)" ::: "memory");
            const unsigned og = xb_add(&bar[XB_TOP], 1u);
            const unsigned tg = og / nx;
            if (og + 1u == (tg + 1u) * nx) xb_add(&bar[XB_TOPGEN], 1u);
            else XB_SPIN(xb_ld(&bar[XB_TOPGEN]) == tg, bar);
            __builtin_amdgcn_fence(__ATOMIC_ACQUIRE, "agent");
            xb_add(&bar[XB_XGEN(b.x)], 1u);
            asm volatile("s_waitcnt vmcnt(0)" ::: "memory");
        } else {
            XB_SPIN(xb_ld(&bar[XB_XGEN(b.x)]) == gen, bar);
            __builtin_amdgcn_fence(__ATOMIC_ACQUIRE, "agent");
            asm volatile("s_waitcnt vmcnt(0)" ::: "memory");
        }
    }
    __syncthreads();
}

constexpr size_t WS_BAR = 768 * 1024;
__device__ unsigned g_bar[XCD_BAR_WORDS + 64];
struct Args { const float* in[20]; float* out; unsigned char* ws; int ph_lo, ph_hi; };

__device__ __forceinline__ void tr_item(const float* __restrict__ W, int K, int N, const float* __restrict__ gain, bf16* __restrict__ WT, int dst_row0, LAS float* scr, int k0, int n0, int lane) {
    float w[32]; const float* wp = W + (size_t)(k0 + (lane >> 5)) * N + n0 + (lane & 31);
#pragma unroll
    for (int i = 0; i < 32; ++i) w[i] = __builtin_nontemporal_load(wp + (size_t)(2 * i) * N);
    if (gain) {
#pragma unroll
        for (int i = 0; i < 32; ++i) w[i] *= gain[k0 + 2 * i + (lane >> 5)];
    }
#pragma unroll
    for (int i = 0; i < 32; ++i) scr[(2 * i + (lane >> 5)) * 33 + (lane & 31)] = w[i];
    LDS_WAIT(); asm volatile("" ::: "memory");
    const int c = lane & 7;
#pragma unroll
    for (int j = 0; j < 4; ++j) { const int n = (lane >> 3) + 8 * j; const LAS float* s = scr + (8 * c) * 33 + n;
        v4u o; o.x = pk2(s[0 * 33], s[1 * 33]); o.y = pk2(s[2 * 33], s[3 * 33]); o.z = pk2(s[4 * 33], s[5 * 33]); o.w = pk2(s[6 * 33], s[7 * 33]);
        *(v4u*)(WT + (size_t)(dst_row0 + n) * K + k0 + 8 * c) = o; }
    LDS_WAIT(); asm volatile("" ::: "memory");
}
__device__ __forceinline__ bool tr_matrix(int& r, const float* W, int K, int N, const float* gain, bf16* WT, int mode, LAS float* scr, int lane) {
    const int nblk = N / 32, items = (K / 64) * nblk;
    if (r >= items) { r -= items; return false; }
    const int kb = r / nblk, nb = r % nblk, n0 = 32 * nb;
    int dst;
    if (mode == 4 && n0 >= 512 && n0 < 1536) { const int ch = (n0 - 512) & 511; dst = 256 * (2 + (ch >> 7)) + (n0 >= 1024 ? 128 : 0) + (ch & 127); }
    else if (mode >= 3) dst = 256 * (n0 >> 8) + 128 * ((n0 >> 5) & 1) + 32 * ((n0 >> 6) & 3);
    else dst = 256 * (n0 >> 7) + (n0 & 127) + (mode == 2 ? 128 : 0);
    tr_item(W, K, N, gain, WT, dst, scr, 64 * kb, n0, lane);
    return true;
}
__device__ __forceinline__ void p0_prep(const Args& a, LAS unsigned char* lds, int gw, int NGW, int lane, int wave) {
    unsigned char* ws = a.ws;
    LAS float* scr = (LAS float*)(lds + wave * 16384);
    constexpr int I_GU = (D / 64) * (FF / 32), I_DN = (FF / 64) * (D / 32), I_IN = (D / 64) * (NPROJ / 32), I_SQ = (D / 64) * (D / 32), I_PP = (PLE / 64) * (D / 32);
    constexpr int NITEMS = 4 * I_GU + 2 * I_DN + I_IN + 2 * I_SQ + I_PP;
    for (int it = gw; it < NITEMS; it += NGW) {
        int r = it;
        if (tr_matrix(r, a.in[3], D, FF, a.in[2], (bf16*)(ws + WS_W1GU), 1, scr, lane)) continue;
        if (tr_matrix(r, a.in[4], D, FF, a.in[2], (bf16*)(ws + WS_W1GU), 2, scr, lane)) continue;
        if (tr_matrix(r, a.in[14], D, FF, a.in[13], (bf16*)(ws + WS_W2GU), 1, scr, lane)) continue;
        if (tr_matrix(r, a.in[15], D, FF, a.in[13], (bf16*)(ws + WS_W2GU), 2, scr, lane)) continue;
        if (tr_matrix(r, a.in[5], FF, D, nullptr, (bf16*)(ws + WS_W1D), 3, scr, lane)) continue;
        if (tr_matrix(r, a.in[16], FF, D, nullptr, (bf16*)(ws + WS_W2D), 3, scr, lane)) continue;
        if (tr_matrix(r, a.in[7], D, NPROJ, a.in[6], (bf16*)(ws + WS_WIN), 4, scr, lane)) continue;
        if (tr_matrix(r, a.in[12], D, D, nullptr, (bf16*)(ws + WS_WOUT), 3, scr, lane)) continue;
        if (tr_matrix(r, a.in[18], D, D, a.in[17], (bf16*)(ws + WS_WPG), 3, scr, lane)) continue;
        tr_matrix(r, a.in[19], PLE, D, nullptr, (bf16*)(ws + WS_WPP), 3, scr, lane);
    }
    const float* __restrict__ x = a.in[0]; bf16* __restrict__ XB = (bf16*)(ws + WS_XB); float* __restrict__ ss1 = (float*)(ws + WS_CTL);
    for (int m0 = gw * 8; m0 < M; m0 += NGW * 8) {
        f32x4 v[8][4];
#pragma unroll
        for (int r = 0; r < 8; ++r)
#pragma unroll
            for (int j = 0; j < 4; ++j) v[r][j] = __builtin_nontemporal_load((const f32x4*)(x + (size_t)(m0 + r) * D) + lane + 64 * j);
#pragma unroll
        for (int r = 0; r < 8; ++r) { float s = 0.f;
#pragma unroll
            for (int j = 0; j < 4; ++j) s += (v[r][j].x * v[r][j].x + v[r][j].y * v[r][j].y) + (v[r][j].z * v[r][j].z + v[r][j].w * v[r][j].w);
            s = wave_sum(s);
            unsigned long long* o8 = (unsigned long long*)(XB + (size_t)(m0 + r) * D) + lane;
#pragma unroll
            for (int j = 0; j < 4; ++j) o8[64 * j] = (unsigned long long)pk2(v[r][j].x, v[r][j].y) | ((unsigned long long)pk2(v[r][j].z, v[r][j].w) << 32);
            if (lane == 0) ss1[m0 + r] = s; }
    }
    for (int i = gw * 64 + lane; i < 3 * M; i += NGW * 64) ss1[M + i] = 0.f;
    const float* __restrict__ p = a.in[1]; bf16* __restrict__ PB = (bf16*)(ws + WS_PB);
    for (int i0 = gw * 64 + lane; i0 < M * PLE / 8; i0 += NGW * 64 * 4) {
        f32x4 v0[4], v1[4];
#pragma unroll
        for (int r = 0; r < 4; ++r) { const size_t i = (size_t)i0 + (size_t)r * NGW * 64; v0[r] = __builtin_nontemporal_load((const f32x4*)(p + i * 8)); v1[r] = __builtin_nontemporal_load((const f32x4*)(p + i * 8 + 4)); }
#pragma unroll
        for (int r = 0; r < 4; ++r) { const size_t i = (size_t)i0 + (size_t)r * NGW * 64; *(v4u*)(PB + i * 8) = (v4u){pk2(v0[r].x, v0[r].y), pk2(v0[r].z, v0[r].w), pk2(v1[r].x, v1[r].y), pk2(v1[r].z, v1[r].w)}; }
    }
}

__device__ __forceinline__ void unpack8(const v4u w, float (&f)[8]) { f[0] = bflo(w.x); f[1] = bfhi(w.x); f[2] = bflo(w.y); f[3] = bfhi(w.y); f[4] = bflo(w.z); f[5] = bfhi(w.z); f[6] = bflo(w.w); f[7] = bfhi(w.w); }
__device__ __forceinline__ v4u pack8(const float (&f)[8]) { return (v4u){pk2(f[0], f[1]), pk2(f[2], f[3]), pk2(f[4], f[5]), pk2(f[6], f[7])}; }
__device__ __forceinline__ void conv_phase(const Args& a, int gw, int NGW, int lane) {
    const bf16* __restrict__ PROJ = (const bf16*)(a.ws + WS_HID); bf16* __restrict__ YMIX = (bf16*)(a.ws + WS_YMIX);
    const float* cw = a.in[8]; const float* cbp = a.in[9];
    float w0[8], w1[8], w2[8], cb[8];
#pragma unroll
    for (int i = 0; i < 8; ++i) { w0[i] = cw[8 * lane + i]; w1[i] = cw[CONVD + 8 * lane + i]; w2[i] = cw[2 * CONVD + 8 * lane + i]; cb[i] = cbp[8 * lane + i]; }
    for (int ch = gw; ch < M / 16; ch += NGW) {
        const int r0 = ch * 16; const bool first = (r0 & (SEQ - 1)) == 0;
        const bf16* pr = PROJ + (size_t)r0 * NPROJ + 8 * lane;
        float z1[8], z2[8];
        { const bf16* q2 = pr - (first ? 0 : 2 * NPROJ); const bf16* q1 = pr - (first ? 0 : NPROJ);
          float c[8]; unpack8(*(const v4u*)(q2 + 512), c);
#pragma unroll
          for (int i = 0; i < 8; ++i) z2[i] = first ? 0.f : c[i];
          unpack8(*(const v4u*)(q1 + 512), c);
#pragma unroll
          for (int i = 0; i < 8; ++i) z1[i] = first ? 0.f : c[i]; }
#pragma unroll 1
        for (int s4 = 0; s4 < 4; ++s4) {
            const bf16* ps = pr + (size_t)(4 * s4) * NPROJ;
            v4u bw[4], cwv[4];
#pragma unroll
            for (int r = 0; r < 4; ++r) { bw[r] = *(const v4u*)(ps + (size_t)r * NPROJ); cwv[r] = *(const v4u*)(ps + (size_t)r * NPROJ + 512); }
#pragma unroll
            for (int r = 0; r < 4; ++r) { float b[8], c[8], y[8]; unpack8(bw[r], b); unpack8(cwv[r], c);
#pragma unroll
                for (int i = 0; i < 8; ++i) { const float z0 = c[i]; y[i] = b[i] * (w0[i] * z2[i] + w1[i] * z1[i] + w2[i] * z0 + cb[i]); z2[i] = z1[i]; z1[i] = z0; }
                *(v4u*)(YMIX + (size_t)(r0 + 4 * s4 + r) * D + 8 * lane) = pack8(y); }
        }
    }
}

__device__ __forceinline__ void p5_attn_naive(const Args& a, int tid) {
    const bf16* PROJ = (const bf16*)(a.ws + WS_HID); bf16* YMIX = (bf16*)(a.ws + WS_YMIX);
    for (int un = blockIdx.x; un < 512; un += gridDim.x) {
        const int bh = un & 31, r = un >> 5, qq = r < 8 ? r : 23 - r, b = bh >> 3, h = bh & 7;
        const int t = qq * 512 + tid;
        const bf16* base = PROJ + (size_t)b * SEQ * NPROJ + h * HD;
        float q[64], o[64];
#pragma unroll
        for (int c = 0; c < 8; ++c) { float f[8]; unpack8(*(const v4u*)(base + (size_t)t * NPROJ + 1536 + 8 * c), f);
#pragma unroll
            for (int e = 0; e < 8; ++e) { q[8 * c + e] = f[e]; o[8 * c + e] = 0.f; } }
        float carry = 0.f;
        for (int j = qq * 512 + 511; j >= 0; --j) {
            const bf16* kr = base + (size_t)j * NPROJ + 2048; float z = 0.f;
#pragma unroll
            for (int c = 0; c < 8; ++c) { float f[8]; unpack8(*(const v4u*)(kr + 8 * c), f);
#pragma unroll
                for (int e = 0; e < 8; ++e) z += q[8 * c + e] * f[e]; }
            const bool act = j < t;
            const float sp = fmaxf(z, 0.f) + __logf(1.0f + __expf(-fabsf(z)));
            const float av = act ? __expf(z - sp + carry) : 0.f;
            carry -= act ? sp : 0.f;
            const bf16* vr = kr + 512;
#pragma unroll
            for (int c = 0; c < 8; ++c) { float f[8]; unpack8(*(const v4u*)(vr + 8 * c), f);
#pragma unroll
                for (int e = 0; e < 8; ++e) o[8 * c + e] += av * f[e]; }
        }
        bf16* orow = YMIX + (size_t)(b * SEQ + t) * D + 512 + h * HD;
#pragma unroll
        for (int c = 0; c < 8; ++c) { float f[8];
#pragma unroll
            for (int e = 0; e < 8; ++e) f[e] = o[8 * c + e];
            *(v4u*)(orow + 8 * c) = pack8(f); }
    }
}

namespace sba {
using bf16x8 = __attribute__((ext_vector_type(8))) short;
using s16x4 = __attribute__((ext_vector_type(4))) short;
using f32x16 = __attribute__((ext_vector_type(16))) float;
typedef short v4i16_t __attribute__((ext_vector_type(4)));
typedef float f32x2_t __attribute__((ext_vector_type(2))); typedef __bf16 bf16x2_t __attribute__((ext_vector_type(2)));
typedef __attribute__((address_space(3))) const char* lds_cptr;
constexpr int SLOTB = 8192, LDS_K = 0, LDS_V = 3 * SLOTB, LDS_FLG = 6 * SLOTB, LDS_OST = 65536;
constexpr float CARRY_DEAD = 1e-30f;
__device__ __forceinline__ void glds16(const void* gbase, unsigned voff, unsigned lds_dst) { unsigned keep;
    asm volatile("s_mov_b32 %0, m0\n\ts_mov_b32 m0, %3\n\ts_nop 0\n\tglobal_load_lds_dwordx4 %1, %2\n\ts_mov_b32 m0, %0" : "=&s"(keep) : "v"(voff), "s"(gbase), "s"(lds_dst) : "memory"); }
__device__ __forceinline__ unsigned cvtpk_s(float lo, float hi) { f32x2_t v = {lo, hi}; bf16x2_t b = __builtin_convertvector(v, bf16x2_t); return __builtin_bit_cast(unsigned, b); }
__device__ __forceinline__ s16x4 vtr(lds_cptr p) { return __builtin_bit_cast(s16x4, __builtin_amdgcn_ds_read_tr16_b64_v4i16((__attribute__((address_space(3))) v4i16_t*)p)); }
#define SBA_MFMA(a, b, c) __builtin_amdgcn_mfma_f32_32x32x16_bf16((a), (b), (c), 0, 0, 0)

#define SBA_WAIT_BAR() asm volatile("s_waitcnt vmcnt(0) lgkmcnt(0)\n\ts_barrier" ::: "memory")
#define SBA_SBAR() do {} while (0)
struct Ctx { const unsigned short* Kh; unsigned koff, voff; unsigned kdst, vdst;     lds_cptr kp0, vp0; __attribute__((address_space(3))) unsigned* flg; int NT, qrel, hi, wid, lane; int s_cur, s_nxt, s_nn; int walive; };
__device__ __forceinline__ void band_mask(f32x16& p0, f32x16& p1, int jb, int qrel, int hi) {
    const int kb = 64 * jb + 4 * hi;
#pragma unroll
    for (int r = 0; r < 16; ++r) { const int kv = kb + (r & 3) + 8 * (r >> 2); if (kv >= qrel) p0[r] = -INFINITY; if (kv + 32 >= qrel) p1[r] = -INFINITY; }
}
__device__ __forceinline__ bool step(Ctx& c, int t, const f32x16& PC0, const f32x16& PC1, f32x16& PN0, f32x16& PN1, f32x16 (&o)[2], const bf16x8 (&qr)[4], float& carry) {
    SBA_WAIT_BAR();
    if (t < c.NT - 1) {
        const __attribute__((address_space(3))) v4u* f = (const __attribute__((address_space(3))) v4u*)(c.flg + ((t + 1) & 1) * 8); const v4u f0 = f[0], f1 = f[1];
        if (((f0.x | f0.y) | (f0.z | f0.w) | (f1.x | f1.y) | (f1.z | f1.w)) == 0u) return false;
    }
    if (t >= 2) { const unsigned short* tb = c.Kh + (size_t)(t - 2) * 64 * NPROJ; glds16(tb, c.koff, (unsigned)__builtin_amdgcn_readfirstlane(c.kdst + c.s_nn)); glds16(tb, c.voff, (unsigned)__builtin_amdgcn_readfirstlane(c.vdst + c.s_nn)); }
    const bool qk = c.walive != 0;
    const bool act = qk && !(t >= c.NT - 4 && (t - (c.NT - 4)) > (c.wid >> 1));
    bf16x8 kf[8]; s16x4 vlo[8], vhi[8];
    const lds_cptr kp = c.kp0 + c.s_nxt; const lds_cptr vp = c.vp0 + c.s_cur;
#define SBA_LDK(d0) do { kf[2 * (d0)] = *(const __attribute__((address_space(3))) bf16x8*)(kp + (d0) * 2048); kf[2 * (d0) + 1] = *(const __attribute__((address_space(3))) bf16x8*)(kp + (d0) * 2048 + 512); } while (0)
#define SBA_LDV(i) do { vlo[i] = vtr(vp + ((i) >> 2) * 4096 + ((i) & 3) * 1024); vhi[i] = vtr(vp + ((i) >> 2) * 4096 + ((i) & 3) * 1024 + 512); } while (0)
    if (qk) SBA_LDK(0);
    const f32x16 zero16 = f32x16{};
    float st = carry; unsigned pw[4][4];
#define VFR(i) ((bf16x8){vlo[i][0], vlo[i][1], vlo[i][2], vlo[i][3], vhi[i][0], vhi[i][1], vhi[i][2], vhi[i][3]})
#define PAF(ks) __builtin_bit_cast(bf16x8, (v4u){pw[ks][0], pw[ks][1], pw[ks][2], pw[ks][3]})
#pragma unroll
    for (int jj = 0; jj < 4; ++jj) {
        const int ks = 3 - jj, p = ks >> 1;
        SBA_SBAR();
        if (qk) { if (jj < 3) SBA_LDK(jj + 1);
            PN0 = SBA_MFMA(kf[2 * jj], qr[jj], jj ? PN0 : zero16); PN1 = SBA_MFMA(kf[2 * jj + 1], qr[jj], jj ? PN1 : zero16); }
        if (act) {
            SBA_LDV(ks); SBA_LDV(4 + ks);
            if (jj >= 1) { o[0] = SBA_MFMA(PAF(ks + 1), VFR(ks + 1), o[0]); o[1] = SBA_MFMA(PAF(ks + 1), VFR(4 + ks + 1), o[1]); }
            float a8[8];
#pragma unroll
            for (int gi = 0; gi < 2; ++gi) {
                const int g = 2 * (ks & 1) + 1 - gi; float k4[4];
#pragma unroll
                for (int e = 0; e < 4; ++e) { const float z = p ? PC1[4 * g + e] : PC0[4 * g + e]; k4[e] = __builtin_amdgcn_rcpf(1.0f + __builtin_amdgcn_exp2f(z)); }
                const float r3 = k4[3], r2 = r3 * k4[2], r1 = r2 * k4[1], G = r1 * k4[0];
                const auto rr = __builtin_amdgcn_permlane32_swap(__float_as_uint(G), __float_as_uint(G), false, false);
                const float Glo = __uint_as_float(rr[0]), Ghi = __uint_as_float(rr[1]);
                const float base = st * (c.hi ? 1.0f : Ghi);
                a8[4 * (1 - gi) + 3] = base * (1.0f - r3); a8[4 * (1 - gi) + 2] = base * (r3 - r2); a8[4 * (1 - gi) + 1] = base * (r2 - r1); a8[4 * (1 - gi)] = base * (r1 - G);
                st = st * (Glo * Ghi);
            }
#pragma unroll
            for (int i = 0; i < 4; ++i) pw[ks][i] = cvtpk_s(a8[2 * i], a8[2 * i + 1]);
        }
    }
    SBA_SBAR();
    if (act) {
        o[0] = SBA_MFMA(PAF(0), VFR(0), o[0]); o[1] = SBA_MFMA(PAF(0), VFR(4), o[1]);
        carry = st;
        const unsigned long long alive = __ballot(st > CARRY_DEAD); c.walive = alive ? 1 : 0;
    }
#undef VFR
#undef PAF
#undef SBA_LDK
#undef SBA_LDV
    if (c.lane == 0) c.flg[(t & 1) * 8 + c.wid] = (unsigned)c.walive;
    if (qk && t - 1 >= c.NT - 4) band_mask(PN0, PN1, t - 1 - (c.NT - 4), c.qrel, c.hi);
    { const int s = c.s_cur; c.s_cur = c.s_nxt; c.s_nxt = c.s_nn; c.s_nn = s; }
    return true;
}
__device__ __forceinline__ void unit(int b, int hd, int qb, const unsigned short* PROJ, unsigned short* YMIX, char* shm, int wid) {
    const int lane = lane_now(), r32 = lane & 31, hi = lane >> 5;
    const size_t rowbase = (size_t)b * SEQ; const int q0 = qb * 256;
    const unsigned short* Qw = PROJ + (rowbase + q0 + wid * 32) * NPROJ + 1536 + hd * 64;
    const unsigned short* Kh = PROJ + rowbase * NPROJ + 2048 + hd * 64; const unsigned short* Vh = Kh + 512;
    const unsigned lds0 = (unsigned)(uintptr_t)shm;
    const lds_cptr shm3 = (lds_cptr)shm;
    Ctx c;
    c.Kh = Kh;
    c.koff = (unsigned)(lane * NPROJ + wid * 8) * 2u;
    c.voff = (unsigned)((16 * (wid & 3) + (lane >> 2)) * NPROJ + 512 + (wid >> 2) * 32 + (lane & 3) * 8) * 2u;
    c.kdst = lds0 + LDS_K + wid * 1024; c.vdst = lds0 + LDS_V + wid * 1024;
    c.kp0 = shm3 + LDS_K + hi * 1024 + r32 * 16;
    c.vp0 = shm3 + LDS_V + ((lane >> 4) & 1) * 32 + (lane & 3) * 8 + (4 * hi + ((lane & 15) >> 2)) * 64;
    c.flg = (__attribute__((address_space(3))) unsigned*)(shm3 + LDS_FLG); c.wid = wid; c.lane = lane;
    c.NT = 4 * (qb + 1); c.qrel = wid * 32 + r32; c.hi = hi; c.s_cur = 0; c.s_nxt = SLOTB; c.s_nn = 2 * SLOTB; c.walive = 1;
    const int NT = c.NT;
    asm volatile("s_waitcnt lgkmcnt(0)\n\ts_barrier" ::: "memory");
    { const unsigned short* t1 = Kh + (size_t)(NT - 1) * 64 * NPROJ; const unsigned short* t2 = Kh + (size_t)(NT - 2) * 64 * NPROJ;
      glds16(t1, c.koff, (unsigned)__builtin_amdgcn_readfirstlane(c.kdst)); glds16(t1, c.voff, (unsigned)__builtin_amdgcn_readfirstlane(c.vdst));
      glds16(t2, c.koff, (unsigned)__builtin_amdgcn_readfirstlane(c.kdst + SLOTB)); glds16(t2, c.voff, (unsigned)__builtin_amdgcn_readfirstlane(c.vdst + SLOTB)); }
    bf16x8 qr[4];
#pragma unroll
    for (int d0 = 0; d0 < 4; ++d0) qr[d0] = *reinterpret_cast<const bf16x8*>(&Qw[(size_t)r32 * NPROJ + d0 * 16 + hi * 8]);
    f32x16 o[2]; o[0] = f32x16{}; o[1] = f32x16{};
    float carry = 1.0f;
    SBA_WAIT_BAR();
    f32x16 pA0, pA1, pB0, pB1;
    { const f32x16 zero16 = f32x16{};
#pragma unroll
      for (int d0 = 0; d0 < 4; ++d0) {
          const bf16x8 b0 = *(const __attribute__((address_space(3))) bf16x8*)(c.kp0 + d0 * 2048);
          const bf16x8 b1 = *(const __attribute__((address_space(3))) bf16x8*)(c.kp0 + d0 * 2048 + 512);
          pA0 = SBA_MFMA(b0, qr[d0], d0 ? pA0 : zero16); pA1 = SBA_MFMA(b1, qr[d0], d0 ? pA1 : zero16);
      }
      band_mask(pA0, pA1, 3, c.qrel, hi); }
    for (int t = NT - 1; t > 0; t -= 2) {
        if (!step(c, t, pA0, pA1, pB0, pB1, o, qr, carry)) break;
        if (!step(c, t - 1, pB0, pB1, pA0, pA1, o, qr, carry)) break;
    }
    unsigned short* Ow = YMIX + (rowbase + q0 + wid * 32) * D + 512 + hd * 64;
    { __attribute__((address_space(3))) unsigned short* stg = (__attribute__((address_space(3))) unsigned short*)(shm3 + LDS_OST + wid * 4096);
#pragma unroll
      for (int r = 0; r < 16; ++r) { const int orow = (r & 3) + 8 * (r >> 2) + 4 * hi;
#pragma unroll
          for (int d0 = 0; d0 < 2; ++d0) stg[orow * 64 + d0 * 32 + r32] = (unsigned short)(cvtpk_s(o[d0][r], 0.f) & 0xffffu); }
      asm volatile("s_waitcnt lgkmcnt(0)" ::: "memory");
#pragma unroll
      for (int i = 0; i < 4; ++i) { const int row = i * 8 + (lane >> 3), ch = lane & 7; const v4u v = *(const __attribute__((address_space(3))) v4u*)(stg + row * 64 + ch * 8); *(v4u*)(Ow + (size_t)row * D + ch * 8) = v; } }
}
__device__ __forceinline__ void phase(const unsigned short* PROJ, unsigned short* YMIX, char* shm, int bx, int wid) {
    const int G = gridDim.x; const int vcu = (G % 8 == 0) ? (bx % 8) * (G / 8) + bx / 8 : bx;
    for (int v = vcu; v < 256; v += G) { const int bh = v >> 3, s = v & 7;
#pragma unroll 1
        for (int i = 0; i < 4; ++i) { const int qb = (i == 0) ? 31 - s : (i == 1) ? 16 + s : (i == 2) ? 15 - s : s; unit(bh >> 3, bh & 7, qb, PROJ, YMIX, shm, wid); } }
}
}

__global__ void __launch_bounds__(NWAVES * 64, 2) mk_fwd(Args args) {
    extern __shared__ __attribute__((aligned(16))) unsigned char lds_raw[];
    LAS unsigned char* lds = (LAS unsigned char*)lds_raw;
    const int wave = __builtin_amdgcn_readfirstlane((int)threadIdx.x >> 6);
#define LANE_NOW() lane_now()
#define TID_NOW() (wave * 64 + lane_now())
    const int G = gridDim.x, gw = blockIdx.x * NWAVES + wave, NGW = G * NWAVES;
    unsigned char* const ws0 = args.ws;
#define PHASE_PTRS() unsigned char* ws = ws0; const Args* ap = (const Args*)__builtin_amdgcn_kernarg_segment_ptr(); asm volatile("" : "+s"(ws), "+s"(ap)); \
    float* ss1 = (float*)(ws + WS_CTL); float* ss2 = ss1 + M; float* ss3 = ss2 + M; float* ss4 = ss3 + M; (void)ss1; (void)ss2; (void)ss3; (void)ss4; \
    bf16* XB = (bf16*)(ws + WS_XB); bf16* PB = (bf16*)(ws + WS_PB); bf16* HID = (bf16*)(ws + WS_HID); bf16* PROJ = HID; bf16* YMIX = (bf16*)(ws + WS_YMIX); bf16* PP = (bf16*)(ws + WS_PP); (void)XB; (void)PB; (void)HID; (void)PROJ; (void)YMIX; (void)PP
    const int lo = args.ph_lo, hi = args.ph_hi;
    volatile LAS unsigned* MISC = (volatile LAS unsigned*)(lds + 131072);
    { const int tid = TID_NOW(); if (tid < 32) MISC[tid] = 0u; }
    __syncthreads();
    XcdBarrier bar; bar.bar = g_bar; bar.x = 0; bar.st = nullptr;
    if (hi - lo > 1) { bar.x = xb_xcc_id(); bar.st = MISC + 8;
        if (TID_NOW() == 0) MISC[10] = xb_add(&bar.bar[XB_XCNT(bar.x)], 1u); }
    __syncthreads();
#define IN(k) (lo <= (k) && (k) < hi)
#define SEAM(k) do { if (IN(k) && IN((k) + 1)) { if ((k) == 0 && hi == 0x7fffffff) cg::this_grid().sync(); else xcd_barrier(bar, wave); } } while (0)
    typedef pg8::StaticOrder SO;
    LAS float* rst = (LAS float*)(lds + 131072 + 256);
#define FILL_RS(S_, ss_) do { pg8::Unit u_; const int tid_ = TID_NOW(); for (int i_ = 0; (S_).next(i_, u_); ++i_) if (tid_ < 256) rst[i_ * 256 + tid_] = pg8::rs_of((ss_)[u_.pm * 256 + tid_]); __syncthreads(); } while (0)
    if (IN(0)) { PHASE_PTRS(); p0_prep(*ap, lds, gw, NGW, LANE_NOW(), wave); } SEAM(0);
    int vc = (int)blockIdx.x;
    if (hi - lo > 1) {
        if (TID_NOW() == 0) { unsigned ok = (G % 8 == 0) ? 1u : 0u, nz = 0u, slot = 0u;
            for (unsigned j = 0; j < 16; ++j) { const unsigned cj = xb_ld(&bar.bar[XB_XCNT(j)]); if (cj) { ++nz; if (cj != (unsigned)G / 8u) ok = 0u; if (j < bar.x) ++slot; } }
            if (nz != 8u) ok = 0u;
            MISC[11] = ok ? (MISC[10] * 8u + slot) : (unsigned)blockIdx.x; }
        __syncthreads();
        vc = (int)MISC[11];
    }
    if (IN(1)) { PHASE_PTRS();
        { pg8::Gemm g{XB, (const bf16*)(ws + WS_W1GU), M, 2 * FF, D}; SO S; S.init(M, 2 * FF, G, vc); FILL_RS(S, ss1); pg8::EpiSwiGLU E{HID, FF, rst};
          pg8::gemm_phase<pg8::EpiSwiGLU, SO, true, true>(lds, g, S, E, wave); }
        { pg8::Gemm g{PB, (const bf16*)(ws + WS_WPP), M, D, PLE}; SO S; S.init(M, D, G, vc); pg8::EpiScaleBf16 E{PP, D, nullptr};
          pg8::gemm_phase<pg8::EpiScaleBf16, SO, true, true>(lds, g, S, E, wave); }
    } SEAM(1);
    if (IN(2)) { PHASE_PTRS(); pg8::Gemm g{HID, (const bf16*)(ws + WS_W1D), M, D, FF}; SO S; S.init(M, D, G, vc); pg8::EpiResid<false> E{nullptr, XB, ss2, 0.5f};
        pg8::gemm_phase<pg8::EpiResid<false>, SO, true, true>(lds, g, S, E, wave); } SEAM(2);
    if (IN(3)) { PHASE_PTRS(); pg8::Gemm g{XB, (const bf16*)(ws + WS_WIN), M, NPROJ, D}; SO S; S.init(M, NPROJ, G, vc); { const int t_ = TID_NOW(); if (t_ < 64) rst[2816 + t_] = ap->in[10][t_] * QSC; else if (t_ < 128) rst[2816 + t_] = ap->in[11][t_ - 64]; } FILL_RS(S, ss2); pg8::EpiProj E{PROJ, rst, rst + 2816};
        pg8::gemm_phase<pg8::EpiProj, SO, true, true>(lds, g, S, E, wave); } SEAM(3);
    if (IN(5)) { PHASE_PTRS(); if (ATTN_NAIVE) p5_attn_naive(*ap, TID_NOW()); else sba::phase(PROJ, YMIX, (char*)lds_raw, vc, wave); conv_phase(*ap, gw, NGW, LANE_NOW()); } SEAM(5);
    if (IN(6)) { PHASE_PTRS(); pg8::Gemm g{YMIX, (const bf16*)(ws + WS_WOUT), M, D, D}; SO S; S.init(M, D, G, vc); pg8::EpiResid<false> E{nullptr, XB, ss3, 1.0f};
        pg8::gemm_phase<pg8::EpiResid<false>, SO, true, true>(lds, g, S, E, wave); } SEAM(6);
    if (IN(7)) { PHASE_PTRS(); pg8::Gemm g{XB, (const bf16*)(ws + WS_W2GU), M, 2 * FF, D}; SO S; S.init(M, 2 * FF, G, vc); FILL_RS(S, ss3); pg8::EpiSwiGLU E{HID, FF, rst};
        pg8::gemm_phase<pg8::EpiSwiGLU, SO, true, true>(lds, g, S, E, wave); } SEAM(7);
    if (IN(8)) { PHASE_PTRS(); pg8::Gemm g{HID, (const bf16*)(ws + WS_W2D), M, D, FF}; SO S; S.init(M, D, G, vc); pg8::EpiResid<false> E{nullptr, XB, ss4, 0.5f};
        pg8::gemm_phase<pg8::EpiResid<false>, SO, true, true>(lds, g, S, E, wave); } SEAM(8);
    if (IN(9)) { PHASE_PTRS(); pg8::Gemm g{XB, (const bf16*)(ws + WS_WPG), M, D, D}; SO S; S.init(M, D, G, vc); FILL_RS(S, ss4); pg8::EpiPle E{XB, ap->out, PP, rst};
        pg8::gemm_phase<pg8::EpiPle, SO, true, true>(lds, g, S, E, wave); }
    if (hi - lo > 1) {
        __syncthreads();
        const int t_ = TID_NOW();
        if (t_ == 0) MISC[12] = (xb_add(&g_bar[XCD_BAR_WORDS], 1u) == (unsigned)G - 1u) ? 1u : 0u;
        __syncthreads();
        if (MISC[12]) { for (int i_ = t_; i_ < XCD_BAR_WORDS + 1; i_ += NWAVES * 64) __hip_atomic_store(&g_bar[i_], 0u, __ATOMIC_RELAXED, __HIP_MEMORY_SCOPE_AGENT); }
    }
#undef IN
#undef SEAM
}

extern "C" void kernel_launch(void* const* d_in, const int* in_sizes, int n_in, void* d_out, int out_size, void* d_ws, size_t ws_size, hipStream_t stream) {
    static int grid = 0;
    if (grid == 0) {
        if (n_in != 20 || out_size != M * D || ws_size < WS_END) { fprintf(stderr, "kernel_launch: unexpected shapes (n_in %d out %d ws %zu)\n", n_in, out_size, ws_size); grid = -1; return; }
        int dev = 0, cus = 0, per_cu = 0;
        if (hipGetDevice(&dev) != hipSuccess || hipDeviceGetAttribute(&cus, hipDeviceAttributeMultiprocessorCount, dev) != hipSuccess) { grid = -1; return; }
        if (hipFuncSetAttribute((const void*)mk_fwd, hipFuncAttributeMaxDynamicSharedMemorySize, LDS_BYTES) != hipSuccess) { fprintf(stderr, "kernel_launch: hipFuncSetAttribute failed\n"); grid = -1; return; }
        if (hipOccupancyMaxActiveBlocksPerMultiprocessor(&per_cu, (const void*)mk_fwd, NWAVES * 64, LDS_BYTES) != hipSuccess || per_cu < 1) { fprintf(stderr, "kernel_launch: occupancy query says %d\n", per_cu); per_cu = 1; }
        (void)hipGetLastError();
        grid = cus;
    }
    if (grid < 0) return;
    Args a{};
    for (int i = 0; i < 20; ++i) a.in[i] = (const float*)d_in[i];
    a.out = (float*)d_out; a.ws = (unsigned char*)d_ws;
#if MK_ONE_LAUNCH
    a.ph_lo = 0; a.ph_hi = N_PHASES;
    void* kargs[] = {&a};
    hipError_t e = hipLaunchCooperativeKernel((const void*)mk_fwd, dim3(grid), dim3(NWAVES * 64), kargs, LDS_BYTES, stream);
    if (e != hipSuccess) fprintf(stderr, "kernel_launch: cooperative launch failed: %s\n", hipGetErrorString(e));
#else
    for (int ph = 0; ph < N_PHASES; ++ph) for (int rep = 0; rep < 1 + ((PROBE_DUP >> ph) & 1); ++rep) { a.ph_lo = ph; a.ph_hi = ph + 1; hipLaunchKernelGGL(mk_fwd, dim3(grid), dim3(NWAVES * 64), LDS_BYTES, stream, a); }
#endif
}
```
